# Optimizing an MI355X kernel written in HIP

```python
import math
import jax, jax.numpy as jnp
from jax import lax
import numpy as np

D_MODEL = 1024
BATCH = 8
SEQ = 2048
DEPTH = 1
DEC_BATCH = 128
DEC_SEQ = 1
PAST_LEN = 16384
PAGE_SIZE = 128

D_MIX = D_MODEL
D_RET = D_MIX // 2
D_LRU = D_MIX - D_RET
N_RET_HEADS = 4
RET_HEAD_DIM = D_RET // N_RET_HEADS
N_LRU_BLOCKS = 8
LRU_BLOCK = D_LRU // N_LRU_BLOCKS
CONV_LRU = 4
CONV_FFN = 3
D_FF = ((8 * D_MODEL // 3 + 127) // 128) * 128
CHUNK = 128
ROPE_BASE = 10000.0
LRU_C = 8.0
EPS = 1e-6
N_MOD = 6
D_PROJ = 4 * D_RET + 2 * D_LRU

kernel_name = "hybrid_retention_rglru_convffn_step"


def rmsnorm(x, g):
    x32 = x.astype(jnp.float32)
    r = x32 * lax.rsqrt(jnp.mean(x32 * x32, axis=-1, keepdims=True) + EPS)
    return (r * g.astype(jnp.float32)).astype(x.dtype)


def rotary(t, pos):
    d = t.shape[-1]
    inv_freq = ROPE_BASE ** (-jnp.arange(0, d, 2, dtype=jnp.float32) / d)
    ang = pos[:, None] * inv_freq[None, :]
    cos, sin = jnp.cos(ang), jnp.sin(ang)
    t1, t2 = t[..., : d // 2], t[..., d // 2:]
    return jnp.concatenate([t1 * cos - t2 * sin, t1 * sin + t2 * cos], axis=-1)


def causal_dwconv(x, buf, w, b):
    K = w.shape[0]
    T = x.shape[1]
    xp = jnp.concatenate([buf.astype(x.dtype), x], axis=1)
    out = b + sum(xp[:, k:k + T] * w[k] for k in range(K))
    return out, xp[:, T:]


def retention(q, k, v, s0):
    B, H, T, d = q.shape
    C = math.gcd(CHUNK, T)
    n = T // C
    log_g = jnp.log(1.0 - 2.0 ** (-5.0 - jnp.arange(H, dtype=jnp.float32)))
    idx = jnp.arange(C, dtype=jnp.float32)
    diff = idx[:, None] - idx[None, :]
    dmask = jnp.where(diff[None] >= 0, jnp.exp(jnp.maximum(diff, 0.0)[None] * log_g[:, None, None]), 0.0)
    q_decay = jnp.exp((idx[None] + 1.0) * log_g[:, None])
    k_decay = jnp.exp((C - 1.0 - idx[None]) * log_g[:, None])
    chunk_decay = jnp.exp(C * log_g)

    def to_chunks(t):
        return t.reshape(B, H, n, C, d).transpose(2, 0, 1, 3, 4)

    def step(s, xs):
        qc, kc, vc = xs
        scores = jnp.einsum('bhid,bhjd->bhij', qc, kc) * dmask
        o = (jnp.einsum('bhij,bhjv->bhiv', scores, vc)
             + jnp.einsum('bhid,bhdv->bhiv', qc * q_decay[None, :, :, None], s))
        s_new = (s * chunk_decay[None, :, None, None]
                 + jnp.einsum('bhjd,bhjv->bhdv', kc * k_decay[None, :, :, None], vc))
        return s_new, o

    s_last, o = lax.scan(step, s0.astype(jnp.float32), (to_chunks(q), to_chunks(k), to_chunks(v)))
    o = o.transpose(1, 2, 0, 3, 4).reshape(B, H, T, d)
    return o, s_last


def rg_lru(x, h0, pos, w_r, b_r, w_i, b_i, lam):
    B, T, W = x.shape
    x32 = x.astype(jnp.float32)
    xb = x32.reshape(B, T, N_LRU_BLOCKS, LRU_BLOCK)
    r = jax.nn.sigmoid(jnp.einsum('btnd,nde->btne', xb, w_r.astype(jnp.float32)).reshape(B, T, W) + b_r)
    i = jax.nn.sigmoid(jnp.einsum('btnd,nde->btne', xb, w_i.astype(jnp.float32)).reshape(B, T, W) + b_i)
    log_a = -LRU_C * r * jax.nn.softplus(-lam.astype(jnp.float32))
    a = jnp.exp(log_a)
    mult = jnp.sqrt(-jnp.expm1(2.0 * log_a))
    mult = jnp.where((pos == 0)[None, :, None], 1.0, mult)
    bterm = mult * i * x32

    def combine(l, rr):
        a1, b1 = l
        a2, b2 = rr
        return a1 * a2, a2 * b1 + b2

    a_cum, b_cum = lax.associative_scan(combine, (a, bterm), axis=1)
    h = a_cum * h0.astype(jnp.float32)[:, None, :] + b_cum
    return h, h[:, -1]


def hybrid_layer(x, c, pos0, s_ret, s_h, s_conv_lru, s_conv_ffn,
                 w_ada, b_ada, g_mix, w_in, conv_lru_w, conv_lru_b, w_r, b_r, w_i, b_i, lam,
                 w_out, g_ffn, w_up_conv, w_up_gate, conv_ffn_w, conv_ffn_b, w_down):
    B, T, D = x.shape
    pos = pos0 + jnp.arange(T, dtype=jnp.float32)
    mod = (jax.nn.silu(c) @ w_ada + b_ada).reshape(B, N_MOD, D)[:, :, None, :]
    shift_m, scale_m, gate_m, shift_f, scale_f, gate_f = [mod[:, j] for j in range(N_MOD)]

    h = rmsnorm(x, g_mix) * (1.0 + scale_m) + shift_m
    proj = h @ w_in
    offs = np.cumsum([D_RET, D_RET, D_RET, D_RET, D_LRU])
    q, k, v, g_ret, x_lru, g_lru = jnp.split(proj, offs, axis=-1)

    def heads(t):
        return t.reshape(B, T, N_RET_HEADS, RET_HEAD_DIM).transpose(0, 2, 1, 3).astype(jnp.float32)

    qh = rotary(heads(q), pos)
    kh = rotary(heads(k), pos) * (RET_HEAD_DIM ** -0.5)
    vh = heads(v)
    o, s_ret_new = retention(qh, kh, vh, s_ret)
    mu = jnp.mean(o, axis=-1, keepdims=True)
    var = jnp.mean((o - mu) ** 2, axis=-1, keepdims=True)
    o = ((o - mu) * lax.rsqrt(var + EPS)).transpose(0, 2, 1, 3).reshape(B, T, D_RET)
    ret_out = (jax.nn.silu(g_ret.astype(jnp.float32)) * o).astype(x.dtype)

    xc, s_conv_lru_new = causal_dwconv(x_lru, s_conv_lru, conv_lru_w, conv_lru_b)
    hl, s_h_new = rg_lru(xc, s_h, pos, w_r, b_r, w_i, b_i, lam)
    lru_out = (hl * jax.nn.gelu(g_lru.astype(jnp.float32))).astype(x.dtype)

    mix = jnp.concatenate([ret_out, lru_out], axis=-1) @ w_out
    x = x + gate_m * mix

    h = rmsnorm(x, g_ffn) * (1.0 + scale_f) + shift_f
    u = h @ w_up_conv
    gv = h @ w_up_gate
    uc, s_conv_ffn_new = causal_dwconv(u, s_conv_ffn, conv_ffn_w, conv_ffn_b)
    f = (jax.nn.gelu(uc) * gv) @ w_down
    x = x + gate_f * f
    return x, s_ret_new, s_h_new, s_conv_lru_new, s_conv_ffn_new


def setup_inputs(seed: int = 0) -> dict:
    key = jax.random.key(seed)
    ks = jax.random.split(key, 40)
    f32 = jnp.float32
    nrm = lambda k, shape, s: jax.random.normal(k, shape, f32) * s
    L = DEPTH
    u = jax.random.uniform(ks[20], (L, D_LRU), f32, 0.9, 0.999)
    sa = u ** (1.0 / LRU_C)
    lam = jnp.log(sa) - jnp.log1p(-sa)
    return {
        "x_prompt": nrm(ks[0], (BATCH, SEQ, D_MODEL), 1.0),
        "x_sample": nrm(ks[1], (DEC_BATCH, DEC_SEQ, D_MODEL), 1.0),
        "c_prompt": nrm(ks[2], (BATCH, D_MODEL), 1.0),
        "c_sample": nrm(ks[3], (DEC_BATCH, D_MODEL), 1.0),
        "state_ret": nrm(ks[4], (L, DEC_BATCH, N_RET_HEADS, RET_HEAD_DIM, RET_HEAD_DIM), 0.5),
        "state_lru_h": nrm(ks[5], (L, DEC_BATCH, D_LRU), 0.5),
        "state_lru_conv": nrm(ks[6], (L, DEC_BATCH, CONV_LRU - 1, D_LRU), 1.0),
        "state_ffn_conv": nrm(ks[7], (L, DEC_BATCH, CONV_FFN - 1, D_FF), 1.0),
        "w_ada": nrm(ks[8], (L, D_MODEL, N_MOD * D_MODEL), 0.3 * D_MODEL ** -0.5),
        "b_ada": nrm(ks[9], (L, N_MOD * D_MODEL), 0.02),
        "g_mix": 1.0 + nrm(ks[10], (L, D_MODEL), 0.02),
        "w_in": nrm(ks[11], (L, D_MODEL, D_PROJ), D_MODEL ** -0.5),
        "conv_lru_w": nrm(ks[12], (L, CONV_LRU, D_LRU), CONV_LRU ** -0.5),
        "conv_lru_b": nrm(ks[13], (L, D_LRU), 0.02),
        "w_r": nrm(ks[14], (L, N_LRU_BLOCKS, LRU_BLOCK, LRU_BLOCK), LRU_BLOCK ** -0.5),
        "b_r": nrm(ks[15], (L, D_LRU), 0.02),
        "w_i": nrm(ks[16], (L, N_LRU_BLOCKS, LRU_BLOCK, LRU_BLOCK), LRU_BLOCK ** -0.5),
        "b_i": nrm(ks[17], (L, D_LRU), 0.02),
        "lam": lam,
        "w_out": nrm(ks[18], (L, D_MIX, D_MODEL), D_MIX ** -0.5),
        "g_ffn": 1.0 + nrm(ks[19], (L, D_MODEL), 0.02),
        "w_up_conv": nrm(ks[21], (L, D_MODEL, D_FF), D_MODEL ** -0.5),
        "w_up_gate": nrm(ks[22], (L, D_MODEL, D_FF), D_MODEL ** -0.5),
        "conv_ffn_w": nrm(ks[23], (L, CONV_FFN, D_FF), CONV_FFN ** -0.5),
        "conv_ffn_b": nrm(ks[24], (L, D_FF), 0.02),
        "w_down": nrm(ks[25], (L, D_FF, D_MODEL), D_FF ** -0.5),
        "g_final": 1.0 + nrm(ks[26], (D_MODEL,), 0.02),
    }


def reference(x_prompt, x_sample, c_prompt, c_sample, state_ret, state_lru_h, state_lru_conv,
              state_ffn_conv, w_ada, b_ada, g_mix, w_in, conv_lru_w, conv_lru_b, w_r, b_r, w_i,
              b_i, lam, w_out, g_ffn, w_up_conv, w_up_gate, conv_ffn_w, conv_ffn_b, w_down,
              g_final):
    yp, ys = x_prompt, x_sample
    ret_p, h_p, cl_p, cf_p = [], [], [], []
    ret_s, h_s, cl_s, cf_s = [], [], [], []
    for l in range(DEPTH):
        wts = (w_ada[l], b_ada[l], g_mix[l], w_in[l], conv_lru_w[l], conv_lru_b[l], w_r[l], b_r[l],
               w_i[l], b_i[l], lam[l], w_out[l], g_ffn[l], w_up_conv[l], w_up_gate[l],
               conv_ffn_w[l], conv_ffn_b[l], w_down[l])
        z_ret = jnp.zeros((BATCH, N_RET_HEADS, RET_HEAD_DIM, RET_HEAD_DIM), jnp.float32)
        z_h = jnp.zeros((BATCH, D_LRU), jnp.float32)
        z_cl = jnp.zeros((BATCH, CONV_LRU - 1, D_LRU), yp.dtype)
        z_cf = jnp.zeros((BATCH, CONV_FFN - 1, D_FF), yp.dtype)
        yp, sr, sh, scl, scf = hybrid_layer(yp, c_prompt, 0, z_ret, z_h, z_cl, z_cf, *wts)
        ret_p.append(sr); h_p.append(sh); cl_p.append(scl); cf_p.append(scf)
        ys, sr, sh, scl, scf = hybrid_layer(ys, c_sample, PAST_LEN, state_ret[l], state_lru_h[l],
                                            state_lru_conv[l], state_ffn_conv[l], *wts)
        ret_s.append(sr); h_s.append(sh); cl_s.append(scl); cf_s.append(scf)
    y_prompt = rmsnorm(yp, g_final)
    y_sample = rmsnorm(ys, g_final)
    return (y_prompt, y_sample,
            jnp.stack(ret_p), jnp.stack(h_p), jnp.stack(cl_p), jnp.stack(cf_p),
            jnp.stack(ret_s), jnp.stack(h_s), jnp.stack(cl_s), jnp.stack(cf_s))
```

```cpp
#include <hip/hip_runtime.h>
#include <hip/hip_cooperative_groups.h>
#include <cstdio>
#include <cstdint>
namespace cg = cooperative_groups;

#ifndef MK_MULTI
#define MK_MULTI 0
#endif

#define DEV __device__ __forceinline__
typedef unsigned short bf16_t;
typedef short bf16x8 __attribute__((ext_vector_type(8)));
typedef float f32x4 __attribute__((ext_vector_type(4)));
typedef unsigned u32x4 __attribute__((ext_vector_type(4)));
typedef unsigned u32x2 __attribute__((ext_vector_type(2)));

constexpr int D = 1024, TSEQ = 2048, NBATCH = 8, NTOK = 16384, NSMP = 128, NROWS = NTOK + NSMP;
constexpr int DP = 3072, DFF = 2816, DLRU = 512, NMODROWS = 144;
constexpr float EPS = 1e-6f;
constexpr int PAST_LEN = 16384;

constexpr size_t O_YP = 0, O_YS = O_YP + (size_t)NTOK * D, O_RETP = O_YS + (size_t)NSMP * D, O_LHP = O_RETP + 8 * 4 * 128 * 128,
                 O_LCP = O_LHP + 8 * 512, O_FCP = O_LCP + 8 * 3 * 512, O_RETS = O_FCP + 8 * 2 * DFF, O_LHS = O_RETS + (size_t)128 * 4 * 128 * 128,
                 O_LCS = O_LHS + 128 * 512, O_FCS = O_LCS + 128 * 3 * 512;

constexpr size_t al256(size_t x) { return (x + 255) & ~(size_t)255; }
constexpr size_t W_BTIN = 0;
constexpr size_t W_BTOUT = W_BTIN + (size_t)DP * D * 2;
constexpr size_t W_BTUP = W_BTOUT + (size_t)D * D * 2;
constexpr size_t W_BTDOWN = W_BTUP + (size_t)2 * DFF * D * 2;
constexpr size_t W_WRT = W_BTDOWN + (size_t)D * DFF * 2;
constexpr size_t W_H = W_WRT + 2 * 8 * 64 * 64 * 2;
constexpr size_t W_PROJ = W_H + (size_t)NROWS * D * 2;
constexpr size_t W_MIX = W_PROJ + (size_t)NTOK * DP * 2;
constexpr size_t W_KVT = W_MIX + (size_t)NROWS * D * 2;
constexpr size_t W_MOD = W_KVT + (size_t)512 * 65536;
constexpr size_t W_SW = W_MOD + (size_t)NMODROWS * 6144 * 4;
constexpr size_t W_PROJS = W_SW + (size_t)NMODROWS * 2 * DFF * 4;
constexpr size_t W_ROPE = W_PROJS + (size_t)NSMP * DP * 4;
constexpr size_t W_EDGEU = al256(W_ROPE + (size_t)(TSEQ + 1) * 128 * 4);
constexpr size_t W_EDGEG = W_EDGEU + (size_t)64 * 2 * DFF * 4;
constexpr size_t W_TAILU = W_EDGEG + (size_t)64 * 2 * DFF * 4;
constexpr size_t W_FIX = W_TAILU + (size_t)64 * 2 * DFF * 4;
constexpr size_t W_AGG = W_FIX + (size_t)256 * 2 * DFF * 2;
constexpr size_t W_RSS1 = W_AGG + (size_t)8 * 8 * 16 * 2 * 64 * 4;
constexpr size_t W_RSS2 = al256(W_RSS1 + (size_t)NROWS * 4);
constexpr size_t W_SPL = al256(W_RSS2 + (size_t)NROWS * 4);
constexpr size_t W_MODA = W_SPL + 512 * 4;
constexpr size_t W_SHF = W_MODA + (size_t)NMODROWS * D * 2;
constexpr size_t W_HIN0 = al256(W_SHF + (size_t)NMODROWS * D * 2);
constexpr size_t W_BAR = W_HIN0 + (size_t)1024 * 64 * 4;
constexpr int BAR_WORDS = 3456 + 64 * 64;
constexpr size_t W_END = W_BAR + (size_t)BAR_WORDS * 4;

constexpr int LDS_BYTES = 147456;

struct Params {
    const float *x_p, *x_s, *c_p, *c_s, *st_ret, *st_h, *st_cl, *st_cf, *w_ada, *b_ada, *g_mix, *w_in, *cl_w, *cl_b, *w_r, *b_r, *w_i, *b_i, *lam,
        *w_out, *g_ffn, *w_upc, *w_upg, *cf_w, *cf_b, *w_down, *g_final;
    float* out;
    unsigned char* ws;
    long long ph_lo, ph_hi;
};

extern __shared__ __attribute__((aligned(16))) unsigned char shm_raw[];

DEV int TIDX() { int t = threadIdx.x; asm volatile("" : "+v"(t)); return t; }
DEV int BIDX() { int b = blockIdx.x; asm volatile("" : "+s"(b)); return b; }
DEV unsigned cvt_pk_bf16(float lo, float hi) { unsigned r; asm("v_cvt_pk_bf16_f32 %0, %1, %2" : "=v"(r) : "v"(lo), "v"(hi)); return r; }
DEV bf16_t f2bf(float x) { return (bf16_t)(cvt_pk_bf16(x, 0.f) & 0xffffu); }
DEV float bf2f(bf16_t v) { return __uint_as_float(((unsigned)v) << 16); }
DEV float bflo(unsigned w) { return __uint_as_float(w << 16); }
DEV float bfhi(unsigned w) { return __uint_as_float(w & 0xffff0000u); }
DEV float fexp2(float x) { return __builtin_amdgcn_exp2f(x); }
DEV float sigmoidf_(float x) { return __builtin_amdgcn_rcpf(1.f + fexp2(-1.4426950408889634f * x)); }
DEV float siluf_(float x) { return x * sigmoidf_(x); }
DEV float geluf_(float x) { const float y = 1.5957691216057308f * (x + 0.044715f * x * x * x); return x * sigmoidf_(y); }
DEV float wave_sum(float v) {
#pragma unroll
    for (int o = 1; o < 64; o <<= 1) v += __shfl_xor(v, o);
    return v;
}
DEV void unpack8(u32x4 w, float* f) { f[0] = bflo(w.x); f[1] = bfhi(w.x); f[2] = bflo(w.y); f[3] = bfhi(w.y); f[4] = bflo(w.z); f[5] = bfhi(w.z); f[6] = bflo(w.w); f[7] = bfhi(w.w); }
DEV u32x4 pack8(const float* f) { u32x4 w; w.x = cvt_pk_bf16(f[0], f[1]); w.y = cvt_pk_bf16(f[2], f[3]); w.z = cvt_pk_bf16(f[4], f[5]); w.w = cvt_pk_bf16(f[6], f[7]); return w; }
DEV int rhoinv(int w) { return 16 * ((w >> 2) & 1) + 4 * (w >> 3) + (w & 3); }
DEV int permpos(int c) { return (c & ~31) | rhoinv(c & 31); }
DEV int slotcol(int n, int s) { return 8 * (s >> 2) + 4 * n + (s & 3); }
DEV float gamma_log2(int h) { return __log2f(1.f - exp2f(-5.f - (float)h)); }

constexpr int BM = 256, BK = 64, HALF = 128, HT = HALF * BK;
DEV int lds_byte(int r, int c) { int st = (r >> 4) * 2 + (c >> 5), rr = r & 15, cc = c & 31, ob = rr * 64 + cc * 2; return st * 1024 + (ob ^ (((ob >> 9) & 1) << 5)); }
DEV void stage_rc(int b, int& R, int& C) { int st = b / 1024, sb = b % 1024, swz = sb ^ (((sb >> 9) & 1) << 5); R = (st >> 1) * 16 + swz / 64; C = (st & 1) * 32 + (swz % 64) / 2; }

#define LAS __attribute__((address_space(3)))
template <bool FIX, class Epi>
DEV void gemm_tile(const bf16_t* __restrict__ A, const bf16_t* __restrict__ Bt, const int K, const int brow, const int bcol, const bf16_t* fixA, Epi&& epi) {
    LAS unsigned char* lds = (LAS unsigned char*)shm_raw;
    const int tid = TIDX(), wid = __builtin_amdgcn_readfirstlane(tid >> 6), lane = tid & 63, wr = wid >> 2, wc = wid & 3, fr = lane & 15, fq = lane >> 4;
    const int nt = K / BK;
    constexpr int HTB = HALF * BK * 2;
    unsigned voff[2], voffF[2];
#pragma unroll
    for (int i = 0; i < 2; ++i) {
        int R, C; stage_rc(tid * 16 + i * 8192, R, C);
        voff[i] = (unsigned)(R * K + C) * 2u; voffF[i] = voff[i];
        if (FIX) { if (R < 2) voffF[i] = (unsigned)(((const char*)fixA - (const char*)(A + (size_t)brow * K)) + (long)(R * K + C) * 2); }
    }
    const size_t kstep = (size_t)(BK * 2), hstep = (size_t)HALF * K * 2;
    const unsigned ldsw = (unsigned)wid * 1024u;
    const int aoff = lds_byte(wr * 64 + fr, fq * 8), boff = lds_byte(wc * 32 + fr, fq * 8);
    const char* cA = (const char*)(A + (size_t)brow * K); const char* cB = (const char*)(Bt + (size_t)bcol * K);
#define SA(b, h) (((b) * 2 + (h)) * HTB)
#define SB(b, h) ((4 + (b) * 2 + (h)) * HTB)
#define STAGE(bufoff, gbase, vo) do { _Pragma("unroll") for (int _i = 0; _i < 2; ++_i) \
        __builtin_amdgcn_global_load_lds((const unsigned*)((const char*)(gbase) + (vo)[_i]), (LAS unsigned*)(lds + (bufoff) + ldsw + _i * 8192), 16, 0, 0); } while (0)
#define LDA(dst, b, h) do { _Pragma("unroll") for (int m = 0; m < 4; ++m) _Pragma("unroll") for (int k = 0; k < 2; ++k) dst[m][k] = *(const LAS bf16x8*)(lds + SA(b, h) + aoff + m * 2048 + k * 1024); } while (0)
#define LDB(dst, b, h) do { _Pragma("unroll") for (int n = 0; n < 2; ++n) _Pragma("unroll") for (int k = 0; k < 2; ++k) dst[n][k] = *(const LAS bf16x8*)(lds + SB(b, h) + boff + n * 2048 + k * 1024); } while (0)
#define MMA(ai, bj, At_, Bt_) do { __builtin_amdgcn_s_setprio(1); _Pragma("unroll") for (int m = 0; m < 4; ++m) _Pragma("unroll") for (int n = 0; n < 2; ++n) _Pragma("unroll") for (int k = 0; k < 2; ++k) \
        acc[ai][bj][m][n] = __builtin_amdgcn_mfma_f32_16x16x32_bf16(Bt_[n][k], At_[m][k], acc[ai][bj][m][n], 0, 0, 0); __builtin_amdgcn_s_setprio(0); } while (0)
#define WAIT_V(n) asm volatile("s_waitcnt vmcnt(" #n ")" ::: "memory")
#define WAIT_L(n) asm volatile("s_waitcnt lgkmcnt(" #n ")" ::: "memory")
#define BAR __builtin_amdgcn_s_barrier()
#define SCHED __builtin_amdgcn_sched_barrier(0)
    f32x4 acc[2][2][4][2];
#pragma unroll
    for (int a = 0; a < 2; ++a)
#pragma unroll
        for (int b = 0; b < 2; ++b)
#pragma unroll
            for (int m = 0; m < 4; ++m)
#pragma unroll
                for (int n = 0; n < 2; ++n) acc[a][b][m][n] = (f32x4){0.f, 0.f, 0.f, 0.f};
    bf16x8 At[4][2], B0[2][2], B1[2][2];
    STAGE(SB(0, 0), cB, voff); STAGE(SA(0, 0), cA, voffF); STAGE(SB(0, 1), cB + hstep, voff); STAGE(SA(0, 1), cA + hstep, voff);
    if (wr == 1) BAR;
    WAIT_V(4); BAR;
    STAGE(SB(1, 0), cB + kstep, voff); STAGE(SA(1, 0), cA + kstep, voffF); STAGE(SB(1, 1), cB + hstep + kstep, voff);
    WAIT_V(6); BAR;
    for (int t = 0; t < nt - 2; t += 2) {
        const char* a1 = cA + (size_t)(t + 1) * kstep; const char* a2 = a1 + kstep; const char* a3 = a2 + kstep;
        const char* b2 = cB + (size_t)(t + 2) * kstep; const char* b3 = b2 + kstep;
        LDB(B0, 0, 0); SCHED; LDA(At, 0, 0); STAGE(SA(1, 1), a1 + hstep, voff);
        WAIT_L(8); BAR; WAIT_L(0); MMA(0, 0, At, B0); BAR; SCHED;
        LDB(B1, 0, 1); STAGE(SB(0, 0), b2, voff);
        BAR; WAIT_L(0); MMA(0, 1, At, B1); BAR;
        LDA(At, 0, 1); STAGE(SA(0, 0), a2, voffF);
        BAR; WAIT_L(0); MMA(1, 0, At, B0); BAR; SCHED;
        STAGE(SB(0, 1), b2 + hstep, voff);
        WAIT_V(6); BAR; MMA(1, 1, At, B1); BAR;
        LDB(B0, 1, 0); SCHED; LDA(At, 1, 0); STAGE(SA(0, 1), a2 + hstep, voff);
        WAIT_L(8); BAR; WAIT_L(0); MMA(0, 0, At, B0); BAR; SCHED;
        LDB(B1, 1, 1); STAGE(SB(1, 0), b3, voff);
        BAR; WAIT_L(0); MMA(0, 1, At, B1); BAR;
        LDA(At, 1, 1); STAGE(SA(1, 0), a3, voffF);
        BAR; WAIT_L(0); MMA(1, 0, At, B0); BAR; SCHED;
        STAGE(SB(1, 1), b3 + hstep, voff);
        WAIT_V(6); BAR; MMA(1, 1, At, B1); BAR;
    }
    { LDB(B0, 0, 0); LDA(At, 0, 0); STAGE(SA(1, 1), cA + (size_t)(nt - 1) * kstep + hstep, voff);
      BAR; WAIT_L(0); MMA(0, 0, At, B0); BAR;
      LDB(B1, 0, 1); BAR; WAIT_L(0); MMA(0, 1, At, B1); BAR;
      LDA(At, 0, 1); WAIT_V(4); BAR; WAIT_L(0); MMA(1, 0, At, B0); MMA(1, 1, At, B1); BAR; }
    { LDB(B0, 1, 0); LDA(At, 1, 0); WAIT_V(2); BAR; WAIT_L(0); MMA(0, 0, At, B0); BAR;
      LDB(B1, 1, 1); WAIT_V(0); BAR; WAIT_L(0); MMA(0, 1, At, B1); BAR;
      LDA(At, 1, 1); BAR; WAIT_L(0); MMA(1, 0, At, B0); MMA(1, 1, At, B1); BAR; }
    if (wr == 0) BAR;
    asm volatile("" ::: "memory");
    epi(acc, brow, bcol, wr, wc, fr, fq);
#undef SA
#undef SB
#undef STAGE
#undef LDA
#undef LDB
#undef MMA
}

DEV void tile_order(int L, int nM, int nN, int& pm, int& pn) {
    const int nwg = nM * nN, NX = 8, WGM = 8;
    int wgid = L; { const int q = nwg / NX, r = nwg % NX, xcd = wgid % NX, off = wgid / NX; wgid = (xcd < r ? xcd * (q + 1) : r * (q + 1) + (xcd - r) * q) + off; }
    const int nig = WGM * nN, gid = wgid / nig, fm = gid * WGM, gsz = (nM - fm) < WGM ? (nM - fm) : WGM;
    pm = fm + ((wgid % nig) % gsz); pn = (wgid % nig) / gsz;
}

DEV float dpp_ror1(float x) { return __int_as_float(__builtin_amdgcn_update_dpp(0, __float_as_int(x), 0x121, 0xf, 0xf, false)); }
DEV float dpp_ror2(float x) { return __int_as_float(__builtin_amdgcn_update_dpp(0, __float_as_int(x), 0x122, 0xf, 0xf, false)); }
DEV float dpp_shr1(float old, float x) { return __int_as_float(__builtin_amdgcn_update_dpp(__float_as_int(old), __float_as_int(x), 0x111, 0xf, 0xf, false)); }
DEV float dpp_shr2(float old, float x) { return __int_as_float(__builtin_amdgcn_update_dpp(__float_as_int(old), __float_as_int(x), 0x112, 0xf, 0xf, false)); }
#define SKINNY_LOOP(j, NBIG_, NSK_) const int _nb = gridDim.x, _first = (NBIG_) % _nb, _bb = BIDX(); if (_bb >= _first) for (int j = _bb - _first; j < (NSK_); j += _nb - _first)
template <bool FIX, class Epi>
DEV void gemm_phase(const bf16_t* __restrict__ A, const bf16_t* __restrict__ Bt, const int K, const int nM, const int nN, const int nbig, const bf16_t* fixbase, Epi&& epi) {
    LAS unsigned char* lds = (LAS unsigned char*)shm_raw;
    const int tid = TIDX(), wid = __builtin_amdgcn_readfirstlane(tid >> 6), lane = tid & 63, wr = wid >> 2, wc = wid & 3, fr = lane & 15, fq = lane >> 4;
    const int nt = K / BK, G = gridDim.x;
    int it = BIDX();
    if (it >= nbig) return;
    constexpr int HTB = HALF * BK * 2;
    unsigned voff[2], voffF[2], voffFn[2];
    int sR[2], sC[2];
#pragma unroll
    for (int i = 0; i < 2; ++i) { stage_rc(tid * 16 + i * 8192, sR[i], sC[i]); voff[i] = (unsigned)(sR[i] * K + sC[i]) * 2u; voffF[i] = voff[i]; voffFn[i] = voff[i]; }
    const size_t kstep = (size_t)(BK * 2), hstep = (size_t)HALF * K * 2, tstep = 2 * hstep;
    const unsigned ldsw = (unsigned)wid * 1024u;
    const int aoff = lds_byte(wr * 64 + fr, fq * 8), boff = lds_byte(wc * 32 + fr, fq * 8);
    int pm, pn; tile_order(it, nM, nN, pm, pn);
    const char* cA = (const char*)A + (size_t)pm * tstep; const char* cB = (const char*)Bt + (size_t)pn * tstep;
    if (FIX) {
#pragma unroll
        for (int i = 0; i < 2; ++i) if (sR[i] < 2) voffF[i] = (unsigned)(((const char*)(fixbase + (size_t)it * 2 * K) - cA) + (long)(sR[i] * K + sC[i]) * 2);
    }
#define SA(b, h) (((b) * 2 + (h)) * HTB)
#define SB(b, h) ((4 + (b) * 2 + (h)) * HTB)
#define STAGE(bufoff, gbase, vo) do { _Pragma("unroll") for (int _i = 0; _i < 2; ++_i) \
        __builtin_amdgcn_global_load_lds((const unsigned*)((const char*)(gbase) + (vo)[_i]), (LAS unsigned*)(lds + (bufoff) + ldsw + _i * 8192), 16, 0, 0); } while (0)
#define LDA(dst, b, h) do { _Pragma("unroll") for (int m = 0; m < 4; ++m) _Pragma("unroll") for (int k = 0; k < 2; ++k) dst[m][k] = *(const LAS bf16x8*)(lds + SA(b, h) + aoff + m * 2048 + k * 1024); } while (0)
#define LDB(dst, b, h) do { _Pragma("unroll") for (int n = 0; n < 2; ++n) _Pragma("unroll") for (int k = 0; k < 2; ++k) dst[n][k] = *(const LAS bf16x8*)(lds + SB(b, h) + boff + n * 2048 + k * 1024); } while (0)
#define MMA(ai, bj, At_, Bt_) do { __builtin_amdgcn_s_setprio(1); _Pragma("unroll") for (int m = 0; m < 4; ++m) _Pragma("unroll") for (int n = 0; n < 2; ++n) _Pragma("unroll") for (int k = 0; k < 2; ++k) \
        acc[ai][bj][m][n] = __builtin_amdgcn_mfma_f32_16x16x32_bf16(Bt_[n][k], At_[m][k], acc[ai][bj][m][n], 0, 0, 0); __builtin_amdgcn_s_setprio(0); } while (0)
    f32x4 acc[2][2][4][2];
#define ZACC() do { _Pragma("unroll") for (int a_ = 0; a_ < 2; ++a_) _Pragma("unroll") for (int b_ = 0; b_ < 2; ++b_) _Pragma("unroll") for (int m_ = 0; m_ < 4; ++m_) _Pragma("unroll") for (int n_ = 0; n_ < 2; ++n_) acc[a_][b_][m_][n_] = (f32x4){0.f, 0.f, 0.f, 0.f}; } while (0)
    ZACC();
    bf16x8 At[4][2], B0[2][2], B1[2][2];
    STAGE(SB(0, 0), cB, voff); STAGE(SB(0, 1), cB + hstep, voff); STAGE(SA(0, 0), cA, voffF); STAGE(SA(0, 1), cA + hstep, voff);
    if (wr == 1) BAR;
    WAIT_V(2); BAR;
    STAGE(SB(1, 0), cB + kstep, voff); STAGE(SA(1, 0), cA + kstep, voffF); STAGE(SB(1, 1), cB + hstep + kstep, voff);
    WAIT_V(6); BAR;
    for (;;) {
        const int itn = it + G; const bool has_next = itn < nbig;
        int pmn = pm, pnn = pn; if (has_next) tile_order(itn, nM, nN, pmn, pnn);
        const char* nA = (const char*)A + (size_t)pmn * tstep; const char* nB = (const char*)Bt + (size_t)pnn * tstep;
        if (FIX) {
#pragma unroll
            for (int i = 0; i < 2; ++i) { voffFn[i] = voff[i]; if (sR[i] < 2) voffFn[i] = (unsigned)(((const char*)(fixbase + (size_t)(has_next ? itn : it) * 2 * K) - nA) + (long)(sR[i] * K + sC[i]) * 2); }
        }
        for (int t = 0; t < nt; t += 2) {
            const bool last = (t == nt - 2);
            const char* a1 = cA + (size_t)(t + 1) * kstep;
            const char* a2 = last ? nA : cA + (size_t)(t + 2) * kstep; const char* b2 = last ? nB : cB + (size_t)(t + 2) * kstep;
            const char* a3 = a2 + kstep; const char* b3 = b2 + kstep;
            unsigned vF2[2];
#pragma unroll
            for (int i = 0; i < 2; ++i) vF2[i] = FIX ? (last ? voffFn[i] : voffF[i]) : voff[i];
            LDB(B0, 0, 0); LDB(B1, 0, 1); SCHED; LDA(At, 0, 0); STAGE(SA(1, 1), a1 + hstep, voff);
            WAIT_V(8); WAIT_L(0); BAR; MMA(0, 0, At, B0); MMA(0, 1, At, B1); BAR; SCHED;
            LDA(At, 0, 1); STAGE(SB(0, 0), b2, voff); STAGE(SB(0, 1), b2 + hstep, voff); STAGE(SA(0, 0), a2, vF2);
            WAIT_V(8); WAIT_L(0); BAR; MMA(1, 0, At, B0); MMA(1, 1, At, B1); BAR; SCHED;
            LDB(B0, 1, 0); LDB(B1, 1, 1); SCHED; LDA(At, 1, 0); STAGE(SA(0, 1), a2 + hstep, voff);
            WAIT_V(8); WAIT_L(0); BAR; MMA(0, 0, At, B0); MMA(0, 1, At, B1); BAR; SCHED;
            LDA(At, 1, 1); STAGE(SB(1, 0), b3, voff); STAGE(SB(1, 1), b3 + hstep, voff); STAGE(SA(1, 0), a3, vF2);
            WAIT_V(8); WAIT_L(0); BAR; MMA(1, 0, At, B0); MMA(1, 1, At, B1); BAR; SCHED;
        }
        if (wr == 0) BAR;
        asm volatile("" ::: "memory");
        epi(acc, pm, pn, pm * BM, pn * BM, wr, wc, fr, fq);
        asm volatile("s_waitcnt vmcnt(0)" ::: "memory");
        if (!has_next) break;
        ZACC();
        it = itn; pm = pmn; pn = pnn; cA = nA; cB = nB;
        if (FIX) { voffF[0] = voffFn[0]; voffF[1] = voffFn[1]; }
        if (wr == 1) BAR;
    }
    BAR;
#undef SA
#undef SB
#undef STAGE
#undef LDA
#undef LDB
#undef MMA
#undef ZACC
}

struct NoRowFn { DEV void operator()(int, float) const {} };
template <int RB, int NBLK, int U, class Epi, class RowFn = NoRowFn>
DEV void skinny_tile(const bf16_t* __restrict__ A, const int lda, const bf16_t* __restrict__ B0, const bf16_t* __restrict__ B1, const int K, Epi&& epi, RowFn&& rowfn = NoRowFn(), const int ldb_ = 0) {
    const int ldb = ldb_ ? ldb_ : K;
    float* red = (float*)shm_raw;
    const int tid = TIDX(), w = tid >> 6, lane = tid & 63, fr = lane & 15, fq = lane >> 4;
    constexpr int KG = (NBLK == 2) ? 4 : 8;
    const int kg = (NBLK == 2) ? (w & 3) : w, nb = (NBLK == 2) ? (w >> 2) : 0;
    const bf16_t* Bp = (nb ? B1 : B0) + (long)fr * ldb + fq * 8;
    const bf16_t* Ap = A + (long)fr * lda + fq * 8;
    const int kper = K / KG, kbeg = kg * kper, kend = kbeg + kper;
    f32x4 acc[RB];
#pragma unroll
    for (int rb = 0; rb < RB; ++rb) acc[rb] = (f32x4){0.f, 0.f, 0.f, 0.f};
    int k = kbeg;
    for (; k + 32 * U <= kend; k += 32 * U) {
        bf16x8 b[U], a[U][RB];
#pragma unroll
        for (int u = 0; u < U; ++u) {
            b[u] = *(const bf16x8*)(Bp + k + 32 * u);
#pragma unroll
            for (int rb = 0; rb < RB; ++rb) a[u][rb] = *(const bf16x8*)(Ap + (long)rb * 16 * lda + k + 32 * u);
        }
#pragma unroll
        for (int u = 0; u < U; ++u)
#pragma unroll
            for (int rb = 0; rb < RB; ++rb) acc[rb] = __builtin_amdgcn_mfma_f32_16x16x32_bf16(b[u], a[u][rb], acc[rb], 0, 0, 0);
    }
    for (; k < kend; k += 32) {
        const bf16x8 b = *(const bf16x8*)(Bp + k);
        bf16x8 a[RB];
#pragma unroll
        for (int rb = 0; rb < RB; ++rb) a[rb] = *(const bf16x8*)(Ap + (long)rb * 16 * lda + k);
#pragma unroll
        for (int rb = 0; rb < RB; ++rb) acc[rb] = __builtin_amdgcn_mfma_f32_16x16x32_bf16(b, a[rb], acc[rb], 0, 0, 0);
    }
    f32x4* r4 = (f32x4*)red;
#pragma unroll
    for (int rb = 0; rb < RB; ++rb) r4[(w * RB + rb) * 64 + lane] = acc[rb];
    __syncthreads();
    for (int e = tid; e < RB * 256; e += 512) {
        const int row = e >> 4, s = e & 15, rb = row >> 4, l2 = (row & 15) + 16 * (s >> 2), r = s & 3;
        float v0 = 0.f, v1 = 0.f;
        if (NBLK == 2) {
#pragma unroll
            for (int g = 0; g < 4; ++g) { v0 += red[((g * RB + rb) * 64 + l2) * 4 + r]; v1 += red[(((4 + g) * RB + rb) * 64 + l2) * 4 + r]; }
        } else {
#pragma unroll
            for (int g = 0; g < 8; ++g) v0 += red[((g * RB + rb) * 64 + l2) * 4 + r];
        }
        float ss = epi(row, s, v0, v1);
        ss += __shfl_xor(ss, 1); ss += __shfl_xor(ss, 2); ss += __shfl_xor(ss, 4); ss += __shfl_xor(ss, 8);
        if (s == 0) rowfn(row, ss);
    }
    __syncthreads();
}

template <class RowMap>
DEV void transpose_tile(const float* __restrict__ src, const int N, const int K, const int k0, const int c0, bf16_t* __restrict__ dst, RowMap&& rowmap) {
    float* lds = (float*)shm_raw;
    const int tid = TIDX();
#pragma unroll
    for (int i = 0; i < 2; ++i) {
        const int idx = tid * 4 + i * 2048, kk = idx >> 6, cc = idx & 63;
        const f32x4 v = *(const f32x4*)(src + (size_t)(k0 + kk) * N + c0 + cc);
        lds[kk * 65 + cc] = v.x; lds[kk * 65 + cc + 1] = v.y; lds[kk * 65 + cc + 2] = v.z; lds[kk * 65 + cc + 3] = v.w;
    }
    __syncthreads();
    {
        const int c = tid >> 3, ks = (tid & 7) * 8;
        float f[8];
#pragma unroll
        for (int e = 0; e < 8; ++e) f[e] = lds[(ks + e) * 65 + c];
        *(u32x4*)(dst + (size_t)rowmap(c0 + c) * K + k0 + ks) = pack8(f);
    }
    __syncthreads();
}

DEV void phase_prep(const Params& p) {
    unsigned char* ws = p.ws;
    bf16_t* BtIn = (bf16_t*)(ws + W_BTIN); bf16_t* BtOut = (bf16_t*)(ws + W_BTOUT); bf16_t* BtUp = (bf16_t*)(ws + W_BTUP);
    bf16_t* BtDown = (bf16_t*)(ws + W_BTDOWN); bf16_t* BtAda = (bf16_t*)(ws + W_KVT); bf16_t* WrT = (bf16_t*)(ws + W_WRT);
    constexpr int T_IN = 16 * 48, T_OUT = 16 * 16, T_UP = 16 * 44, T_DOWN = 44 * 16, T_ADA = 16 * 96, T_G = 16;
    constexpr int T_ALL = T_IN + T_OUT + 2 * T_UP + T_DOWN + T_ADA + T_G;
    for (int it = BIDX(); it < T_ALL; it += gridDim.x) {
        int r = it;
        if (r < T_ADA) { transpose_tile(p.w_ada, 6144, 1024, (r / 96) * 64, (r % 96) * 64, BtAda, [](int c) { return permpos(c); }); continue; } r -= T_ADA;
        if (r < T_IN) { transpose_tile(p.w_in, DP, 1024, (r / 48) * 64, (r % 48) * 64, BtIn, [](int c) { return permpos(c); }); continue; } r -= T_IN;
        if (r < T_OUT) { transpose_tile(p.w_out, D, 1024, (r / 16) * 64, (r % 16) * 64, BtOut, [](int c) { return permpos(c); }); continue; } r -= T_OUT;
        if (r < T_UP) { transpose_tile(p.w_upc, DFF, 1024, (r / 44) * 64, (r % 44) * 64, BtUp, [](int c) { return 256 * (c >> 7) + permpos(c & 127); }); continue; } r -= T_UP;
        if (r < T_UP) { transpose_tile(p.w_upg, DFF, 1024, (r / 44) * 64, (r % 44) * 64, BtUp, [](int c) { return 256 * (c >> 7) + 128 + permpos(c & 127); }); continue; } r -= T_UP;
        if (r < T_DOWN) { transpose_tile(p.w_down, D, DFF, (r / 16) * 64, (r % 16) * 64, BtDown, [](int c) { return permpos(c); }); continue; } r -= T_DOWN;
        { const int g = r >> 3, jb = r & 7; transpose_tile((g ? p.w_i : p.w_r) + jb * 4096, 64, 64, 0, 0, WrT + (g * 8 + jb) * 4096, [](int c) { return c; }); }
    }
    const int gt = BIDX() * 512 + TIDX(), GT = gridDim.x * 512;
    bf16_t* modA = (bf16_t*)(ws + W_MODA);
    for (int i = gt; i < NMODROWS * D; i += GT) {
        const int row = i >> 10, k = i & 1023;
        float v = 0.f;
        if (row < 8) v = siluf_(p.c_p[row * D + k]); else if (row < 136) v = siluf_(p.c_s[(row - 8) * D + k]);
        modA[i] = f2bf(v);
    }
    float* rope = (float*)(ws + W_ROPE);
    for (int i = gt; i < (TSEQ + 1) * 64; i += GT) {
        const int t = i >> 6, j = i & 63;
        const float pos = (t < TSEQ) ? (float)t : (float)PAST_LEN;
        const float invf = exp2f(-(float)(2 * j) * (13.287712379549449f / 128.f));
        const float ang = pos * invf;
        float s, c; sincosf(ang, &s, &c);
        rope[t * 128 + j] = c; rope[t * 128 + 64 + j] = s;
    }
    float* rss1 = (float*)(ws + W_RSS1); float* rss2 = (float*)(ws + W_RSS2); float* spl = (float*)(ws + W_SPL);
    for (int i = gt; i < NROWS; i += GT) { rss1[i] = 0.f; rss2[i] = 0.f; }
    for (int i = gt; i < 512; i += GT) spl[i] = 8.f * log1pf(__expf(-p.lam[i]));
}

DEV void phase_mod(const Params& p) {
    unsigned char* ws = p.ws;
    const bf16_t* modA = (const bf16_t*)(ws + W_MODA); const bf16_t* BtAda = (const bf16_t*)(ws + W_KVT); float* mod = (float*)(ws + W_MOD);
    for (int it = BIDX(); it < 128; it += gridDim.x) {
        const int g = it >> 1, n = it & 1;
        const bf16_t* B0 = BtAda + (size_t)(32 * g + 16 * n) * D;
        skinny_tile<9, 1, 4>(modA, D, B0, B0, D, [&](int row, int s, float v0, float v1) {
            if (row < 136) { const int c0 = 32 * g + slotcol(n, s); mod[(size_t)row * 6144 + c0] = v0 + p.b_ada[c0]; }
            return 0.f;
        });
    }
}

DEV void phase_norm1(const Params& p) {
    unsigned char* ws = p.ws;
    const float* mod = (const float*)(ws + W_MOD); bf16_t* H = (bf16_t*)(ws + W_H); bf16_t* shf = (bf16_t*)(ws + W_SHF);
    const int lane = TIDX() & 63, gw = BIDX() * 8 + (TIDX() >> 6), NGW = gridDim.x * 8;
    for (int row = gw; row < NROWS; row += NGW) {
        const float* xr = (row < NTOK) ? p.x_p + (size_t)row * D : p.x_s + (size_t)(row - NTOK) * D;
        const int b = (row < NTOK) ? (row >> 11) : 8 + (row - NTOK);
        const float* mrow = mod + (size_t)b * 6144;
        f32x4 v[4]; float ss = 0.f;
#pragma unroll
        for (int j = 0; j < 4; ++j) { v[j] = *(const f32x4*)(xr + 4 * lane + 256 * j); ss += v[j].x * v[j].x + v[j].y * v[j].y + v[j].z * v[j].z + v[j].w * v[j].w; }
        const float rstd = __builtin_amdgcn_rsqf(wave_sum(ss) * (1.f / D) + EPS);
#pragma unroll
        for (int j = 0; j < 4; ++j) {
            const int k = 4 * lane + 256 * j;
            const f32x4 g = *(const f32x4*)(p.g_mix + k), sh = *(const f32x4*)(mrow + k), sc = *(const f32x4*)(mrow + D + k);
            const f32x4 h = v[j] * rstd * g * (1.f + sc) + sh;
            u32x2 o; o.x = cvt_pk_bf16(h.x, h.y); o.y = cvt_pk_bf16(h.z, h.w);
            *(u32x2*)(H + (size_t)row * D + k) = o;
        }
    }
}

DEV void phase_inproj(const Params& p) {
    unsigned char* ws = p.ws;
    const bf16_t* H = (const bf16_t*)(ws + W_H); const bf16_t* BtIn = (const bf16_t*)(ws + W_BTIN); bf16_t* proj = (bf16_t*)(ws + W_PROJ);
    float* projS = (float*)(ws + W_PROJS);
    constexpr int NBIG = 64 * 12, NSK1 = 96;
    gemm_phase<false>(H, BtIn, D, 64, 12, NBIG, nullptr, [&](const f32x4 (&acc)[2][2][4][2], int pm, int pn, int brow, int bcol, int wr, int wc, int fr, int fq) {
#pragma unroll
        for (int ai = 0; ai < 2; ++ai)
#pragma unroll
            for (int m = 0; m < 4; ++m) {
                bf16_t* rp = proj + (size_t)(brow + ai * HALF + wr * 64 + m * 16 + fr) * DP + bcol + wc * 32 + 8 * fq;
#pragma unroll
                for (int bj = 0; bj < 2; ++bj) {
                    const f32x4 a = acc[ai][bj][m][0], b = acc[ai][bj][m][1];
                    u32x4 w; w.x = cvt_pk_bf16(a[0], a[1]); w.y = cvt_pk_bf16(a[2], a[3]); w.z = cvt_pk_bf16(b[0], b[1]); w.w = cvt_pk_bf16(b[2], b[3]);
                    *(u32x4*)(rp + bj * HALF) = w;
                }
            }
    });
    const bf16_t* modA = (const bf16_t*)(ws + W_MODA); const bf16_t* BtAda = (const bf16_t*)(ws + W_KVT); float* mod = (float*)(ws + W_MOD);
    SKINNY_LOOP(j, NBIG, NSK1 + 128) {
        if (j < NSK1) {
            const int g = j;
            const bf16_t* B0 = BtIn + (size_t)(32 * g) * D;
            skinny_tile<8, 2, 4>(H + (size_t)NTOK * D, D, B0, B0 + 16 * D, D, [&](int row, int s, float v0, float v1) {
                const int c0 = 32 * g + slotcol(0, s); projS[row * DP + c0] = v0; projS[row * DP + c0 + 4] = v1; return 0.f;
            });
        } else {
            const int g = 64 + (j - NSK1);
            const bf16_t* B0 = BtAda + (size_t)(32 * g) * D;
            skinny_tile<9, 2, 4>(modA, D, B0, B0 + 16 * D, D, [&](int row, int s, float v0, float v1) {
                if (row < 136) { const int c0 = 32 * g + slotcol(0, s), c1 = c0 + 4; mod[(size_t)row * 6144 + c0] = v0 + p.b_ada[c0]; mod[(size_t)row * 6144 + c1] = v1 + p.b_ada[c1]; }
                return 0.f;
            });
        }
    }
}

constexpr int RP = 136;
DEV void rot8(const float* x1, const float* x2, const float* tr, int d0, float scale, float* o1, float* o2) {
    const f32x4 c0 = *(const f32x4*)(tr + d0), c1 = *(const f32x4*)(tr + d0 + 4), s0 = *(const f32x4*)(tr + 64 + d0), s1 = *(const f32x4*)(tr + 64 + d0 + 4);
    const float c[8] = {c0.x, c0.y, c0.z, c0.w, c1.x, c1.y, c1.z, c1.w}, s[8] = {s0.x, s0.y, s0.z, s0.w, s1.x, s1.y, s1.z, s1.w};
#pragma unroll
    for (int e = 0; e < 8; ++e) { o1[e] = (x1[e] * c[e] - x2[e] * s[e]) * scale; o2[e] = (x1[e] * s[e] + x2[e] * c[e]) * scale; }
}

DEV void rot8v(const u32x4 a, const u32x4 b, const f32x4 c0, const f32x4 c1, const f32x4 s0, const f32x4 s1, float scale, float* o1, float* o2) {
    float x1[8], x2[8]; unpack8(a, x1); unpack8(b, x2);
    const float c[8] = {c0.x, c0.y, c0.z, c0.w, c1.x, c1.y, c1.z, c1.w}, s[8] = {s0.x, s0.y, s0.z, s0.w, s1.x, s1.y, s1.z, s1.w};
#pragma unroll
    for (int e = 0; e < 8; ++e) { o1[e] = (x1[e] * c[e] - x2[e] * s[e]) * scale; o2[e] = (x1[e] * s[e] + x2[e] * c[e]) * scale; }
}
DEV void scatter_vT(const u32x4 w, int j, int d0, bf16_t* vT) {
    const unsigned ww[4] = {w.x, w.y, w.z, w.w};
#pragma unroll
    for (int e = 0; e < 4; ++e) { vT[(d0 + 2 * e) * RP + j] = (bf16_t)(ww[e] & 0xffffu); vT[(d0 + 2 * e + 1) * RP + j] = (bf16_t)(ww[e] >> 16); }
}
DEV void stage_vT(const bf16_t* proj, int row0, int h, bf16_t* vT) {
    for (int item = TIDX(); item < 2048; item += 512) {
        const int j = item >> 4, d0 = (item & 15) * 8;
        const u32x4 w = *(const u32x4*)(proj + (size_t)(row0 + j) * DP + 1024 + h * 128 + d0);
        const unsigned ww[4] = {w.x, w.y, w.z, w.w};
#pragma unroll
        for (int e = 0; e < 4; ++e) { vT[(d0 + 2 * e) * RP + j] = (bf16_t)(ww[e] & 0xffffu); vT[(d0 + 2 * e + 1) * RP + j] = (bf16_t)(ww[e] >> 16); }
    }
}

DEV void ret_passA(const Params& p, int unit) {
    unsigned char* ws = p.ws;
    const bf16_t* proj = (const bf16_t*)(ws + W_PROJ); const float* rope = (const float*)(ws + W_ROPE); float* KVT = (float*)(ws + W_KVT) + (size_t)unit * 16384;
    const int n = unit & 15, h = (unit >> 4) & 3, b = unit >> 6, row0 = b * TSEQ + n * 128;
    bf16_t* kT = (bf16_t*)shm_raw; bf16_t* vT = kT + 128 * RP;
    const float lg = gamma_log2(h);
    {
        const int tid = TIDX();
        u32x4 kA[2], kB[2], vv[4]; f32x4 rc[2][4];
#pragma unroll
        for (int i = 0; i < 2; ++i) {
            const int item = tid + 512 * i, j = item >> 3, d0 = (item & 7) * 8;
            const bf16_t* kr = proj + (size_t)(row0 + j) * DP + 512 + h * 128; const float* tr = rope + (size_t)(n * 128 + j) * 128;
            kA[i] = *(const u32x4*)(kr + d0); kB[i] = *(const u32x4*)(kr + 64 + d0);
            rc[i][0] = *(const f32x4*)(tr + d0); rc[i][1] = *(const f32x4*)(tr + d0 + 4); rc[i][2] = *(const f32x4*)(tr + 64 + d0); rc[i][3] = *(const f32x4*)(tr + 64 + d0 + 4);
        }
#pragma unroll
        for (int i = 0; i < 4; ++i) { const int item = tid + 512 * i, j = item >> 4, d0 = (item & 15) * 8; vv[i] = *(const u32x4*)(proj + (size_t)(row0 + j) * DP + 1024 + h * 128 + d0); }
#pragma unroll
        for (int i = 0; i < 2; ++i) {
            const int item = tid + 512 * i, j = item >> 3, d0 = (item & 7) * 8;
            float o1[8], o2[8];
            rot8v(kA[i], kB[i], rc[i][0], rc[i][1], rc[i][2], rc[i][3], 0.08838834764831845f * fexp2(lg * (float)(127 - j)), o1, o2);
#pragma unroll
            for (int e = 0; e < 8; ++e) { kT[(d0 + e) * RP + j] = f2bf(o1[e]); kT[(64 + d0 + e) * RP + j] = f2bf(o2[e]); }
        }
#pragma unroll
        for (int i = 0; i < 4; ++i) { const int item = tid + 512 * i; scatter_vT(vv[i], item >> 4, (item & 15) * 8, vT); }
    }
    __syncthreads();
    const int w = TIDX() >> 6, lane = TIDX() & 63, fr = lane & 15, fq = lane >> 4;
    f32x4 acc[8];
#pragma unroll
    for (int vb = 0; vb < 8; ++vb) acc[vb] = (f32x4){0.f, 0.f, 0.f, 0.f};
#pragma unroll
    for (int ks = 0; ks < 4; ++ks) {
        const bf16x8 a = *(const bf16x8*)(kT + (16 * w + fr) * RP + 32 * ks + 8 * fq);
#pragma unroll
        for (int vb = 0; vb < 8; ++vb) {
            const bf16x8 bb = *(const bf16x8*)(vT + (16 * vb + fr) * RP + 32 * ks + 8 * fq);
            acc[vb] = __builtin_amdgcn_mfma_f32_16x16x32_bf16(a, bb, acc[vb], 0, 0, 0);
        }
    }
#pragma unroll
    for (int vb = 0; vb < 8; ++vb) *(f32x4*)(KVT + (16 * vb + fr) * 128 + 16 * w + 4 * fq) = acc[vb];
    __syncthreads();
}

DEV void ret_passC(const Params& p, int unit) {
    unsigned char* ws = p.ws;
    const bf16_t* proj = (const bf16_t*)(ws + W_PROJ); const float* rope = (const float*)(ws + W_ROPE); bf16_t* mix = (bf16_t*)(ws + W_MIX);
    const int n = unit & 15, h = (unit >> 4) & 3, b = unit >> 6, row0 = b * TSEQ + n * 128;
    bf16_t* ks_ = (bf16_t*)shm_raw; bf16_t* vT = ks_ + 128 * RP; bf16_t* ST = vT + 128 * RP; bf16_t* P = ST + 128 * RP;
    const float lg = gamma_log2(h);
    const int tid = TIDX(), w = tid >> 6, lane = tid & 63, fr = lane & 15, fq = lane >> 4;
    const int i_loc = 16 * w + fr;
    bf16x8 qf[4];
    {
        u32x4 kA[2], kB[2], vv[4], st[4], qA[2], qB[2]; f32x4 rc[2][4], qc[2][4];
#pragma unroll
        for (int i = 0; i < 2; ++i) {
            const int item = tid + 512 * i, j = item >> 3, d0 = (item & 7) * 8;
            const bf16_t* kr = proj + (size_t)(row0 + j) * DP + 512 + h * 128; const float* tr = rope + (size_t)(n * 128 + j) * 128;
            kA[i] = *(const u32x4*)(kr + d0); kB[i] = *(const u32x4*)(kr + 64 + d0);
            rc[i][0] = *(const f32x4*)(tr + d0); rc[i][1] = *(const f32x4*)(tr + d0 + 4); rc[i][2] = *(const f32x4*)(tr + 64 + d0); rc[i][3] = *(const f32x4*)(tr + 64 + d0 + 4);
        }
#pragma unroll
        for (int i = 0; i < 4; ++i) { const int item = tid + 512 * i, j = item >> 4, d0 = (item & 15) * 8; vv[i] = *(const u32x4*)(proj + (size_t)(row0 + j) * DP + 1024 + h * 128 + d0); }
        {
            const int dv = tid >> 2, sg = tid & 3;
            const bf16_t* src = (const bf16_t*)(ws + W_H) + (size_t)unit * 16384 + dv * 128 + sg * 32;
#pragma unroll
            for (int i = 0; i < 4; ++i) st[i] = *(const u32x4*)(src + 8 * i);
        }
        {
            const bf16_t* qr = proj + (size_t)(row0 + i_loc) * DP + h * 128; const float* tr = rope + (size_t)(n * 128 + i_loc) * 128;
#pragma unroll
            for (int kk = 0; kk < 2; ++kk) {
                const int d0 = 32 * kk + 8 * fq;
                qA[kk] = *(const u32x4*)(qr + d0); qB[kk] = *(const u32x4*)(qr + 64 + d0);
                qc[kk][0] = *(const f32x4*)(tr + d0); qc[kk][1] = *(const f32x4*)(tr + d0 + 4); qc[kk][2] = *(const f32x4*)(tr + 64 + d0); qc[kk][3] = *(const f32x4*)(tr + 64 + d0 + 4);
            }
        }
#pragma unroll
        for (int i = 0; i < 2; ++i) {
            const int item = tid + 512 * i, j = item >> 3, d0 = (item & 7) * 8;
            float o1[8], o2[8];
            rot8v(kA[i], kB[i], rc[i][0], rc[i][1], rc[i][2], rc[i][3], 0.08838834764831845f, o1, o2);
            *(u32x4*)(ks_ + j * RP + d0) = pack8(o1); *(u32x4*)(ks_ + j * RP + 64 + d0) = pack8(o2);
        }
#pragma unroll
        for (int i = 0; i < 4; ++i) { const int item = tid + 512 * i; scatter_vT(vv[i], item >> 4, (item & 15) * 8, vT); }
        {
            const int dv = tid >> 2, sg = tid & 3;
#pragma unroll
            for (int i = 0; i < 4; ++i) *(u32x4*)(ST + dv * RP + sg * 32 + 8 * i) = st[i];
        }
#pragma unroll
        for (int kk = 0; kk < 2; ++kk) {
            float o1[8], o2[8];
            rot8v(qA[kk], qB[kk], qc[kk][0], qc[kk][1], qc[kk][2], qc[kk][3], 1.f, o1, o2);
            const u32x4 a = pack8(o1), c = pack8(o2);
            qf[kk] = __builtin_bit_cast(bf16x8, a); qf[kk + 2] = __builtin_bit_cast(bf16x8, c);
        }
    }
    __syncthreads();
#pragma unroll
    for (int jb = 0; jb < 8; ++jb) {
        u32x2 o; o.x = 0u; o.y = 0u;
        if (jb <= w) {
            f32x4 sc = (f32x4){0.f, 0.f, 0.f, 0.f};
#pragma unroll
            for (int kk = 0; kk < 4; ++kk) {
                const bf16x8 a = *(const bf16x8*)(ks_ + (16 * jb + fr) * RP + 32 * kk + 8 * fq);
                sc = __builtin_amdgcn_mfma_f32_16x16x32_bf16(a, qf[kk], sc, 0, 0, 0);
            }
            float pv[4];
#pragma unroll
            for (int r = 0; r < 4; ++r) { const int dj = i_loc - (16 * jb + 4 * fq + r); pv[r] = dj >= 0 ? sc[r] * fexp2(lg * (float)dj) : 0.f; }
            o.x = cvt_pk_bf16(pv[0], pv[1]); o.y = cvt_pk_bf16(pv[2], pv[3]);
        }
        *(u32x2*)(P + i_loc * RP + 16 * jb + 4 * fq) = o;
    }
    __syncthreads();
    f32x4 a1[8], a2[8];
#pragma unroll
    for (int vb = 0; vb < 8; ++vb) { a1[vb] = (f32x4){0.f, 0.f, 0.f, 0.f}; a2[vb] = (f32x4){0.f, 0.f, 0.f, 0.f}; }
    for (int kk = 0; kk <= (w >> 1); ++kk) {
        const bf16x8 pb = *(const bf16x8*)(P + i_loc * RP + 32 * kk + 8 * fq);
#pragma unroll
        for (int vb = 0; vb < 8; ++vb) {
            const bf16x8 a = *(const bf16x8*)(vT + (16 * vb + fr) * RP + 32 * kk + 8 * fq);
            a1[vb] = __builtin_amdgcn_mfma_f32_16x16x32_bf16(a, pb, a1[vb], 0, 0, 0);
        }
    }
#pragma unroll
    for (int kk = 0; kk < 4; ++kk) {
#pragma unroll
        for (int vb = 0; vb < 8; ++vb) {
            const bf16x8 a = *(const bf16x8*)(ST + (16 * vb + fr) * RP + 32 * kk + 8 * fq);
            a2[vb] = __builtin_amdgcn_mfma_f32_16x16x32_bf16(a, qf[kk], a2[vb], 0, 0, 0);
        }
    }
    const float qd = fexp2(lg * (float)(i_loc + 1));
    float sum = 0.f;
#pragma unroll
    for (int vb = 0; vb < 8; ++vb) { a1[vb] = a1[vb] + qd * a2[vb]; sum += (a1[vb].x + a1[vb].y) + (a1[vb].z + a1[vb].w); }
    sum += __shfl_xor(sum, 16); sum += __shfl_xor(sum, 32);
    const float mu = sum * (1.f / 128.f);
    float var = 0.f;
#pragma unroll
    for (int vb = 0; vb < 8; ++vb) { const f32x4 d = a1[vb] - mu; var += (d.x * d.x + d.y * d.y) + (d.z * d.z + d.w * d.w); }
    var += __shfl_xor(var, 16); var += __shfl_xor(var, 32);
    const float rstd = __builtin_amdgcn_rsqf(var * (1.f / 128.f) + EPS);
    const bf16_t* gr = proj + (size_t)(row0 + i_loc) * DP + 1536 + h * 128 + 4 * fq;
    bf16_t* orow = mix + (size_t)(row0 + i_loc) * D + h * 128 + 4 * fq;
#pragma unroll
    for (int vb = 0; vb < 8; ++vb) {
        const u32x2 g = *(const u32x2*)(gr + 16 * vb);
        const f32x4 d = (a1[vb] - mu) * rstd;
        u32x2 o; o.x = cvt_pk_bf16(d.x * siluf_(bflo(g.x)), d.y * siluf_(bfhi(g.x))); o.y = cvt_pk_bf16(d.z * siluf_(bflo(g.y)), d.w * siluf_(bfhi(g.y)));
        *(u32x2*)(orow + 16 * vb) = o;
    }
    __syncthreads();
}

#define LBAR() do { asm volatile("s_waitcnt lgkmcnt(0)" ::: "memory"); __builtin_amdgcn_s_barrier(); asm volatile("" ::: "memory"); } while (0)
template <bool FINAL>
DEV void lru_phase(const Params& p) {
    unsigned char* ws = p.ws;
    const bf16_t* proj = (const bf16_t*)(ws + W_PROJ); bf16_t* mix = (bf16_t*)(ws + W_MIX); const bf16_t* WrT = (const bf16_t*)(ws + W_WRT);
    const float* spl = (const float*)(ws + W_SPL); float* agg = (float*)(ws + W_AGG); const float* hin0g = (const float*)(ws + W_HIN0);
    float* xcf = (float*)shm_raw;
    constexpr int XP = 68;
    float* af = xcf + 128 * XP;
    bf16_t* xcb = (bf16_t*)(af + 128 * XP);
    float* segA = (float*)(xcb + 128 * 72);
    float* segB = segA + 512;
    float* hin = segB + 512;
    bf16_t* wT = (bf16_t*)(hin + 512);
    float* cwL = (float*)(wT + 2 * 64 * 72);
    bf16_t* gbuf = (bf16_t*)(cwL + 8 * 64);
    const int tid = TIDX(), w = tid >> 6, lane = tid & 63, fr = lane & 15, fq = lane >> 4;
    const int tt = tid >> 2, e0 = (tid & 3) * 16;
    int key = -1;
    u32x4 xr[4][2]; u32x4 gr[2]; float h0 = 0.f;
    auto prefetch = [&](int unit) {
        const int c = unit & 15, jb = (unit >> 4) & 7, b = unit >> 7, ch0 = 64 * jb;
#pragma unroll
        for (int k = 0; k < 4; ++k) {
            const int tabs = c * 128 + tt - 3 + k;
            xr[k][0] = (u32x4){0u, 0u, 0u, 0u}; xr[k][1] = xr[k][0];
            if (tabs >= 0) { const bf16_t* xp = proj + (size_t)(b * TSEQ + tabs) * DP + 2048 + ch0 + e0; xr[k][0] = *(const u32x4*)xp; xr[k][1] = *(const u32x4*)(xp + 8); }
        }
        if (FINAL) {
            const bf16_t* gp = proj + (size_t)(b * TSEQ + c * 128 + tt) * DP + 2560 + ch0 + e0; gr[0] = *(const u32x4*)gp; gr[1] = *(const u32x4*)(gp + 8);
            if (tid < 64) h0 = hin0g[(size_t)unit * 64 + tid];
        }
    };
    int it = BIDX();
    if (it < 1024) prefetch(it);
    for (; it < 1024; it += gridDim.x) {
        const int unit = it, c = unit & 15, jb = (unit >> 4) & 7, b = unit >> 7, row0 = b * TSEQ + c * 128, ch0 = 64 * jb;
        if ((unit & 127) != key) {
            key = unit & 127;
            { const int g = tid >> 8, e = (tid >> 2) & 63, sg = tid & 3; const bf16_t* src = WrT + (size_t)((g * 8 + jb) * 64 + e) * 64 + sg * 16;
              *(u32x4*)(wT + (g * 64 + e) * 72 + sg * 16) = *(const u32x4*)src; *(u32x4*)(wT + (g * 64 + e) * 72 + sg * 16 + 8) = *(const u32x4*)(src + 8); }
            { const int q = tid >> 6, e = tid & 63; float v;
              if (q < 4) v = p.cl_w[q * DLRU + ch0 + e]; else if (q == 4) v = p.cl_b[ch0 + e]; else if (q == 5) v = p.b_r[ch0 + e]; else if (q == 6) v = p.b_i[ch0 + e]; else v = spl[ch0 + e];
              cwL[q * 64 + e] = v; }
            LBAR();
        }
        {
            float accv[16];
#pragma unroll
            for (int i = 0; i < 4; ++i) { const f32x4 cb = *(const f32x4*)(cwL + 4 * 64 + e0 + 4 * i); accv[4 * i] = cb.x; accv[4 * i + 1] = cb.y; accv[4 * i + 2] = cb.z; accv[4 * i + 3] = cb.w; }
#pragma unroll
            for (int k = 0; k < 4; ++k) {
                float xv[16]; unpack8(xr[k][0], xv); unpack8(xr[k][1], xv + 8);
#pragma unroll
                for (int i = 0; i < 4; ++i) { const f32x4 cw = *(const f32x4*)(cwL + k * 64 + e0 + 4 * i);
                    accv[4 * i] += cw.x * xv[4 * i]; accv[4 * i + 1] += cw.y * xv[4 * i + 1]; accv[4 * i + 2] += cw.z * xv[4 * i + 2]; accv[4 * i + 3] += cw.w * xv[4 * i + 3]; }
            }
#pragma unroll
            for (int i = 0; i < 4; ++i) *(f32x4*)(xcf + tt * XP + e0 + 4 * i) = (f32x4){accv[4 * i], accv[4 * i + 1], accv[4 * i + 2], accv[4 * i + 3]};
            *(u32x4*)(xcb + tt * 72 + e0) = pack8(accv); *(u32x4*)(xcb + tt * 72 + e0 + 8) = pack8(accv + 8);
            if (FINAL) { *(u32x4*)(gbuf + tt * 64 + e0) = gr[0]; *(u32x4*)(gbuf + tt * 64 + e0 + 8) = gr[1]; }
        }
        const float h0u = h0;
        if (it + (int)gridDim.x < 1024) prefetch(it + gridDim.x);
        LBAR();
        {
            const int t = 16 * w + fr;
            bf16x8 xb[2];
#pragma unroll
            for (int kk = 0; kk < 2; ++kk) xb[kk] = *(const bf16x8*)(xcb + t * 72 + 32 * kk + 8 * fq);
            const bool first = (c == 0 && t == 0);
#pragma unroll
            for (int eb = 0; eb < 4; ++eb) {
                f32x4 ar = (f32x4){0.f, 0.f, 0.f, 0.f}, ai = (f32x4){0.f, 0.f, 0.f, 0.f};
#pragma unroll
                for (int kk = 0; kk < 2; ++kk) {
                    const bf16x8 wr_ = *(const bf16x8*)(wT + (16 * eb + fr) * 72 + 32 * kk + 8 * fq);
                    const bf16x8 wi_ = *(const bf16x8*)(wT + (64 + 16 * eb + fr) * 72 + 32 * kk + 8 * fq);
                    ar = __builtin_amdgcn_mfma_f32_16x16x32_bf16(wr_, xb[kk], ar, 0, 0, 0);
                    ai = __builtin_amdgcn_mfma_f32_16x16x32_bf16(wi_, xb[kk], ai, 0, 0, 0);
                }
                const int e = 16 * eb + 4 * fq;
                const f32x4 br = *(const f32x4*)(cwL + 5 * 64 + e), bi = *(const f32x4*)(cwL + 6 * 64 + e), sp = *(const f32x4*)(cwL + 7 * 64 + e);
                const f32x4 xc4 = *(const f32x4*)(xcf + t * XP + e);
                f32x4 av, bv;
#pragma unroll
                for (int r = 0; r < 4; ++r) {
                    const float rr = sigmoidf_(ar[r] + br[r]), ii = sigmoidf_(ai[r] + bi[r]);
                    const float la = -sp[r] * rr, a = fexp2(1.4426950408889634f * la), x2 = 2.f * la;
                    const float em = -x2 * (1.f + 0.5f * x2 * (1.f + (1.f / 3.f) * x2 * (1.f + 0.25f * x2 * (1.f + 0.2f * x2 * (1.f + (1.f / 6.f) * x2)))));
                    const float mult = first ? 1.f : __builtin_amdgcn_sqrtf(em);
                    av[r] = a; bv[r] = mult * ii * xc4[r];
                }
                *(f32x4*)(af + t * XP + e) = av; *(f32x4*)(xcf + t * XP + e) = bv;
            }
        }
        LBAR();
        const int e = tid & 63, seg = tid >> 6;
        {
            float A = 1.f, B = 0.f;
#pragma unroll
            for (int i = 0; i < 16; ++i) { const int t = seg * 16 + i; const float a = af[t * XP + e]; B = a * B + xcf[t * XP + e]; A *= a; }
            segA[seg * 64 + e] = A; segB[seg * 64 + e] = B;
        }
        LBAR();
        if (!FINAL) {
            if (tid < 64) {
                float A = 1.f, B = 0.f;
#pragma unroll
                for (int s = 0; s < 8; ++s) { const float a = segA[s * 64 + tid]; B = a * B + segB[s * 64 + tid]; A *= a; }
                agg[(size_t)unit * 128 + tid] = A; agg[(size_t)unit * 128 + 64 + tid] = B;
            }
        } else {
            if (tid < 64) {
                float hh = h0u;
#pragma unroll
                for (int s = 0; s < 8; ++s) { hin[s * 64 + tid] = hh; hh = segA[s * 64 + tid] * hh + segB[s * 64 + tid]; }
            }
            LBAR();
            float hh = hin[seg * 64 + e];
#pragma unroll
            for (int i = 0; i < 16; ++i) {
                const int t = seg * 16 + i;
                hh = af[t * XP + e] * hh + xcf[t * XP + e];
                gbuf[t * 64 + e] = f2bf(hh * geluf_(bf2f(gbuf[t * 64 + e])));
            }
            if (c == 15 && seg == 7) {
                p.out[O_LHP + b * 512 + ch0 + e] = hh;
#pragma unroll
                for (int k = 0; k < 3; ++k) p.out[O_LCP + (size_t)(b * 3 + k) * 512 + ch0 + e] = bf2f(proj[(size_t)(b * TSEQ + 2045 + k) * DP + 2048 + ch0 + e]);
            }
            LBAR();
            { bf16_t* op = mix + (size_t)(row0 + tt) * D + 512 + ch0 + e0; *(u32x4*)op = *(const u32x4*)(gbuf + tt * 64 + e0); *(u32x4*)(op + 8) = *(const u32x4*)(gbuf + tt * 64 + e0 + 8); }
        }
        LBAR();
    }
    __syncthreads();
}

DEV void phase_scan(const Params& p) {
    unsigned char* ws = p.ws;
    const float* KVT = (const float*)(ws + W_KVT); bf16_t* STg = (bf16_t*)(ws + W_H);
    const float* agg = (const float*)(ws + W_AGG); float* hin0g = (float*)(ws + W_HIN0);
    const int gt = BIDX() * 512 + TIDX(), GT = gridDim.x * 512;
    for (int gid = gt; gid < 32 * 4096; gid += GT) {
        const int bh = gid >> 12, idx = gid & 4095, dv = idx >> 5, dk0 = (idx & 31) * 4, h = bh & 3;
        const float cd = exp2f(gamma_log2(h) * 128.f);
        const float* src = KVT + (size_t)bh * 16 * 16384 + dv * 128 + dk0;
        f32x4 kv[16];
#pragma unroll
        for (int m = 0; m < 16; ++m) kv[m] = *(const f32x4*)(src + (size_t)m * 16384);
        f32x4 S = (f32x4){0.f, 0.f, 0.f, 0.f};
        bf16_t* dst = STg + (size_t)bh * 16 * 16384 + dv * 128 + dk0;
#pragma unroll
        for (int m = 0; m < 16; ++m) {
            u32x2 o; o.x = cvt_pk_bf16(S.x, S.y); o.y = cvt_pk_bf16(S.z, S.w);
            *(u32x2*)(dst + (size_t)m * 16384) = o;
            S = S * cd + kv[m];
        }
        float* rp = p.out + O_RETP + (size_t)bh * 16384 + dv;
        rp[(dk0 + 0) * 128] = S.x; rp[(dk0 + 1) * 128] = S.y; rp[(dk0 + 2) * 128] = S.z; rp[(dk0 + 3) * 128] = S.w;
    }
    for (int gid = gt; gid < 64 * 64; gid += GT) {
        const int bjb = gid >> 6, e = gid & 63;
        float A[16], B[16];
#pragma unroll
        for (int c = 0; c < 16; ++c) { A[c] = agg[(size_t)(bjb * 16 + c) * 128 + e]; B[c] = agg[(size_t)(bjb * 16 + c) * 128 + 64 + e]; }
        float hh = 0.f;
#pragma unroll
        for (int c = 0; c < 16; ++c) { hin0g[(size_t)(bjb * 16 + c) * 64 + e] = hh; hh = A[c] * hh + B[c]; }
    }
}

DEV void sample_ret2(const Params& p, int unit) {
    unsigned char* ws = p.ws;
    const float* projS = (const float*)(ws + W_PROJS); const float* rope = (const float*)(ws + W_ROPE) + (size_t)TSEQ * 128; bf16_t* mix = (bf16_t*)(ws + W_MIX);
    const int h = unit & 3, b = unit >> 2, tid = TIDX();
    float* qs = (float*)shm_raw; float* ks = qs + 128; float* vs = ks + 128; float* part = vs + 128;
    float* red = part + 16 * 128;
    const float* pr = projS + (size_t)b * DP;
    const float gam = 1.f - exp2f(-5.f - (float)h);
    if (tid < 64) {
        const float c = rope[tid], s = rope[64 + tid];
        const float q1 = pr[h * 128 + tid], q2 = pr[h * 128 + 64 + tid], k1 = pr[512 + h * 128 + tid], k2 = pr[512 + h * 128 + 64 + tid];
        const float qa = q1 * c - q2 * s, qb = q1 * s + q2 * c, ka = (k1 * c - k2 * s) * 0.08838834764831845f, kb = (k1 * s + k2 * c) * 0.08838834764831845f;
        qs[tid] = qa; qs[64 + tid] = qb; ks[tid] = ka; ks[64 + tid] = kb;
        const float qkp = wave_sum(qa * ka + qb * kb);
        if (tid == 0) red[4] = qkp;
    } else if (tid < 192) vs[tid - 64] = pr[1024 + h * 128 + tid - 64];
    __syncthreads();
    {
        const int dv4 = (tid & 31) * 4, dkg = tid >> 5;
        const f32x4 v4 = *(const f32x4*)(vs + dv4);
        const float* S0 = p.st_ret + (size_t)unit * 16384; float* S1 = p.out + O_RETS + (size_t)unit * 16384;
        f32x4 po = (f32x4){0.f, 0.f, 0.f, 0.f};
#pragma unroll
        for (int i = 0; i < 8; ++i) {
            const int dk = dkg * 8 + i;
            const f32x4 s0 = *(const f32x4*)(S0 + dk * 128 + dv4);
            *(f32x4*)(S1 + dk * 128 + dv4) = s0 * gam + ks[dk] * v4;
            po = po + qs[dk] * s0;
        }
        *(f32x4*)(part + dkg * 128 + dv4) = po;
    }
    __syncthreads();
    float o = 0.f;
    if (tid < 128) {
        const float qk = red[4];
#pragma unroll
        for (int g = 0; g < 16; ++g) o += part[g * 128 + tid];
        o = qk * vs[tid] + gam * o;
        const float s1 = wave_sum(o);
        if ((tid & 63) == 0) red[tid >> 6] = s1;
    }
    __syncthreads();
    float mu = 0.f, dlt = 0.f;
    if (tid < 128) {
        mu = (red[0] + red[1]) * (1.f / 128.f); dlt = o - mu;
        const float s2 = wave_sum(dlt * dlt);
        if ((tid & 63) == 0) red[2 + (tid >> 6)] = s2;
    }
    __syncthreads();
    if (tid < 128) {
        const float rstd = __builtin_amdgcn_rsqf((red[2] + red[3]) * (1.f / 128.f) + EPS);
        const float g = pr[1536 + h * 128 + tid];
        mix[(size_t)(NTOK + b) * D + h * 128 + tid] = f2bf(dlt * rstd * siluf_(g));
    }
    __syncthreads();
}

DEV void sample_lru(const Params& p, int b) {
    unsigned char* ws = p.ws;
    const float* projS = (const float*)(ws + W_PROJS); bf16_t* mix = (bf16_t*)(ws + W_MIX); const float* spl = (const float*)(ws + W_SPL);
    float* xcS = (float*)shm_raw;
    const int ch = TIDX();
    const float* pr = projS + (size_t)b * DP;
    const float s0 = p.st_cl[(size_t)(b * 3 + 0) * 512 + ch], s1 = p.st_cl[(size_t)(b * 3 + 1) * 512 + ch], s2 = p.st_cl[(size_t)(b * 3 + 2) * 512 + ch], x = pr[2048 + ch];
    const float xc = p.cl_b[ch] + p.cl_w[ch] * s0 + p.cl_w[512 + ch] * s1 + p.cl_w[1024 + ch] * s2 + p.cl_w[1536 + ch] * x;
    xcS[ch] = xc;
    __syncthreads();
    const int jb = ch >> 6, e = ch & 63;
    float pr_ = 0.f, pi_ = 0.f;
    const float* wr = p.w_r + (size_t)jb * 4096 + e; const float* wi = p.w_i + (size_t)jb * 4096 + e;
#pragma unroll 8
    for (int d = 0; d < 64; ++d) { const float xv = xcS[64 * jb + d]; pr_ += xv * wr[d * 64]; pi_ += xv * wi[d * 64]; }
    const float rr = sigmoidf_(pr_ + p.b_r[ch]), ii = sigmoidf_(pi_ + p.b_i[ch]);
    const float la = -spl[ch] * rr, a = __expf(la), mult = sqrtf(-expm1f(2.f * la));
    const float hh = a * p.st_h[(size_t)b * 512 + ch] + mult * ii * xc;
    p.out[O_LHS + (size_t)b * 512 + ch] = hh;
    p.out[O_LCS + (size_t)(b * 3 + 0) * 512 + ch] = s1; p.out[O_LCS + (size_t)(b * 3 + 1) * 512 + ch] = s2; p.out[O_LCS + (size_t)(b * 3 + 2) * 512 + ch] = x;
    mix[(size_t)(NTOK + b) * D + 512 + ch] = f2bf(hh * geluf_(pr[2560 + ch]));
    __syncthreads();
}

DEV void phase_mixA(const Params& p) {
    constexpr int N1 = 512, N3 = 512, N4 = 128;
    {
        const float* mod = (const float*)(p.ws + W_MOD); bf16_t* shf = (bf16_t*)(p.ws + W_SHF);
        const int gt = BIDX() * 512 + TIDX(), GT = gridDim.x * 512;
        for (int i = gt; i < NMODROWS * D; i += GT) { const int row = i >> 10, k = i & 1023; shf[i] = f2bf(row < 136 ? mod[(size_t)row * 6144 + 3 * D + k] : 0.f); }
    }
    lru_phase<false>(p);
    for (int it = BIDX(); it < N1 + N3 + N4; it += gridDim.x) {
        if (it < N1) ret_passA(p, it);
        else if (it < N1 + N3) sample_ret2(p, it - N1);
        else sample_lru(p, it - N1 - N3);
    }
}
DEV void phase_mixC(const Params& p) {
    constexpr int N1 = 512;
    lru_phase<true>(p);
    for (int it = BIDX(); it < N1; it += gridDim.x) {
        { const int u = it; const int n = u & 15; const int nn = (((u >> 4) ^ (u >> 8)) & 1) ? 15 - n : n; ret_passC(p, (u & ~15) | nn); }
    }
}

DEV void phase_outproj(const Params& p) {
    unsigned char* ws = p.ws;
    const bf16_t* mix = (const bf16_t*)(ws + W_MIX); const bf16_t* BtOut = (const bf16_t*)(ws + W_BTOUT); bf16_t* xs = (bf16_t*)(ws + W_H);
    const float* mod = (const float*)(ws + W_MOD); float* rss1 = (float*)(ws + W_RSS1);
    constexpr int NBIG = 64 * 4;
    gemm_phase<false>(mix, BtOut, D, 64, 4, NBIG, nullptr, [&](const f32x4 (&acc)[2][2][4][2], int pm, int pn, int brow, int bcol, int wr, int wc, int fr, int fq) {
                const int b = brow >> 11;
                const float* mrow = mod + (size_t)b * 6144;
                f32x4 gt[2][2], sf[2][2];
#pragma unroll
                for (int bj = 0; bj < 2; ++bj)
#pragma unroll
                    for (int n = 0; n < 2; ++n) {
                        const int col = bcol + bj * HALF + wc * 32 + 8 * fq + 4 * n;
                        gt[bj][n] = *(const f32x4*)(mrow + 2 * D + col);
                        sf[bj][n] = *(const f32x4*)(p.g_ffn + col) * (1.f + *(const f32x4*)(mrow + 4 * D + col));
                    }
#pragma unroll
                for (int ai = 0; ai < 2; ++ai)
#pragma unroll
                    for (int m = 0; m < 4; ++m) {
                        const int row = brow + ai * HALF + wr * 64 + m * 16 + fr;
                        float ss = 0.f;
#pragma unroll
                        for (int bj = 0; bj < 2; ++bj) {
                            const int col = bcol + bj * HALF + wc * 32 + 8 * fq;
                            f32x4 y[2];
#pragma unroll
                            for (int n = 0; n < 2; ++n) {
                                y[n] = *(const f32x4*)(p.x_p + (size_t)row * D + col + 4 * n) + gt[bj][n] * acc[ai][bj][m][n];
                                ss += (y[n].x * y[n].x + y[n].y * y[n].y) + (y[n].z * y[n].z + y[n].w * y[n].w);
                                y[n] = y[n] * sf[bj][n];
                            }
                            u32x4 w; w.x = cvt_pk_bf16(y[0].x, y[0].y); w.y = cvt_pk_bf16(y[0].z, y[0].w); w.z = cvt_pk_bf16(y[1].x, y[1].y); w.w = cvt_pk_bf16(y[1].z, y[1].w);
                            *(u32x4*)(xs + (size_t)row * D + col) = w;
                        }
                        ss += __shfl_xor(ss, 16); ss += __shfl_xor(ss, 32);
                        if (fq == 0) atomicAdd(rss1 + row, ss);
                    }
            });
    const bf16_t* BtUp = (const bf16_t*)(ws + W_BTUP); const bf16_t* shf = (const bf16_t*)(ws + W_SHF); float* sW = (float*)(ws + W_SW);
    SKINNY_LOOP(j, NBIG, 64 + 176) {
        if (j < 64) {
            const int g = j >> 1, n = j & 1;
            const bf16_t* B0 = BtOut + (size_t)(32 * g + 16 * n) * D;
            skinny_tile<8, 1, 4>(mix + (size_t)NTOK * D, D, B0, B0, D, [&](int row, int s, float v0, float v1) {
                const float* mrow = mod + (size_t)(8 + row) * 6144;
                const int c0 = 32 * g + slotcol(n, s);
                const float y0 = p.x_s[(size_t)row * D + c0] + mrow[2 * D + c0] * v0;
                p.out[O_YS + (size_t)row * D + c0] = y0;
                xs[(size_t)(NTOK + row) * D + c0] = f2bf(y0 * p.g_ffn[c0] * (1.f + mrow[4 * D + c0]));
                return y0 * y0;
            }, [&](int row, float ss) { atomicAdd(rss1 + NTOK + row, ss); });
        } else {
            const int t = j - 64, pn = t >> 3, bj = (t >> 2) & 1, g4 = t & 3;
            const bf16_t* B0 = BtUp + (size_t)(256 * pn + 128 * bj + 32 * g4) * D;
            skinny_tile<9, 2, 4>(shf, D, B0, B0 + 16 * D, D, [&](int row, int s, float v0, float v1) {
                const int c0 = bj * DFF + 128 * pn + 32 * g4 + slotcol(0, s); sW[(size_t)row * (2 * DFF) + c0] = v0; sW[(size_t)row * (2 * DFF) + c0 + 4] = v1; return 0.f;
            });
        }
    }
}

DEV void phase_up(const Params& p) {
    unsigned char* ws = p.ws;
    const bf16_t* xs = (const bf16_t*)(ws + W_H); const bf16_t* BtUp = (const bf16_t*)(ws + W_BTUP); bf16_t* fin = (bf16_t*)(ws + W_PROJ);
    const float* sW = (const float*)(ws + W_SW); const float* rss1 = (const float*)(ws + W_RSS1);
    float* edgeU = (float*)(ws + W_EDGEU); float* edgeG = (float*)(ws + W_EDGEG); float* tailU = (float*)(ws + W_TAILU);
    constexpr int NBIG = 64 * 22, NSK = 176;
    gemm_phase<false>(xs, BtUp, D, 64, 22, NBIG, nullptr, [&](f32x4 (&acc)[2][2][4][2], int pm, int pn, int brow, int bcol, int wr, int wc, int fr, int fq) {
        float* halo = (float*)(shm_raw + 131072);
        const int b = brow >> 11;
        const int ff0 = 128 * pn + wc * 32 + 8 * fq;
        const int cl0 = wc * 32 + 8 * fq;
        {
            f32x4 swc[2], swg[2];
#pragma unroll
            for (int n = 0; n < 2; ++n) { swc[n] = *(const f32x4*)(sW + (size_t)b * (2 * DFF) + ff0 + 4 * n); swg[n] = *(const f32x4*)(sW + (size_t)b * (2 * DFF) + DFF + ff0 + 4 * n); }
#pragma unroll
            for (int ai = 0; ai < 2; ++ai)
#pragma unroll
                for (int m = 0; m < 4; ++m) {
                    const int rl = ai * HALF + wr * 64 + m * 16 + fr;
                    const float rstd = __builtin_amdgcn_rsqf(rss1[brow + rl] * (1.f / D) + EPS);
#pragma unroll
                    for (int n = 0; n < 2; ++n) { acc[ai][0][m][n] = acc[ai][0][m][n] * rstd + swc[n]; acc[ai][1][m][n] = acc[ai][1][m][n] * rstd + swg[n]; }
                }
        }
        if (fr >= 14) {
#pragma unroll
            for (int ai = 0; ai < 2; ++ai)
#pragma unroll
                for (int n = 0; n < 2; ++n) *(f32x4*)(halo + ((ai * 2 + wr) * 2 + fr - 14) * 128 + cl0 + 4 * n) = acc[ai][0][3][n];
        }
        __syncthreads();
        {
            f32x4 cw0[2], cw1[2], cw2[2], cb[2];
#pragma unroll
            for (int n = 0; n < 2; ++n) {
                cw0[n] = *(const f32x4*)(p.cf_w + ff0 + 4 * n); cw1[n] = *(const f32x4*)(p.cf_w + DFF + ff0 + 4 * n); cw2[n] = *(const f32x4*)(p.cf_w + 2 * DFF + ff0 + 4 * n);
                cb[n] = *(const f32x4*)(p.cf_b + ff0 + 4 * n);
            }
#pragma unroll
            for (int ai = 0; ai < 2; ++ai) {
                const int st = ai * 2 + wr;
                f32x4 um1[2];
#pragma unroll
                for (int n = 0; n < 2; ++n) {
                    um1[n] = (f32x4){0.f, 0.f, 0.f, 0.f};
                    if (st > 0 && fr >= 14) um1[n] = *(const f32x4*)(halo + ((st - 1) * 2 + fr - 14) * 128 + cl0 + 4 * n);
                }
#pragma unroll
                for (int m = 0; m < 4; ++m) {
                    const int rl = ai * HALF + wr * 64 + m * 16 + fr;
                    unsigned wv[4];
#pragma unroll
                    for (int n = 0; n < 2; ++n) {
                        const f32x4 u = acc[ai][0][m][n], g = acc[ai][1][m][n];
                        f32x4 p1, p2;
#pragma unroll
                        for (int c = 0; c < 4; ++c) { p1[c] = dpp_shr1(dpp_ror1(um1[n][c]), u[c]); p2[c] = dpp_shr2(dpp_ror2(um1[n][c]), u[c]); }
                        const f32x4 uc = cb[n] + cw0[n] * p2 + cw1[n] * p1 + cw2[n] * u;
                        wv[2 * n] = cvt_pk_bf16(geluf_(uc.x) * g.x, geluf_(uc.y) * g.y); wv[2 * n + 1] = cvt_pk_bf16(geluf_(uc.z) * g.z, geluf_(uc.w) * g.w);
                        um1[n] = u;
                    }
                    if (rl >= 2) {
                        u32x4 w; w.x = wv[0]; w.y = wv[1]; w.z = wv[2]; w.w = wv[3];
                        *(u32x4*)(fin + (size_t)(brow + rl) * DFF + ff0) = w;
                    } else {
#pragma unroll
                        for (int n = 0; n < 2; ++n) {
                            *(f32x4*)(edgeU + (size_t)(pm * 2 + rl) * DFF + ff0 + 4 * n) = acc[ai][0][m][n];
                            *(f32x4*)(edgeG + (size_t)(pm * 2 + rl) * DFF + ff0 + 4 * n) = acc[ai][1][m][n];
                        }
                    }
                    if (rl >= 254) {
#pragma unroll
                        for (int n = 0; n < 2; ++n) {
                            *(f32x4*)(tailU + (size_t)(pm * 2 + rl - 254) * DFF + ff0 + 4 * n) = acc[ai][0][m][n];
                            if ((pm & 7) == 7) *(f32x4*)(p.out + O_FCP + (size_t)(b * 2 + rl - 254) * DFF + ff0 + 4 * n) = acc[ai][0][m][n];
                        }
                    }
                }
            }
        }
    });
    SKINNY_LOOP(j, NBIG, NSK) {
            const int t = j, pn = t >> 3, g4 = (t >> 1) & 3, n = t & 1;
            const bf16_t* B0 = BtUp + (size_t)(256 * pn + 32 * g4 + 16 * n) * D;
            skinny_tile<8, 2, 4>(xs + (size_t)NTOK * D, D, B0, B0 + 128 * D, D, [&](int row, int s, float v0, float v1) {
                const int ff = 128 * pn + 32 * g4 + slotcol(n, s);
                const float rstd = __builtin_amdgcn_rsqf(rss1[NTOK + row] * (1.f / D) + EPS);
                const float u = v0 * rstd + sW[(size_t)(8 + row) * (2 * DFF) + ff], g = v1 * rstd + sW[(size_t)(8 + row) * (2 * DFF) + DFF + ff];
                const float s0 = p.st_cf[(size_t)(row * 2 + 0) * DFF + ff], s1 = p.st_cf[(size_t)(row * 2 + 1) * DFF + ff];
                const float uc = p.cf_b[ff] + p.cf_w[ff] * s0 + p.cf_w[DFF + ff] * s1 + p.cf_w[2 * DFF + ff] * u;
                fin[(size_t)(NTOK + row) * DFF + ff] = f2bf(geluf_(uc) * g);
                p.out[O_FCS + (size_t)(row * 2 + 0) * DFF + ff] = s1; p.out[O_FCS + (size_t)(row * 2 + 1) * DFF + ff] = u; return 0.f;
            });
    }
}

DEV void phase_down(const Params& p) {
    unsigned char* ws = p.ws;
    const bf16_t* fin = (const bf16_t*)(ws + W_PROJ); const bf16_t* BtDown = (const bf16_t*)(ws + W_BTDOWN);
    const float* mod = (const float*)(ws + W_MOD); float* rss2 = (float*)(ws + W_RSS2);
    const float* edgeU = (const float*)(ws + W_EDGEU); const float* edgeG = (const float*)(ws + W_EDGEG); const float* tailU = (const float*)(ws + W_TAILU);
    constexpr int NBIG = 64 * 4;
    for (int it = BIDX(); it < NBIG; it += gridDim.x) {
        int pm, pn; tile_order(it, 64, 4, pm, pn);
        bf16_t* fix = (bf16_t*)(ws + W_FIX) + (size_t)it * 2 * DFF;
            {
                const bool hp = (pm & 7) != 0;
                for (int i = TIDX(); i < DFF / 4; i += 512) {
                    const int ff = 4 * i;
                    const f32x4 z = (f32x4){0.f, 0.f, 0.f, 0.f};
                    const f32x4 um1 = hp ? *(const f32x4*)(tailU + (size_t)((pm - 1) * 2 + 1) * DFF + ff) : z, um2 = hp ? *(const f32x4*)(tailU + (size_t)((pm - 1) * 2 + 0) * DFF + ff) : z;
                    const f32x4 u0 = *(const f32x4*)(edgeU + (size_t)(pm * 2) * DFF + ff), u1 = *(const f32x4*)(edgeU + (size_t)(pm * 2 + 1) * DFF + ff);
                    const f32x4 g0 = *(const f32x4*)(edgeG + (size_t)(pm * 2) * DFF + ff), g1 = *(const f32x4*)(edgeG + (size_t)(pm * 2 + 1) * DFF + ff);
                    const f32x4 cb = *(const f32x4*)(p.cf_b + ff), w0 = *(const f32x4*)(p.cf_w + ff), w1 = *(const f32x4*)(p.cf_w + DFF + ff), w2 = *(const f32x4*)(p.cf_w + 2 * DFF + ff);
                    const f32x4 c0 = cb + w0 * um2 + w1 * um1 + w2 * u0, c1 = cb + w0 * um1 + w1 * u0 + w2 * u1;
                    u32x2 o0, o1;
                    o0.x = cvt_pk_bf16(geluf_(c0.x) * g0.x, geluf_(c0.y) * g0.y); o0.y = cvt_pk_bf16(geluf_(c0.z) * g0.z, geluf_(c0.w) * g0.w);
                    o1.x = cvt_pk_bf16(geluf_(c1.x) * g1.x, geluf_(c1.y) * g1.y); o1.y = cvt_pk_bf16(geluf_(c1.z) * g1.z, geluf_(c1.w) * g1.w);
                    *(u32x2*)(fix + ff) = o0; *(u32x2*)(fix + DFF + ff) = o1;
                }
            }
    }
    asm volatile("s_waitcnt vmcnt(0)" ::: "memory");
    __syncthreads();
    gemm_phase<true>(fin, BtDown, DFF, 64, 4, NBIG, (const bf16_t*)(ws + W_FIX), [&](f32x4 (&acc)[2][2][4][2], int pm, int pn, int brow, int bcol, int wr, int wc, int fr, int fq) {
        const int b = brow >> 11;
        const float* mrow = mod + (size_t)b * 6144;
        const bf16_t* xs = (const bf16_t*)(ws + W_H);
        const bool fuse = (gridDim.x == 256);
        unsigned* cnt = (unsigned*)(ws + W_BAR) + 3456 + 64 * pm;
        {
            f32x4 gt[2][2], isf[2][2];
#pragma unroll
            for (int bj = 0; bj < 2; ++bj)
#pragma unroll
                for (int n = 0; n < 2; ++n) {
                    const int col = bcol + bj * HALF + wc * 32 + 8 * fq + 4 * n;
                    gt[bj][n] = *(const f32x4*)(mrow + 5 * D + col);
                    const f32x4 sf = *(const f32x4*)(p.g_ffn + col) * (1.f + *(const f32x4*)(mrow + 4 * D + col));
                    isf[bj][n] = (f32x4){__builtin_amdgcn_rcpf(sf.x), __builtin_amdgcn_rcpf(sf.y), __builtin_amdgcn_rcpf(sf.z), __builtin_amdgcn_rcpf(sf.w)};
                }
#pragma unroll
            for (int ai = 0; ai < 2; ++ai)
#pragma unroll
                for (int m = 0; m < 4; ++m) {
                    const int row = brow + ai * HALF + wr * 64 + m * 16 + fr;
                    float ss = 0.f;
#pragma unroll
                    for (int bj = 0; bj < 2; ++bj) {
                        const int col = bcol + bj * HALF + wc * 32 + 8 * fq;
                        float xv[8]; unpack8(*(const u32x4*)(xs + (size_t)row * D + col), xv);
#pragma unroll
                        for (int n = 0; n < 2; ++n) {
                            const f32x4 x1 = (f32x4){xv[4 * n], xv[4 * n + 1], xv[4 * n + 2], xv[4 * n + 3]} * isf[bj][n];
                            const f32x4 y = x1 + gt[bj][n] * acc[ai][bj][m][n];
                            acc[ai][bj][m][n] = y;
                            ss += (y.x * y.x + y.y * y.y) + (y.z * y.z + y.w * y.w);
                        }
                    }
                    ss += __shfl_xor(ss, 16); ss += __shfl_xor(ss, 32);
                    if (fq == 0) atomicAdd(rss2 + row, ss);
                }
        }
        asm volatile("s_waitcnt vmcnt(0)" ::: "memory");
        __syncthreads();
        if (fuse && TIDX() == 0) {
            __hip_atomic_fetch_add(cnt, 1u, __ATOMIC_RELAXED, __HIP_MEMORY_SCOPE_AGENT);
            unsigned sp = 0;
            while (__hip_atomic_load(cnt, __ATOMIC_RELAXED, __HIP_MEMORY_SCOPE_AGENT) < 4u) { __builtin_amdgcn_s_sleep(2); if (++sp > (1u << 22)) break; }
        }
        __syncthreads();
        {
            f32x4 gf[2][2];
#pragma unroll
            for (int bj = 0; bj < 2; ++bj)
#pragma unroll
                for (int n = 0; n < 2; ++n) gf[bj][n] = *(const f32x4*)(p.g_final + bcol + bj * HALF + wc * 32 + 8 * fq + 4 * n);
            float tot[2][4];
#pragma unroll
            for (int ai = 0; ai < 2; ++ai)
#pragma unroll
                for (int m = 0; m < 4; ++m) tot[ai][m] = fuse ? __hip_atomic_load(rss2 + brow + ai * HALF + wr * 64 + m * 16 + fr, __ATOMIC_RELAXED, __HIP_MEMORY_SCOPE_AGENT) : 0.f;
#pragma unroll
            for (int ai = 0; ai < 2; ++ai)
#pragma unroll
                for (int m = 0; m < 4; ++m) {
                    const int row = brow + ai * HALF + wr * 64 + m * 16 + fr;
                    const float rstd = fuse ? __builtin_amdgcn_rsqf(tot[ai][m] * (1.f / D) + EPS) : 1.f;
#pragma unroll
                    for (int bj = 0; bj < 2; ++bj)
#pragma unroll
                        for (int n = 0; n < 2; ++n)
                            *(f32x4*)(p.out + O_YP + (size_t)row * D + bcol + bj * HALF + wc * 32 + 8 * fq + 4 * n) = fuse ? acc[ai][bj][m][n] * rstd * gf[bj][n] : acc[ai][bj][m][n];
                }
        }
    });
    for (int j = BIDX(); j < 32 * 11; j += gridDim.x) {
        const int g = j / 11, ksl = j - g * 11;
        const bf16_t* B0 = BtDown + (size_t)(32 * g) * DFF + ksl * 256;
        float* part = (float*)(ws + W_KVT) + (size_t)ksl * NSMP * D;
        skinny_tile<8, 2, 2>(fin + (size_t)NTOK * DFF + ksl * 256, DFF, B0, B0 + 16 * DFF, 256, [&](int row, int s, float v0, float v1) {
            const int c0 = 32 * g + slotcol(0, s);
            part[(size_t)row * D + c0] = v0; part[(size_t)row * D + c0 + 4] = v1; return 0.f;
        }, NoRowFn(), DFF);
    }
}

DEV void phase_final(const Params& p) {
    const float* rss2 = (const float*)(p.ws + W_RSS2);
    const int gt = BIDX() * 512 + TIDX(), GT = gridDim.x * 512;
    if (gridDim.x != 256)
    for (int i = gt; i < NTOK * 256; i += GT) {
        const int row = i >> 8, k = (i & 255) * 4;
        const float rstd = __builtin_amdgcn_rsqf(rss2[row] * (1.f / D) + EPS);
        f32x4* yp = (f32x4*)(p.out + (size_t)row * D + k);
        *yp = *yp * rstd * *(const f32x4*)(p.g_final + k);
    }
    const float* part = (const float*)(p.ws + W_KVT); const float* mod = (const float*)(p.ws + W_MOD);
    const int lane = TIDX() & 63, gw = BIDX() * 8 + (TIDX() >> 6), NGW = gridDim.x * 8;
    for (int row = gw; row < NSMP; row += NGW) {
        float* yp = p.out + O_YS + (size_t)row * D; const float* mrow = mod + (size_t)(8 + row) * 6144 + 5 * D;
        f32x4 y[4]; float ss = 0.f;
#pragma unroll
        for (int j = 0; j < 4; ++j) {
            const int k = 4 * lane + 256 * j;
            f32x4 a = (f32x4){0.f, 0.f, 0.f, 0.f};
#pragma unroll
            for (int sl = 0; sl < 11; ++sl) a = a + *(const f32x4*)(part + ((size_t)sl * NSMP + row) * D + k);
            y[j] = *(const f32x4*)(yp + k) + *(const f32x4*)(mrow + k) * a;
            ss += y[j].x * y[j].x + y[j].y * y[j].y + y[j].z * y[j].z + y[j].w * y[j].w;
        }
        const float rstd = __builtin_amdgcn_rsqf(wave_sum(ss) * (1.f / D) + EPS);
#pragma unroll
        for (int j = 0; j < 4; ++j) { const int k = 4 * lane + 256 * j; *(f32x4*)(yp + k) = y[j] * rstd * *(const f32x4*)(p.g_final + k); }
    }
}

#define XB_TMO      128
#define XB_XCNT(j)  (256  + 64 * (j))
#define XB_XSUB(j)  (1280 + 64 * (j))
#define XB_XGEN(j)  (2304 + 64 * (j))
#define XB_TOP      3328
#define XB_TOPGEN   3392
#define XCD_BAR_WORDS 3456
#define XB_SPIN_CAP (1u << 20)
DEV unsigned xb_ld(unsigned* p) { return __hip_atomic_load(p, __ATOMIC_RELAXED, __HIP_MEMORY_SCOPE_AGENT); }
DEV unsigned xb_add(unsigned* p, unsigned v) { return __hip_atomic_fetch_add(p, v, __ATOMIC_RELAXED, __HIP_MEMORY_SCOPE_AGENT); }
DEV unsigned xb_xcc_id() { return (unsigned)__builtin_amdgcn_s_getreg((3 << 11) | 20) & 0xFu; }
#define XB_SPIN(cond, bar) do { unsigned _sp = 0; while (cond) { __builtin_amdgcn_s_sleep(1); \
    if ((++_sp & 255u) == 0u) { if (xb_ld(&(bar)[XB_TMO])) break; if (_sp > XB_SPIN_CAP) { atomicAdd(&(bar)[XB_TMO], 1u); break; } } } } while (0)
struct XcdBarrier { unsigned* bar; unsigned x; volatile LAS unsigned* st; };
DEV XcdBarrier xcd_barrier_post(unsigned* bar, volatile LAS unsigned* st) {
    XcdBarrier b; b.bar = bar; b.x = xb_xcc_id(); b.st = st;
    if (threadIdx.x == 0) (void)xb_add(&bar[XB_XCNT(b.x)], 1u);
    return b;
}
DEV void xcd_barrier_complete(unsigned* bar, unsigned x, unsigned& nloc, unsigned& nx) {
    const unsigned G = gridDim.x * gridDim.y * gridDim.z;
    unsigned sum, cnt, mine, sp = 0u;
    for (;;) {
        sum = 0u; cnt = 0u; mine = 0u;
#pragma unroll
        for (unsigned j = 0; j < 16; ++j) { const unsigned c = xb_ld(&bar[XB_XCNT(j)]); sum += c; cnt += (c > 0u) ? 1u : 0u; mine = (j == x) ? c : mine; }
        if (sum == G) break;
        __builtin_amdgcn_s_sleep(1);
        if ((++sp & 255u) == 0u) { if (xb_ld(&bar[XB_TMO])) break; if (sp > XB_SPIN_CAP) { atomicAdd(&bar[XB_TMO], 1u); break; } }
    }
    nloc = mine > 0u ? mine : 1u; nx = cnt > 0u ? cnt : 1u;
}
DEV void xcd_barrier(const XcdBarrier& b) {
    asm volatile("s_waitcnt vmcnt(0)" ::: "memory");
    __syncthreads();
    if (threadIdx.x == 0) {
        unsigned* bar = b.bar;
        __builtin_amdgcn_s_waitcnt(0);
        unsigned nloc = b.st[0], nx = b.st[1];
        if (nloc == 0u) { xcd_barrier_complete(bar, b.x, nloc, nx); b.st[0] = nloc; b.st[1] = nx; }
        const unsigned old = xb_add(&bar[XB_XSUB(b.x)], 1u);
        const unsigned gen = old / nloc;
        if (old + 1u == (gen + 1u) * nloc) {
            __builtin_amdgcn_fence(__ATOMIC_RELEASE, "agent");
            asm volatile("s_waitcnt vmcnt(0)" ::: "memory");
            const unsigned og = xb_add(&bar[XB_TOP], 1u);
            const unsigned tg = og / nx;
            if (og + 1u == (tg + 1u) * nx) xb_add(&bar[XB_TOPGEN], 1u);
            else XB_SPIN(xb_ld(&bar[XB_TOPGEN]) == tg, bar);
            __builtin_amdgcn_fence(__ATOMIC_ACQUIRE, "agent");
            xb_add(&bar[XB_XGEN(b.x)], 1u);
            asm volatile("s_waitcnt vmcnt(0)" ::: "memory");
        } else {
            XB_SPIN(xb_ld(&bar[XB_XGEN(b.x)]) == gen, bar);
            __builtin_amdgcn_fence(__ATOMIC_ACQUIRE, "agent");
            asm volatile("s_waitcnt vmcnt(0)" ::: "memory");
        }
    }
    __syncthreads();
}

typedef const unsigned long long __attribute__((address_space(4)))* KWordPtr;
DEV Params kparams() {
    KWordPtr k = (KWordPtr)__builtin_amdgcn_kernarg_segment_ptr(); asm volatile("" : "+s"(k));
    Params q; unsigned long long* d = (unsigned long long*)&q;
#pragma unroll
    for (int i = 0; i < (int)(sizeof(Params) / 8); ++i) d[i] = k[i];
    return q;
}
__global__ void __launch_bounds__(512) fwd_kernel(Params p) {
    cg::grid_group grid = cg::this_grid();
    volatile LAS unsigned* xst = (volatile LAS unsigned*)((LAS unsigned char*)shm_raw + (LDS_BYTES - 16));
    if (threadIdx.x == 0) { xst[0] = 0u; xst[1] = 0u; }
    __syncthreads();
    const XcdBarrier xb = xcd_barrier_post((unsigned*)(p.ws + W_BAR), xst);
    const int lo = (int)p.ph_lo, hi = (int)p.ph_hi;
    if (hi < 0) grid.sync();
#ifdef ONLY_PHASE
#define RUNP(si, ph, call) if (ph == ONLY_PHASE) { const Params q = kparams(); call(q); }
#else
#define RUNP(si, ph, call) if (lo <= si && si < hi) { { const Params q = kparams(); call(q); } if (si + 1 < hi) { xcd_barrier(xb); } }
#endif
    RUNP(0, 0, phase_prep)
    RUNP(1, 1, phase_mod)
    RUNP(2, 2, phase_norm1)
    RUNP(3, 3, phase_inproj)
    RUNP(4, 4, phase_mixA)
    RUNP(5, 10, phase_scan)
    RUNP(6, 5, phase_mixC)
    RUNP(7, 6, phase_outproj)
    RUNP(8, 7, phase_up)
    RUNP(9, 8, phase_down)
    RUNP(10, 9, phase_final)
}

extern "C" void kernel_launch(void* const* d_in, const int* in_sizes, int n_in, void* d_out, int out_size, void* d_ws, size_t ws_size, hipStream_t stream) {
    static int grid_blocks = 0;
    if (grid_blocks == 0) {
        if (n_in != 27 || ws_size < W_END) { fprintf(stderr, "kernel_launch: unexpected n_in %d or ws_size %zu (< %zu)\n", n_in, ws_size, (size_t)W_END); grid_blocks = -1; return; }
        int dev = 0, cus = 0, per_cu = 0;
        hipGetDevice(&dev);
        hipDeviceGetAttribute(&cus, hipDeviceAttributeMultiprocessorCount, dev);
        if (hipFuncSetAttribute((const void*)fwd_kernel, hipFuncAttributeMaxDynamicSharedMemorySize, LDS_BYTES) != hipSuccess) { fprintf(stderr, "kernel_launch: hipFuncSetAttribute failed\n"); grid_blocks = -1; return; }
        if (hipOccupancyMaxActiveBlocksPerMultiprocessor(&per_cu, (const void*)fwd_kernel, 512, LDS_BYTES) != hipSuccess || per_cu < 1) { fprintf(stderr, "kernel_launch: occupancy query failed (%d)\n", per_cu); (void)hipGetLastError(); per_cu = 1; }
        grid_blocks = cus * 1;
    }
    if (grid_blocks < 0) return;
    Params p{};
    const float** pp = (const float**)&p;
    for (int i = 0; i < 27; ++i) pp[i] = (const float*)d_in[i];
    p.out = (float*)d_out; p.ws = (unsigned char*)d_ws;
    if (hipMemsetAsync((char*)d_ws + W_BAR, 0, (size_t)BAR_WORDS * 4, stream) != hipSuccess) { fprintf(stderr, "kernel_launch: memset failed\n"); return; }
#if MK_MULTI
    for (int ph = 0; ph < 11; ++ph) {
        p.ph_lo = ph; p.ph_hi = ph + 1;
        hipLaunchKernelGGL(fwd_kernel, dim3(grid_blocks), dim3(512), LDS_BYTES, stream, p);
    }
#else
    p.ph_lo = 0; p.ph_hi = 11;
    void* args[] = {&p};
    hipError_t e = hipLaunchCooperativeKernel((const void*)fwd_kernel, dim3(grid_blocks), dim3(512), args, LDS_BYTES, stream);
    if (e != hipSuccess) fprintf(stderr, "cooperative launch failed: %s (grid %d)\n", hipGetErrorString(e), grid_blocks);
#endif
}
```

```cpp
#include <hip/hip_runtime.h>
#include <hip/hip_cooperative_groups.h>
#include <cstdio>
#include <cstdint>
namespace cg = cooperative_groups;

#ifndef MK_MULTI
#define MK_MULTI 0
#endif

#define DEV __device__ __forceinline__
typedef unsigned short bf16_t;
typedef short bf16x8 __attribute__((ext_vector_type(8)));
typedef float f32x4 __attribute__((ext_vector_type(4)));
typedef unsigned u32x4 __attribute__((ext_vector_type(4)));
typedef unsigned u32x2 __attribute__((ext_vector_type(2)));

constexpr int D = 1024, TSEQ = 2048, NBATCH = 8, NTOK = 16384, NSMP = 128, NROWS = NTOK + NSMP;
constexpr int DP = 3072, DFF = 2816, DLRU = 512, NMODROWS = 144;
constexpr float EPS = 1e-6f;
constexpr int PAST_LEN = 16384;

constexpr size_t O_YP = 0, O_YS = O_YP + (size_t)NTOK * D, O_RETP = O_YS + (size_t)NSMP * D, O_LHP = O_RETP + 8 * 4 * 128 * 128,
                 O_LCP = O_LHP + 8 * 512, O_FCP = O_LCP + 8 * 3 * 512, O_RETS = O_FCP + 8 * 2 * DFF, O_LHS = O_RETS + (size_t)128 * 4 * 128 * 128,
                 O_LCS = O_LHS + 128 * 512, O_FCS = O_LCS + 128 * 3 * 512;

constexpr size_t al256(size_t x) { return (x + 255) & ~(size_t)255; }
constexpr size_t W_BTIN = 0;
constexpr size_t W_BTOUT = W_BTIN + (size_t)DP * D * 2;
constexpr size_t W_BTUP = W_BTOUT + (size_t)D * D * 2;
constexpr size_t W_BTDOWN = W_BTUP + (size_t)2 * DFF * D * 2;
constexpr size_t W_WRT = W_BTDOWN + (size_t)D * DFF * 2;
constexpr size_t W_H = W_WRT + 2 * 8 * 64 * 64 * 2;
constexpr size_t W_PROJ = W_H + (size_t)NROWS * D * 2;
constexpr size_t W_MIX = W_PROJ + (size_t)NTOK * DP * 2;
constexpr size_t W_KVT = W_MIX + (size_t)NROWS * D * 2;
constexpr size_t W_MOD = W_KVT + (size_t)512 * 65536;
constexpr size_t W_SW = W_MOD + (size_t)NMODROWS * 6144 * 4;
constexpr size_t W_PROJS = W_SW + (size_t)NMODROWS * 2 * DFF * 4;
constexpr size_t W_ROPE = W_PROJS + (size_t)NSMP * DP * 4;
constexpr size_t W_EDGEU = al256(W_ROPE + (size_t)(TSEQ + 1) * 128 * 4);
constexpr size_t W_EDGEG = W_EDGEU + (size_t)64 * 2 * DFF * 4;
constexpr size_t W_TAILU = W_EDGEG + (size_t)64 * 2 * DFF * 4;
constexpr size_t W_FIX = W_TAILU + (size_t)64 * 2 * DFF * 4;
constexpr size_t W_AGG = W_FIX + (size_t)256 * 2 * DFF * 2;
constexpr size_t W_RSS1 = W_AGG + (size_t)8 * 8 * 16 * 2 * 64 * 4;
constexpr size_t W_RSS2 = al256(W_RSS1 + (size_t)NROWS * 4);
constexpr size_t W_SPL = al256(W_RSS2 + (size_t)NROWS * 4);
constexpr size_t W_MODA = W_SPL + 512 * 4;
constexpr size_t W_SHF = W_MODA + (size_t)NMODROWS * D * 2;
constexpr size_t W_HIN0 = al256(W_SHF + (size_t)NMODROWS * D * 2);
constexpr size_t W_BAR = W_HIN0 + (size_t)1024 * 64 * 4;
constexpr int BAR_WORDS = 3456 + 64 * 64;
constexpr size_t W_END = W_BAR + (size_t)BAR_WORDS * 4;

constexpr int LDS_BYTES = 147456;

struct Params {
    const float *x_p, *x_s, *c_p, *c_s, *st_ret, *st_h, *st_cl, *st_cf, *w_ada, *b_ada, *g_mix, *w_in, *cl_w, *cl_b, *w_r, *b_r, *w_i, *b_i, *lam,
        *w_out, *g_ffn, *w_upc, *w_upg, *cf_w, *cf_b, *w_down, *g_final;
    float* out;
    unsigned char* ws;
    long long ph_lo, ph_hi;
};

extern __shared__ __attribute__((aligned(16))) unsigned char shm_raw[];

DEV int TIDX() { int t = threadIdx.x; asm volatile("" : "+v"(t)); return t; }
DEV int BIDX() { int b = blockIdx.x; asm volatile("" : "+s"(b)); return b; }
typedef float f32x2_ __attribute__((ext_vector_type(2)));
typedef __bf16 bf16x2_ __attribute__((ext_vector_type(2)));
DEV unsigned cvt_pk_bf16(float lo, float hi) { const f32x2_ v = {lo, hi}; const bf16x2_ r = __builtin_convertvector(v, bf16x2_); return __builtin_bit_cast(unsigned, r); }
DEV bf16_t f2bf(float x) { return (bf16_t)(cvt_pk_bf16(x, 0.f) & 0xffffu); }
DEV float bf2f(bf16_t v) { return __uint_as_float(((unsigned)v) << 16); }
DEV float bflo(unsigned w) { return __uint_as_float(w << 16); }
DEV float bfhi(unsigned w) { return __uint_as_float(w & 0xffff0000u); }
DEV float fexp2(float x) { return __builtin_amdgcn_exp2f(x); }
DEV float sigmoidf_(float x) { return __builtin_amdgcn_rcpf(1.f + fexp2(-1.4426950408889634f * x)); }
DEV float siluf_(float x) { return x * sigmoidf_(x); }
DEV float geluf_(float x) { const float y = 1.5957691216057308f * (x + 0.044715f * x * x * x); return x * sigmoidf_(y); }
DEV float wave_sum(float v) {
#pragma unroll
    for (int o = 1; o < 64; o <<= 1) v += __shfl_xor(v, o);
    return v;
}
DEV void unpack8(u32x4 w, float* f) { f[0] = bflo(w.x); f[1] = bfhi(w.x); f[2] = bflo(w.y); f[3] = bfhi(w.y); f[4] = bflo(w.z); f[5] = bfhi(w.z); f[6] = bflo(w.w); f[7] = bfhi(w.w); }
DEV u32x4 pack8(const float* f) { u32x4 w; w.x = cvt_pk_bf16(f[0], f[1]); w.y = cvt_pk_bf16(f[2], f[3]); w.z = cvt_pk_bf16(f[4], f[5]); w.w = cvt_pk_bf16(f[6], f[7]); return w; }
DEV int rhoinv(int w) { return 16 * ((w >> 2) & 1) + 4 * (w >> 3) + (w & 3); }
DEV int permpos(int c) { return (c & ~31) | rhoinv(c & 31); }
DEV int slotcol(int n, int s) { return 8 * (s >> 2) + 4 * n + (s & 3); }
DEV float gamma_log2(int h) { return __log2f(1.f - exp2f(-5.f - (float)h)); }

constexpr int BM = 256, BK = 64, HALF = 128, HT = HALF * BK;
DEV int lds_byte(int r, int c) { int st = (r >> 4) * 2 + (c >> 5), rr = r & 15, cc = c & 31, ob = rr * 64 + cc * 2; return st * 1024 + (ob ^ (((ob >> 9) & 1) << 5)); }
DEV void stage_rc(int b, int& R, int& C) { int st = b / 1024, sb = b % 1024, swz = sb ^ (((sb >> 9) & 1) << 5); R = (st >> 1) * 16 + swz / 64; C = (st & 1) * 32 + (swz % 64) / 2; }

#define LAS __attribute__((address_space(3)))
template <bool FIX, class Epi>
DEV void gemm_tile(const bf16_t* __restrict__ A, const bf16_t* __restrict__ Bt, const int K, const int brow, const int bcol, const bf16_t* fixA, Epi&& epi) {
    LAS unsigned char* lds = (LAS unsigned char*)shm_raw;
    const int tid = TIDX(), wid = __builtin_amdgcn_readfirstlane(tid >> 6), lane = tid & 63, wr = wid >> 2, wc = wid & 3, fr = lane & 15, fq = lane >> 4;
    const int nt = K / BK;
    constexpr int HTB = HALF * BK * 2;
    unsigned voff[2], voffF[2];
#pragma unroll
    for (int i = 0; i < 2; ++i) {
        int R, C; stage_rc(tid * 16 + i * 8192, R, C);
        voff[i] = (unsigned)(R * K + C) * 2u; voffF[i] = voff[i];
        if (FIX) { if (R < 2) voffF[i] = (unsigned)(((const char*)fixA - (const char*)(A + (size_t)brow * K)) + (long)(R * K + C) * 2); }
    }
    const size_t kstep = (size_t)(BK * 2), hstep = (size_t)HALF * K * 2;
    const unsigned ldsw = (unsigned)wid * 1024u;
    const int aoff = lds_byte(wr * 64 + fr, fq * 8), boff = lds_byte(wc * 32 + fr, fq * 8);
    const char* cA = (const char*)(A + (size_t)brow * K); const char* cB = (const char*)(Bt + (size_t)bcol * K);
#define SA(b, h) (((b) * 2 + (h)) * HTB)
#define SB(b, h) ((4 + (b) * 2 + (h)) * HTB)
#define STAGE(bufoff, gbase, vo) do { _Pragma("unroll") for (int _i = 0; _i < 2; ++_i) \
        __builtin_amdgcn_global_load_lds((const unsigned*)((const char*)(gbase) + (vo)[_i]), (LAS unsigned*)(lds + (bufoff) + ldsw + _i * 8192), 16, 0, 0); } while (0)
#define LDA(dst, b, h) do { _Pragma("unroll") for (int m = 0; m < 4; ++m) _Pragma("unroll") for (int k = 0; k < 2; ++k) dst[m][k] = *(const LAS bf16x8*)(lds + SA(b, h) + aoff + m * 2048 + k * 1024); } while (0)
#define LDB(dst, b, h) do { _Pragma("unroll") for (int n = 0; n < 2; ++n) _Pragma("unroll") for (int k = 0; k < 2; ++k) dst[n][k] = *(const LAS bf16x8*)(lds + SB(b, h) + boff + n * 2048 + k * 1024); } while (0)
#define MMA(ai, bj, At_, Bt_) do { __builtin_amdgcn_s_setprio(1); _Pragma("unroll") for (int m = 0; m < 4; ++m) _Pragma("unroll") for (int n = 0; n < 2; ++n) _Pragma("unroll") for (int k = 0; k < 2; ++k) \
        acc[ai][bj][m][n] = __builtin_amdgcn_mfma_f32_16x16x32_bf16(Bt_[n][k], At_[m][k], acc[ai][bj][m][n], 0, 0, 0); __builtin_amdgcn_s_setprio(0); } while (0)
#define WAIT_V(n) asm volatile("s_waitcnt vmcnt(" #n ")" ::: "memory")
#define WAIT_L(n) asm volatile("s_waitcnt lgkmcnt(" #n ")" ::: "memory")
#define BAR __builtin_amdgcn_s_barrier()
#define SCHED __builtin_amdgcn_sched_barrier(0)
    f32x4 acc[2][2][4][2];
#pragma unroll
    for (int a = 0; a < 2; ++a)
#pragma unroll
        for (int b = 0; b < 2; ++b)
#pragma unroll
            for (int m = 0; m < 4; ++m)
#pragma unroll
                for (int n = 0; n < 2; ++n) acc[a][b][m][n] = (f32x4){0.f, 0.f, 0.f, 0.f};
    bf16x8 At[4][2], B0[2][2], B1[2][2];
    STAGE(SB(0, 0), cB, voff); STAGE(SA(0, 0), cA, voffF); STAGE(SB(0, 1), cB + hstep, voff); STAGE(SA(0, 1), cA + hstep, voff);
    if (wr == 1) BAR;
    WAIT_V(4); BAR;
    STAGE(SB(1, 0), cB + kstep, voff); STAGE(SA(1, 0), cA + kstep, voffF); STAGE(SB(1, 1), cB + hstep + kstep, voff);
    WAIT_V(6); BAR;
    for (int t = 0; t < nt - 2; t += 2) {
        const char* a1 = cA + (size_t)(t + 1) * kstep; const char* a2 = a1 + kstep; const char* a3 = a2 + kstep;
        const char* b2 = cB + (size_t)(t + 2) * kstep; const char* b3 = b2 + kstep;
        LDB(B0, 0, 0); SCHED; LDA(At, 0, 0); STAGE(SA(1, 1), a1 + hstep, voff);
        WAIT_L(8); BAR; WAIT_L(0); MMA(0, 0, At, B0); BAR; SCHED;
        LDB(B1, 0, 1); STAGE(SB(0, 0), b2, voff);
        BAR; WAIT_L(0); MMA(0, 1, At, B1); BAR;
        LDA(At, 0, 1); STAGE(SA(0, 0), a2, voffF);
        BAR; WAIT_L(0); MMA(1, 0, At, B0); BAR; SCHED;
        STAGE(SB(0, 1), b2 + hstep, voff);
        WAIT_V(6); BAR; MMA(1, 1, At, B1); BAR;
        LDB(B0, 1, 0); SCHED; LDA(At, 1, 0); STAGE(SA(0, 1), a2 + hstep, voff);
        WAIT_L(8); BAR; WAIT_L(0); MMA(0, 0, At, B0); BAR; SCHED;
        LDB(B1, 1, 1); STAGE(SB(1, 0), b3, voff);
        BAR; WAIT_L(0); MMA(0, 1, At, B1); BAR;
        LDA(At, 1, 1); STAGE(SA(1, 0), a3, voffF);
        BAR; WAIT_L(0); MMA(1, 0, At, B0); BAR; SCHED;
        STAGE(SB(1, 1), b3 + hstep, voff);
        WAIT_V(6); BAR; MMA(1, 1, At, B1); BAR;
    }
    { LDB(B0, 0, 0); LDA(At, 0, 0); STAGE(SA(1, 1), cA + (size_t)(nt - 1) * kstep + hstep, voff);
      BAR; WAIT_L(0); MMA(0, 0, At, B0); BAR;
      LDB(B1, 0, 1); BAR; WAIT_L(0); MMA(0, 1, At, B1); BAR;
      LDA(At, 0, 1); WAIT_V(4); BAR; WAIT_L(0); MMA(1, 0, At, B0); MMA(1, 1, At, B1); BAR; }
    { LDB(B0, 1, 0); LDA(At, 1, 0); WAIT_V(2); BAR; WAIT_L(0); MMA(0, 0, At, B0); BAR;
      LDB(B1, 1, 1); WAIT_V(0); BAR; WAIT_L(0); MMA(0, 1, At, B1); BAR;
      LDA(At, 1, 1); BAR; WAIT_L(0); MMA(1, 0, At, B0); MMA(1, 1, At, B1); BAR; }
    if (wr == 0) BAR;
    asm volatile("" ::: "memory");
    epi(acc, brow, bcol, wr, wc, fr, fq);
#undef SA
#undef SB
#undef STAGE
#undef LDA
#undef LDB
#undef MMA
}

DEV void tile_order(int L, int nM, int nN, int& pm, int& pn) {
    const int nwg = nM * nN, NX = 8, WGM = 8;
    int wgid = L; { const int q = nwg / NX, r = nwg % NX, xcd = wgid % NX, off = wgid / NX; wgid = (xcd < r ? xcd * (q + 1) : r * (q + 1) + (xcd - r) * q) + off; }
    const int nig = WGM * nN, gid = wgid / nig, fm = gid * WGM, gsz = (nM - fm) < WGM ? (nM - fm) : WGM;
    pm = fm + ((wgid % nig) % gsz); pn = (wgid % nig) / gsz;
}

DEV float dpp_ror1(float x) { return __int_as_float(__builtin_amdgcn_update_dpp(0, __float_as_int(x), 0x121, 0xf, 0xf, false)); }
DEV float dpp_ror2(float x) { return __int_as_float(__builtin_amdgcn_update_dpp(0, __float_as_int(x), 0x122, 0xf, 0xf, false)); }
DEV float dpp_shr1(float old, float x) { return __int_as_float(__builtin_amdgcn_update_dpp(__float_as_int(old), __float_as_int(x), 0x111, 0xf, 0xf, false)); }
DEV float dpp_shr2(float old, float x) { return __int_as_float(__builtin_amdgcn_update_dpp(__float_as_int(old), __float_as_int(x), 0x112, 0xf, 0xf, false)); }
#define SKINNY_LOOP(j, NBIG_, NSK_) const int _nb = gridDim.x, _first = (NBIG_) % _nb, _bb = BIDX(); if (_bb >= _first) for (int j = _bb - _first; j < (NSK_); j += _nb - _first)
template <bool FIX, class Epi>
DEV void gemm_phase(const bf16_t* __restrict__ A, const bf16_t* __restrict__ Bt, const int K, const int nM, const int nN, const int nbig, const bf16_t* fixbase, Epi&& epi) {
    LAS unsigned char* lds = (LAS unsigned char*)shm_raw;
    const int tid = TIDX(), wid = __builtin_amdgcn_readfirstlane(tid >> 6), lane = tid & 63, wr = wid >> 2, wc = wid & 3, fr = lane & 15, fq = lane >> 4;
    const int nt = K / BK, G = gridDim.x;
    int it = BIDX();
    if (it >= nbig) return;
    constexpr int HTB = HALF * BK * 2;
    unsigned voff[2], voffF[2], voffFn[2];
    int sR[2], sC[2];
#pragma unroll
    for (int i = 0; i < 2; ++i) { stage_rc(tid * 16 + i * 8192, sR[i], sC[i]); voff[i] = (unsigned)(sR[i] * K + sC[i]) * 2u; voffF[i] = voff[i]; voffFn[i] = voff[i]; }
    const size_t kstep = (size_t)(BK * 2), hstep = (size_t)HALF * K * 2, tstep = 2 * hstep;
    const unsigned ldsw = (unsigned)wid * 1024u;
    const int aoff = lds_byte(wr * 64 + fr, fq * 8), boff = lds_byte(wc * 32 + fr, fq * 8);
    int pm, pn; tile_order(it, nM, nN, pm, pn);
    const char* cA = (const char*)A + (size_t)pm * tstep; const char* cB = (const char*)Bt + (size_t)pn * tstep;
    if (FIX) {
#pragma unroll
        for (int i = 0; i < 2; ++i) if (sR[i] < 2) voffF[i] = (unsigned)(((const char*)(fixbase + (size_t)it * 2 * K) - cA) + (long)(sR[i] * K + sC[i]) * 2);
    }
#define SA(b, h) (((b) * 2 + (h)) * HTB)
#define SB(b, h) ((4 + (b) * 2 + (h)) * HTB)
#define STAGE(bufoff, gbase, vo) do { _Pragma("unroll") for (int _i = 0; _i < 2; ++_i) \
        __builtin_amdgcn_global_load_lds((const unsigned*)((const char*)(gbase) + (vo)[_i]), (LAS unsigned*)(lds + (bufoff) + ldsw + _i * 8192), 16, 0, 0); } while (0)
#define LDA(dst, b, h) do { _Pragma("unroll") for (int m = 0; m < 4; ++m) _Pragma("unroll") for (int k = 0; k < 2; ++k) dst[m][k] = *(const LAS bf16x8*)(lds + SA(b, h) + aoff + m * 2048 + k * 1024); } while (0)
#define LDB(dst, b, h) do { _Pragma("unroll") for (int n = 0; n < 2; ++n) _Pragma("unroll") for (int k = 0; k < 2; ++k) dst[n][k] = *(const LAS bf16x8*)(lds + SB(b, h) + boff + n * 2048 + k * 1024); } while (0)
#define MMA(ai, bj, At_, Bt_) do { __builtin_amdgcn_s_setprio(1); _Pragma("unroll") for (int m = 0; m < 4; ++m) _Pragma("unroll") for (int n = 0; n < 2; ++n) _Pragma("unroll") for (int k = 0; k < 2; ++k) \
        acc[ai][bj][m][n] = __builtin_amdgcn_mfma_f32_16x16x32_bf16(Bt_[n][k], At_[m][k], acc[ai][bj][m][n], 0, 0, 0); __builtin_amdgcn_s_setprio(0); } while (0)
    f32x4 acc[2][2][4][2];
#define ZACC() do { _Pragma("unroll") for (int a_ = 0; a_ < 2; ++a_) _Pragma("unroll") for (int b_ = 0; b_ < 2; ++b_) _Pragma("unroll") for (int m_ = 0; m_ < 4; ++m_) _Pragma("unroll") for (int n_ = 0; n_ < 2; ++n_) acc[a_][b_][m_][n_] = (f32x4){0.f, 0.f, 0.f, 0.f}; } while (0)
    ZACC();
    bf16x8 At[4][2], B0[2][2], B1[2][2];
    STAGE(SB(0, 0), cB, voff); STAGE(SB(0, 1), cB + hstep, voff); STAGE(SA(0, 0), cA, voffF); STAGE(SA(0, 1), cA + hstep, voff);
    if (wr == 1) BAR;
    WAIT_V(2); BAR;
    STAGE(SB(1, 0), cB + kstep, voff); STAGE(SA(1, 0), cA + kstep, voffF); STAGE(SB(1, 1), cB + hstep + kstep, voff);
    WAIT_V(6); BAR;
    for (;;) {
        const int itn = it + G; const bool has_next = itn < nbig;
        int pmn = pm, pnn = pn; if (has_next) tile_order(itn, nM, nN, pmn, pnn);
        const char* nA = (const char*)A + (size_t)pmn * tstep; const char* nB = (const char*)Bt + (size_t)pnn * tstep;
        if (FIX) {
#pragma unroll
            for (int i = 0; i < 2; ++i) { voffFn[i] = voff[i]; if (sR[i] < 2) voffFn[i] = (unsigned)(((const char*)(fixbase + (size_t)(has_next ? itn : it) * 2 * K) - nA) + (long)(sR[i] * K + sC[i]) * 2); }
        }
        for (int t = 0; t < nt; t += 2) {
            const bool last = (t == nt - 2);
            const char* a1 = cA + (size_t)(t + 1) * kstep;
            const char* a2 = last ? nA : cA + (size_t)(t + 2) * kstep; const char* b2 = last ? nB : cB + (size_t)(t + 2) * kstep;
            const char* a3 = a2 + kstep; const char* b3 = b2 + kstep;
            unsigned vF2[2];
#pragma unroll
            for (int i = 0; i < 2; ++i) vF2[i] = FIX ? (last ? voffFn[i] : voffF[i]) : voff[i];
            LDB(B0, 0, 0); LDB(B1, 0, 1); SCHED; LDA(At, 0, 0); STAGE(SA(1, 1), a1 + hstep, voff);
            WAIT_V(8); WAIT_L(0); BAR; MMA(0, 0, At, B0); MMA(0, 1, At, B1); BAR; SCHED;
            LDA(At, 0, 1); STAGE(SB(0, 0), b2, voff); STAGE(SB(0, 1), b2 + hstep, voff); STAGE(SA(0, 0), a2, vF2);
            WAIT_V(8); WAIT_L(0); BAR; MMA(1, 0, At, B0); MMA(1, 1, At, B1); BAR; SCHED;
            LDB(B0, 1, 0); LDB(B1, 1, 1); SCHED; LDA(At, 1, 0); STAGE(SA(0, 1), a2 + hstep, voff);
            WAIT_V(8); WAIT_L(0); BAR; MMA(0, 0, At, B0); MMA(0, 1, At, B1); BAR; SCHED;
            LDA(At, 1, 1); STAGE(SB(1, 0), b3, voff); STAGE(SB(1, 1), b3 + hstep, voff); STAGE(SA(1, 0), a3, vF2);
            WAIT_V(8); WAIT_L(0); BAR; MMA(1, 0, At, B0); MMA(1, 1, At, B1); BAR; SCHED;
        }
        if (wr == 0) BAR;
        asm volatile("" ::: "memory");
        epi(acc, pm, pn, pm * BM, pn * BM, wr, wc, fr, fq);
        asm volatile("s_waitcnt vmcnt(0)" ::: "memory");
        if (!has_next) break;
        ZACC();
        it = itn; pm = pmn; pn = pnn; cA = nA; cB = nB;
        if (FIX) { voffF[0] = voffFn[0]; voffF[1] = voffFn[1]; }
        if (wr == 1) BAR;
    }
    BAR;
#undef SA
#undef SB
#undef STAGE
#undef LDA
#undef LDB
#undef MMA
#undef ZACC
}

struct NoRowFn { DEV void operator()(int, float) const {} };
template <int RB, int NBLK, int U, class Epi, class RowFn = NoRowFn>
DEV void skinny_tile(const bf16_t* __restrict__ A, const int lda, const bf16_t* __restrict__ B0, const bf16_t* __restrict__ B1, const int K, Epi&& epi, RowFn&& rowfn = NoRowFn(), const int ldb_ = 0) {
    const int ldb = ldb_ ? ldb_ : K;
    float* red = (float*)shm_raw;
    const int tid = TIDX(), w = tid >> 6, lane = tid & 63, fr = lane & 15, fq = lane >> 4;
    constexpr int KG = (NBLK == 2) ? 4 : 8;
    const int kg = (NBLK == 2) ? (w & 3) : w, nb = (NBLK == 2) ? (w >> 2) : 0;
    const bf16_t* Bp = (nb ? B1 : B0) + (long)fr * ldb + fq * 8;
    const bf16_t* Ap = A + (long)fr * lda + fq * 8;
    const int kper = K / KG, kbeg = kg * kper, kend = kbeg + kper;
    f32x4 acc[RB];
#pragma unroll
    for (int rb = 0; rb < RB; ++rb) acc[rb] = (f32x4){0.f, 0.f, 0.f, 0.f};
    int k = kbeg;
    for (; k + 32 * U <= kend; k += 32 * U) {
        bf16x8 b[U], a[U][RB];
#pragma unroll
        for (int u = 0; u < U; ++u) {
            b[u] = *(const bf16x8*)(Bp + k + 32 * u);
#pragma unroll
            for (int rb = 0; rb < RB; ++rb) a[u][rb] = *(const bf16x8*)(Ap + (long)rb * 16 * lda + k + 32 * u);
        }
#pragma unroll
        for (int u = 0; u < U; ++u)
#pragma unroll
            for (int rb = 0; rb < RB; ++rb) acc[rb] = __builtin_amdgcn_mfma_f32_16x16x32_bf16(b[u], a[u][rb], acc[rb], 0, 0, 0);
    }
    for (; k < kend; k += 32) {
        const bf16x8 b = *(const bf16x8*)(Bp + k);
        bf16x8 a[RB];
#pragma unroll
        for (int rb = 0; rb < RB; ++rb) a[rb] = *(const bf16x8*)(Ap + (long)rb * 16 * lda + k);
#pragma unroll
        for (int rb = 0; rb < RB; ++rb) acc[rb] = __builtin_amdgcn_mfma_f32_16x16x32_bf16(b, a[rb], acc[rb], 0, 0, 0);
    }
    f32x4* r4 = (f32x4*)red;
#pragma unroll
    for (int rb = 0; rb < RB; ++rb) r4[(w * RB + rb) * 64 + lane] = acc[rb];
    __syncthreads();
    for (int e = tid; e < RB * 256; e += 512) {
        const int row = e >> 4, s = e & 15, rb = row >> 4, l2 = (row & 15) + 16 * (s >> 2), r = s & 3;
        float v0 = 0.f, v1 = 0.f;
        if (NBLK == 2) {
#pragma unroll
            for (int g = 0; g < 4; ++g) { v0 += red[((g * RB + rb) * 64 + l2) * 4 + r]; v1 += red[(((4 + g) * RB + rb) * 64 + l2) * 4 + r]; }
        } else {
#pragma unroll
            for (int g = 0; g < 8; ++g) v0 += red[((g * RB + rb) * 64 + l2) * 4 + r];
        }
        float ss = epi(row, s, v0, v1);
        ss += __shfl_xor(ss, 1); ss += __shfl_xor(ss, 2); ss += __shfl_xor(ss, 4); ss += __shfl_xor(ss, 8);
        if (s == 0) rowfn(row, ss);
    }
    __syncthreads();
}

template <class RowMap>
DEV void transpose_tile(const float* __restrict__ src, const int N, const int K, const int k0, const int c0, bf16_t* __restrict__ dst, RowMap&& rowmap) {
    float* lds = (float*)shm_raw;
    const int tid = TIDX();
#pragma unroll
    for (int i = 0; i < 2; ++i) {
        const int idx = tid * 4 + i * 2048, kk = idx >> 6, cc = idx & 63;
        const f32x4 v = *(const f32x4*)(src + (size_t)(k0 + kk) * N + c0 + cc);
        lds[kk * 65 + cc] = v.x; lds[kk * 65 + cc + 1] = v.y; lds[kk * 65 + cc + 2] = v.z; lds[kk * 65 + cc + 3] = v.w;
    }
    __syncthreads();
    {
        const int c = tid >> 3, ks = (tid & 7) * 8;
        float f[8];
#pragma unroll
        for (int e = 0; e < 8; ++e) f[e] = lds[(ks + e) * 65 + c];
        *(u32x4*)(dst + (size_t)rowmap(c0 + c) * K + k0 + ks) = pack8(f);
    }
    __syncthreads();
}

DEV void phase_prep(const Params& p) {
    unsigned char* ws = p.ws;
    bf16_t* BtIn = (bf16_t*)(ws + W_BTIN); bf16_t* BtOut = (bf16_t*)(ws + W_BTOUT); bf16_t* BtUp = (bf16_t*)(ws + W_BTUP);
    bf16_t* BtDown = (bf16_t*)(ws + W_BTDOWN); bf16_t* BtAda = (bf16_t*)(ws + W_KVT); bf16_t* WrT = (bf16_t*)(ws + W_WRT);
    constexpr int T_IN = 16 * 48, T_OUT = 16 * 16, T_UP = 16 * 44, T_DOWN = 44 * 16, T_ADA = 16 * 96, T_G = 16;
    constexpr int T_ALL = T_IN + T_OUT + 2 * T_UP + T_DOWN + T_ADA + T_G;
    for (int it = BIDX(); it < T_ALL; it += gridDim.x) {
        int r = it;
        if (r < T_ADA) { transpose_tile(p.w_ada, 6144, 1024, (r / 96) * 64, (r % 96) * 64, BtAda, [](int c) { return permpos(c); }); continue; } r -= T_ADA;
        if (r < T_IN) { transpose_tile(p.w_in, DP, 1024, (r / 48) * 64, (r % 48) * 64, BtIn, [](int c) { return permpos(c); }); continue; } r -= T_IN;
        if (r < T_OUT) { transpose_tile(p.w_out, D, 1024, (r / 16) * 64, (r % 16) * 64, BtOut, [](int c) { return permpos(c); }); continue; } r -= T_OUT;
        if (r < T_UP) { transpose_tile(p.w_upc, DFF, 1024, (r / 44) * 64, (r % 44) * 64, BtUp, [](int c) { return 256 * (c >> 7) + permpos(c & 127); }); continue; } r -= T_UP;
        if (r < T_UP) { transpose_tile(p.w_upg, DFF, 1024, (r / 44) * 64, (r % 44) * 64, BtUp, [](int c) { return 256 * (c >> 7) + 128 + permpos(c & 127); }); continue; } r -= T_UP;
        if (r < T_DOWN) { transpose_tile(p.w_down, D, DFF, (r / 16) * 64, (r % 16) * 64, BtDown, [](int c) { return permpos(c); }); continue; } r -= T_DOWN;
        { const int g = r >> 3, jb = r & 7; transpose_tile((g ? p.w_i : p.w_r) + jb * 4096, 64, 64, 0, 0, WrT + (g * 8 + jb) * 4096, [](int c) { return c; }); }
    }
    const int gt = BIDX() * 512 + TIDX(), GT = gridDim.x * 512;
    bf16_t* modA = (bf16_t*)(ws + W_MODA);
    for (int i = gt; i < NMODROWS * D; i += GT) {
        const int row = i >> 10, k = i & 1023;
        float v = 0.f;
        if (row < 8) v = siluf_(p.c_p[row * D + k]); else if (row < 136) v = siluf_(p.c_s[(row - 8) * D + k]);
        modA[i] = f2bf(v);
    }
    float* rope = (float*)(ws + W_ROPE);
    for (int i = gt; i < (TSEQ + 1) * 64; i += GT) {
        const int t = i >> 6, j = i & 63;
        const float pos = (t < TSEQ) ? (float)t : (float)PAST_LEN;
        const float invf = exp2f(-(float)(2 * j) * (13.287712379549449f / 128.f));
        const float ang = pos * invf;
        float s, c; sincosf(ang, &s, &c);
        rope[t * 128 + j] = c; rope[t * 128 + 64 + j] = s;
    }
    float* rss1 = (float*)(ws + W_RSS1); float* rss2 = (float*)(ws + W_RSS2); float* spl = (float*)(ws + W_SPL);
    for (int i = gt; i < NROWS; i += GT) { rss1[i] = 0.f; rss2[i] = 0.f; }
    for (int i = gt; i < 512; i += GT) spl[i] = 8.f * log1pf(__expf(-p.lam[i]));
}

DEV void phase_mod(const Params& p) {
    unsigned char* ws = p.ws;
    const bf16_t* modA = (const bf16_t*)(ws + W_MODA); const bf16_t* BtAda = (const bf16_t*)(ws + W_KVT); float* mod = (float*)(ws + W_MOD);
    for (int it = BIDX(); it < 128; it += gridDim.x) {
        const int g = it >> 1, n = it & 1;
        const bf16_t* B0 = BtAda + (size_t)(32 * g + 16 * n) * D;
        skinny_tile<9, 1, 4>(modA, D, B0, B0, D, [&](int row, int s, float v0, float v1) {
            if (row < 136) { const int c0 = 32 * g + slotcol(n, s); mod[(size_t)row * 6144 + c0] = v0 + p.b_ada[c0]; }
            return 0.f;
        });
    }
}

DEV void phase_norm1(const Params& p) {
    unsigned char* ws = p.ws;
    const float* mod = (const float*)(ws + W_MOD); bf16_t* H = (bf16_t*)(ws + W_H); bf16_t* shf = (bf16_t*)(ws + W_SHF);
    const int lane = TIDX() & 63, gw = BIDX() * 8 + (TIDX() >> 6), NGW = gridDim.x * 8;
    for (int row = gw; row < NROWS; row += NGW) {
        const float* xr = (row < NTOK) ? p.x_p + (size_t)row * D : p.x_s + (size_t)(row - NTOK) * D;
        const int b = (row < NTOK) ? (row >> 11) : 8 + (row - NTOK);
        const float* mrow = mod + (size_t)b * 6144;
        f32x4 v[4]; float ss = 0.f;
#pragma unroll
        for (int j = 0; j < 4; ++j) { v[j] = *(const f32x4*)(xr + 4 * lane + 256 * j); ss += v[j].x * v[j].x + v[j].y * v[j].y + v[j].z * v[j].z + v[j].w * v[j].w; }
        const float rstd = __builtin_amdgcn_rsqf(wave_sum(ss) * (1.f / D) + EPS);
#pragma unroll
        for (int j = 0; j < 4; ++j) {
            const int k = 4 * lane + 256 * j;
            const f32x4 g = *(const f32x4*)(p.g_mix + k), sh = *(const f32x4*)(mrow + k), sc = *(const f32x4*)(mrow + D + k);
            const f32x4 h = v[j] * rstd * g * (1.f + sc) + sh;
            u32x2 o; o.x = cvt_pk_bf16(h.x, h.y); o.y = cvt_pk_bf16(h.z, h.w);
            *(u32x2*)(H + (size_t)row * D + k) = o;
        }
    }
}

DEV void phase_inproj(const Params& p) {
    unsigned char* ws = p.ws;
    const bf16_t* H = (const bf16_t*)(ws + W_H); const bf16_t* BtIn = (const bf16_t*)(ws + W_BTIN); bf16_t* proj = (bf16_t*)(ws + W_PROJ);
    float* projS = (float*)(ws + W_PROJS);
    constexpr int NBIG = 64 * 12, NSK1 = 96;
    gemm_phase<false>(H, BtIn, D, 64, 12, NBIG, nullptr, [&](const f32x4 (&acc)[2][2][4][2], int pm, int pn, int brow, int bcol, int wr, int wc, int fr, int fq) {
#pragma unroll
        for (int ai = 0; ai < 2; ++ai)
#pragma unroll
            for (int m = 0; m < 4; ++m) {
                bf16_t* rp = proj + (size_t)(brow + ai * HALF + wr * 64 + m * 16 + fr) * DP + bcol + wc * 32 + 8 * fq;
#pragma unroll
                for (int bj = 0; bj < 2; ++bj) {
                    const f32x4 a = acc[ai][bj][m][0], b = acc[ai][bj][m][1];
                    u32x4 w; w.x = cvt_pk_bf16(a[0], a[1]); w.y = cvt_pk_bf16(a[2], a[3]); w.z = cvt_pk_bf16(b[0], b[1]); w.w = cvt_pk_bf16(b[2], b[3]);
                    *(u32x4*)(rp + bj * HALF) = w;
                }
            }
    });
    const bf16_t* modA = (const bf16_t*)(ws + W_MODA); const bf16_t* BtAda = (const bf16_t*)(ws + W_KVT); float* mod = (float*)(ws + W_MOD);
    SKINNY_LOOP(j, NBIG, NSK1 + 128) {
        if (j < NSK1) {
            const int g = j;
            const bf16_t* B0 = BtIn + (size_t)(32 * g) * D;
            skinny_tile<8, 2, 4>(H + (size_t)NTOK * D, D, B0, B0 + 16 * D, D, [&](int row, int s, float v0, float v1) {
                const int c0 = 32 * g + slotcol(0, s); projS[row * DP + c0] = v0; projS[row * DP + c0 + 4] = v1; return 0.f;
            });
        } else {
            const int g = 64 + (j - NSK1);
            const bf16_t* B0 = BtAda + (size_t)(32 * g) * D;
            skinny_tile<9, 2, 4>(modA, D, B0, B0 + 16 * D, D, [&](int row, int s, float v0, float v1) {
                if (row < 136) { const int c0 = 32 * g + slotcol(0, s), c1 = c0 + 4; mod[(size_t)row * 6144 + c0] = v0 + p.b_ada[c0]; mod[(size_t)row * 6144 + c1] = v1 + p.b_ada[c1]; }
                return 0.f;
            });
        }
    }
}

constexpr int RP = 136;
DEV void rot8(const float* x1, const float* x2, const float* tr, int d0, float scale, float* o1, float* o2) {
    const f32x4 c0 = *(const f32x4*)(tr + d0), c1 = *(const f32x4*)(tr + d0 + 4), s0 = *(const f32x4*)(tr + 64 + d0), s1 = *(const f32x4*)(tr + 64 + d0 + 4);
    const float c[8] = {c0.x, c0.y, c0.z, c0.w, c1.x, c1.y, c1.z, c1.w}, s[8] = {s0.x, s0.y, s0.z, s0.w, s1.x, s1.y, s1.z, s1.w};
#pragma unroll
    for (int e = 0; e < 8; ++e) { o1[e] = (x1[e] * c[e] - x2[e] * s[e]) * scale; o2[e] = (x1[e] * s[e] + x2[e] * c[e]) * scale; }
}

DEV void rot8v(const u32x4 a, const u32x4 b, const f32x4 c0, const f32x4 c1, const f32x4 s0, const f32x4 s1, float scale, float* o1, float* o2) {
    float x1[8], x2[8]; unpack8(a, x1); unpack8(b, x2);
    const float c[8] = {c0.x, c0.y, c0.z, c0.w, c1.x, c1.y, c1.z, c1.w}, s[8] = {s0.x, s0.y, s0.z, s0.w, s1.x, s1.y, s1.z, s1.w};
#pragma unroll
    for (int e = 0; e < 8; ++e) { o1[e] = (x1[e] * c[e] - x2[e] * s[e]) * scale; o2[e] = (x1[e] * s[e] + x2[e] * c[e]) * scale; }
}
DEV void scatter_vT(const u32x4 w, int j, int d0, bf16_t* vT) {
    const unsigned ww[4] = {w.x, w.y, w.z, w.w};
#pragma unroll
    for (int e = 0; e < 4; ++e) { vT[(d0 + 2 * e) * RP + j] = (bf16_t)(ww[e] & 0xffffu); vT[(d0 + 2 * e + 1) * RP + j] = (bf16_t)(ww[e] >> 16); }
}
DEV void stage_vT(const bf16_t* proj, int row0, int h, bf16_t* vT) {
    for (int item = TIDX(); item < 2048; item += 512) {
        const int j = item >> 4, d0 = (item & 15) * 8;
        const u32x4 w = *(const u32x4*)(proj + (size_t)(row0 + j) * DP + 1024 + h * 128 + d0);
        const unsigned ww[4] = {w.x, w.y, w.z, w.w};
#pragma unroll
        for (int e = 0; e < 4; ++e) { vT[(d0 + 2 * e) * RP + j] = (bf16_t)(ww[e] & 0xffffu); vT[(d0 + 2 * e + 1) * RP + j] = (bf16_t)(ww[e] >> 16); }
    }
}

DEV void ret_passA(const Params& p, int unit) {
    unsigned char* ws = p.ws;
    const bf16_t* proj = (const bf16_t*)(ws + W_PROJ); const float* rope = (const float*)(ws + W_ROPE); float* KVT = (float*)(ws + W_KVT) + (size_t)unit * 16384;
    const int n = unit & 15, h = (unit >> 4) & 3, b = unit >> 6, row0 = b * TSEQ + n * 128;
    bf16_t* kT = (bf16_t*)shm_raw; bf16_t* vT = kT + 128 * RP;
    const float lg = gamma_log2(h);
    {
        const int tid = TIDX();
        u32x4 kA[2], kB[2], vv[4]; f32x4 rc[2][4];
#pragma unroll
        for (int i = 0; i < 2; ++i) {
            const int item = tid + 512 * i, j = item >> 3, d0 = (item & 7) * 8;
            const bf16_t* kr = proj + (size_t)(row0 + j) * DP + 512 + h * 128; const float* tr = rope + (size_t)(n * 128 + j) * 128;
            kA[i] = *(const u32x4*)(kr + d0); kB[i] = *(const u32x4*)(kr + 64 + d0);
            rc[i][0] = *(const f32x4*)(tr + d0); rc[i][1] = *(const f32x4*)(tr + d0 + 4); rc[i][2] = *(const f32x4*)(tr + 64 + d0); rc[i][3] = *(const f32x4*)(tr + 64 + d0 + 4);
        }
#pragma unroll
        for (int i = 0; i < 4; ++i) { const int item = tid + 512 * i, j = item >> 4, d0 = (item & 15) * 8; vv[i] = *(const u32x4*)(proj + (size_t)(row0 + j) * DP + 1024 + h * 128 + d0); }
#pragma unroll
        for (int i = 0; i < 2; ++i) {
            const int item = tid + 512 * i, j = item >> 3, d0 = (item & 7) * 8;
            float o1[8], o2[8];
            rot8v(kA[i], kB[i], rc[i][0], rc[i][1], rc[i][2], rc[i][3], 0.08838834764831845f * fexp2(lg * (float)(127 - j)), o1, o2);
#pragma unroll
            for (int e = 0; e < 8; ++e) { kT[(d0 + e) * RP + j] = f2bf(o1[e]); kT[(64 + d0 + e) * RP + j] = f2bf(o2[e]); }
        }
#pragma unroll
        for (int i = 0; i < 4; ++i) { const int item = tid + 512 * i; scatter_vT(vv[i], item >> 4, (item & 15) * 8, vT); }
    }
    __syncthreads();
    const int w = TIDX() >> 6, lane = TIDX() & 63, fr = lane & 15, fq = lane >> 4;
    f32x4 acc[8];
#pragma unroll
    for (int vb = 0; vb < 8; ++vb) acc[vb] = (f32x4){0.f, 0.f, 0.f, 0.f};
#pragma unroll
    for (int ks = 0; ks < 4; ++ks) {
        const bf16x8 a = *(const bf16x8*)(kT + (16 * w + fr) * RP + 32 * ks + 8 * fq);
#pragma unroll
        for (int vb = 0; vb < 8; ++vb) {
            const bf16x8 bb = *(const bf16x8*)(vT + (16 * vb + fr) * RP + 32 * ks + 8 * fq);
            acc[vb] = __builtin_amdgcn_mfma_f32_16x16x32_bf16(a, bb, acc[vb], 0, 0, 0);
        }
    }
#pragma unroll
    for (int vb = 0; vb < 8; ++vb) *(f32x4*)(KVT + (16 * vb + fr) * 128 + 16 * w + 4 * fq) = acc[vb];
    __syncthreads();
}

DEV void ret_passC(const Params& p, int unit) {
    unsigned char* ws = p.ws;
    const bf16_t* proj = (const bf16_t*)(ws + W_PROJ); const float* rope = (const float*)(ws + W_ROPE); bf16_t* mix = (bf16_t*)(ws + W_MIX);
    const int n = unit & 15, h = (unit >> 4) & 3, b = unit >> 6, row0 = b * TSEQ + n * 128;
    bf16_t* ks_ = (bf16_t*)shm_raw; bf16_t* vT = ks_ + 128 * RP; bf16_t* ST = vT + 128 * RP; bf16_t* P = ST + 128 * RP;
    const float lg = gamma_log2(h);
    const int tid = TIDX(), w = tid >> 6, lane = tid & 63, fr = lane & 15, fq = lane >> 4;
    const int i_loc = 16 * w + fr;
    bf16x8 qf[4];
    {
        u32x4 kA[2], kB[2], vv[4], st[4], qA[2], qB[2]; f32x4 rc[2][4], qc[2][4];
#pragma unroll
        for (int i = 0; i < 2; ++i) {
            const int item = tid + 512 * i, j = item >> 3, d0 = (item & 7) * 8;
            const bf16_t* kr = proj + (size_t)(row0 + j) * DP + 512 + h * 128; const float* tr = rope + (size_t)(n * 128 + j) * 128;
            kA[i] = *(const u32x4*)(kr + d0); kB[i] = *(const u32x4*)(kr + 64 + d0);
            rc[i][0] = *(const f32x4*)(tr + d0); rc[i][1] = *(const f32x4*)(tr + d0 + 4); rc[i][2] = *(const f32x4*)(tr + 64 + d0); rc[i][3] = *(const f32x4*)(tr + 64 + d0 + 4);
        }
#pragma unroll
        for (int i = 0; i < 4; ++i) { const int item = tid + 512 * i, j = item >> 4, d0 = (item & 15) * 8; vv[i] = *(const u32x4*)(proj + (size_t)(row0 + j) * DP + 1024 + h * 128 + d0); }
        {
            const int dv = tid >> 2, sg = tid & 3;
            const bf16_t* src = (const bf16_t*)(ws + W_H) + (size_t)unit * 16384 + dv * 128 + sg * 32;
#pragma unroll
            for (int i = 0; i < 4; ++i) st[i] = *(const u32x4*)(src + 8 * i);
        }
        {
            const bf16_t* qr = proj + (size_t)(row0 + i_loc) * DP + h * 128; const float* tr = rope + (size_t)(n * 128 + i_loc) * 128;
#pragma unroll
            for (int kk = 0; kk < 2; ++kk) {
                const int d0 = 32 * kk + 8 * fq;
                qA[kk] = *(const u32x4*)(qr + d0); qB[kk] = *(const u32x4*)(qr + 64 + d0);
                qc[kk][0] = *(const f32x4*)(tr + d0); qc[kk][1] = *(const f32x4*)(tr + d0 + 4); qc[kk][2] = *(const f32x4*)(tr + 64 + d0); qc[kk][3] = *(const f32x4*)(tr + 64 + d0 + 4);
            }
        }
#pragma unroll
        for (int i = 0; i < 2; ++i) {
            const int item = tid + 512 * i, j = item >> 3, d0 = (item & 7) * 8;
            float o1[8], o2[8];
            rot8v(kA[i], kB[i], rc[i][0], rc[i][1], rc[i][2], rc[i][3], 0.08838834764831845f, o1, o2);
            *(u32x4*)(ks_ + j * RP + d0) = pack8(o1); *(u32x4*)(ks_ + j * RP + 64 + d0) = pack8(o2);
        }
#pragma unroll
        for (int i = 0; i < 4; ++i) { const int item = tid + 512 * i; scatter_vT(vv[i], item >> 4, (item & 15) * 8, vT); }
        {
            const int dv = tid >> 2, sg = tid & 3;
#pragma unroll
            for (int i = 0; i < 4; ++i) *(u32x4*)(ST + dv * RP + sg * 32 + 8 * i) = st[i];
        }
#pragma unroll
        for (int kk = 0; kk < 2; ++kk) {
            float o1[8], o2[8];
            rot8v(qA[kk], qB[kk], qc[kk][0], qc[kk][1], qc[kk][2], qc[kk][3], 1.f, o1, o2);
            const u32x4 a = pack8(o1), c = pack8(o2);
            qf[kk] = __builtin_bit_cast(bf16x8, a); qf[kk + 2] = __builtin_bit_cast(bf16x8, c);
        }
    }
    __syncthreads();
#pragma unroll
    for (int jb = 0; jb < 8; ++jb) {
        u32x2 o; o.x = 0u; o.y = 0u;
        if (jb <= w) {
            f32x4 sc = (f32x4){0.f, 0.f, 0.f, 0.f};
#pragma unroll
            for (int kk = 0; kk < 4; ++kk) {
                const bf16x8 a = *(const bf16x8*)(ks_ + (16 * jb + fr) * RP + 32 * kk + 8 * fq);
                sc = __builtin_amdgcn_mfma_f32_16x16x32_bf16(a, qf[kk], sc, 0, 0, 0);
            }
            float pv[4];
#pragma unroll
            for (int r = 0; r < 4; ++r) { const int dj = i_loc - (16 * jb + 4 * fq + r); pv[r] = dj >= 0 ? sc[r] * fexp2(lg * (float)dj) : 0.f; }
            o.x = cvt_pk_bf16(pv[0], pv[1]); o.y = cvt_pk_bf16(pv[2], pv[3]);
        }
        *(u32x2*)(P + i_loc * RP + 16 * jb + 4 * fq) = o;
    }
    __syncthreads();
    f32x4 a1[8], a2[8];
#pragma unroll
    for (int vb = 0; vb < 8; ++vb) { a1[vb] = (f32x4){0.f, 0.f, 0.f, 0.f}; a2[vb] = (f32x4){0.f, 0.f, 0.f, 0.f}; }
    for (int kk = 0; kk <= (w >> 1); ++kk) {
        const bf16x8 pb = *(const bf16x8*)(P + i_loc * RP + 32 * kk + 8 * fq);
#pragma unroll
        for (int vb = 0; vb < 8; ++vb) {
            const bf16x8 a = *(const bf16x8*)(vT + (16 * vb + fr) * RP + 32 * kk + 8 * fq);
            a1[vb] = __builtin_amdgcn_mfma_f32_16x16x32_bf16(a, pb, a1[vb], 0, 0, 0);
        }
    }
#pragma unroll
    for (int kk = 0; kk < 4; ++kk) {
#pragma unroll
        for (int vb = 0; vb < 8; ++vb) {
            const bf16x8 a = *(const bf16x8*)(ST + (16 * vb + fr) * RP + 32 * kk + 8 * fq);
            a2[vb] = __builtin_amdgcn_mfma_f32_16x16x32_bf16(a, qf[kk], a2[vb], 0, 0, 0);
        }
    }
    const float qd = fexp2(lg * (float)(i_loc + 1));
    float sum = 0.f;
#pragma unroll
    for (int vb = 0; vb < 8; ++vb) { a1[vb] = a1[vb] + qd * a2[vb]; sum += (a1[vb].x + a1[vb].y) + (a1[vb].z + a1[vb].w); }
    sum += __shfl_xor(sum, 16); sum += __shfl_xor(sum, 32);
    const float mu = sum * (1.f / 128.f);
    float var = 0.f;
#pragma unroll
    for (int vb = 0; vb < 8; ++vb) { const f32x4 d = a1[vb] - mu; var += (d.x * d.x + d.y * d.y) + (d.z * d.z + d.w * d.w); }
    var += __shfl_xor(var, 16); var += __shfl_xor(var, 32);
    const float rstd = __builtin_amdgcn_rsqf(var * (1.f / 128.f) + EPS);
    const bf16_t* gr = proj + (size_t)(row0 + i_loc) * DP + 1536 + h * 128 + 4 * fq;
    bf16_t* orow = mix + (size_t)(row0 + i_loc) * D + h * 128 + 4 * fq;
#pragma unroll
    for (int vb = 0; vb < 8; ++vb) {
        const u32x2 g = *(const u32x2*)(gr + 16 * vb);
        const f32x4 d = (a1[vb] - mu) * rstd;
        u32x2 o; o.x = cvt_pk_bf16(d.x * siluf_(bflo(g.x)), d.y * siluf_(bfhi(g.x))); o.y = cvt_pk_bf16(d.z * siluf_(bflo(g.y)), d.w * siluf_(bfhi(g.y)));
        *(u32x2*)(orow + 16 * vb) = o;
    }
    __syncthreads();
}

#define LBAR() do { asm volatile("s_waitcnt lgkmcnt(0)" ::: "memory"); __builtin_amdgcn_s_barrier(); asm volatile("" ::: "memory"); } while (0)
template <bool FINAL>
DEV void lru_phase(const Params& p) {
    unsigned char* ws = p.ws;
    const bf16_t* proj = (const bf16_t*)(ws + W_PROJ); bf16_t* mix = (bf16_t*)(ws + W_MIX); const bf16_t* WrT = (const bf16_t*)(ws + W_WRT);
    const float* spl = (const float*)(ws + W_SPL); float* agg = (float*)(ws + W_AGG); const float* hin0g = (const float*)(ws + W_HIN0);
    float* xcf = (float*)shm_raw;
    constexpr int XP = 68;
    float* af = xcf + 128 * XP;
    bf16_t* xcb = (bf16_t*)(af + 128 * XP);
    float* segA = (float*)(xcb + 128 * 72);
    float* segB = segA + 512;
    float* hin = segB + 512;
    bf16_t* wT = (bf16_t*)(hin + 512);
    float* cwL = (float*)(wT + 2 * 64 * 72);
    bf16_t* gbuf = (bf16_t*)(cwL + 8 * 64);
    const int tid = TIDX(), w = tid >> 6, lane = tid & 63, fr = lane & 15, fq = lane >> 4;
    const int tt = tid >> 2, e0 = (tid & 3) * 16;
    int key = -1;
    u32x4 xr[4][2]; u32x4 gr[2]; float h0 = 0.f;
    auto prefetch = [&](int unit) {
        const int c = unit & 15, jb = (unit >> 4) & 7, b = unit >> 7, ch0 = 64 * jb;
#pragma unroll
        for (int k = 0; k < 4; ++k) {
            const int tabs = c * 128 + tt - 3 + k;
            xr[k][0] = (u32x4){0u, 0u, 0u, 0u}; xr[k][1] = xr[k][0];
            if (tabs >= 0) { const bf16_t* xp = proj + (size_t)(b * TSEQ + tabs) * DP + 2048 + ch0 + e0; xr[k][0] = *(const u32x4*)xp; xr[k][1] = *(const u32x4*)(xp + 8); }
        }
        if (FINAL) {
            const bf16_t* gp = proj + (size_t)(b * TSEQ + c * 128 + tt) * DP + 2560 + ch0 + e0; gr[0] = *(const u32x4*)gp; gr[1] = *(const u32x4*)(gp + 8);
            if (tid < 64) h0 = hin0g[(size_t)unit * 64 + tid];
        }
    };
    int it = BIDX();
    if (it < 1024) prefetch(it);
    for (; it < 1024; it += gridDim.x) {
        const int unit = it, c = unit & 15, jb = (unit >> 4) & 7, b = unit >> 7, row0 = b * TSEQ + c * 128, ch0 = 64 * jb;
        if ((unit & 127) != key) {
            key = unit & 127;
            { const int g = tid >> 8, e = (tid >> 2) & 63, sg = tid & 3; const bf16_t* src = WrT + (size_t)((g * 8 + jb) * 64 + e) * 64 + sg * 16;
              *(u32x4*)(wT + (g * 64 + e) * 72 + sg * 16) = *(const u32x4*)src; *(u32x4*)(wT + (g * 64 + e) * 72 + sg * 16 + 8) = *(const u32x4*)(src + 8); }
            { const int q = tid >> 6, e = tid & 63; float v;
              if (q < 4) v = p.cl_w[q * DLRU + ch0 + e]; else if (q == 4) v = p.cl_b[ch0 + e]; else if (q == 5) v = p.b_r[ch0 + e]; else if (q == 6) v = p.b_i[ch0 + e]; else v = spl[ch0 + e];
              cwL[q * 64 + e] = v; }
            LBAR();
        }
        {
            float accv[16];
#pragma unroll
            for (int i = 0; i < 4; ++i) { const f32x4 cb = *(const f32x4*)(cwL + 4 * 64 + e0 + 4 * i); accv[4 * i] = cb.x; accv[4 * i + 1] = cb.y; accv[4 * i + 2] = cb.z; accv[4 * i + 3] = cb.w; }
#pragma unroll
            for (int k = 0; k < 4; ++k) {
                float xv[16]; unpack8(xr[k][0], xv); unpack8(xr[k][1], xv + 8);
#pragma unroll
                for (int i = 0; i < 4; ++i) { const f32x4 cw = *(const f32x4*)(cwL + k * 64 + e0 + 4 * i);
                    accv[4 * i] += cw.x * xv[4 * i]; accv[4 * i + 1] += cw.y * xv[4 * i + 1]; accv[4 * i + 2] += cw.z * xv[4 * i + 2]; accv[4 * i + 3] += cw.w * xv[4 * i + 3]; }
            }
#pragma unroll
            for (int i = 0; i < 4; ++i) *(f32x4*)(xcf + tt * XP + e0 + 4 * i) = (f32x4){accv[4 * i], accv[4 * i + 1], accv[4 * i + 2], accv[4 * i + 3]};
            *(u32x4*)(xcb + tt * 72 + e0) = pack8(accv); *(u32x4*)(xcb + tt * 72 + e0 + 8) = pack8(accv + 8);
            if (FINAL) { *(u32x4*)(gbuf + tt * 64 + e0) = gr[0]; *(u32x4*)(gbuf + tt * 64 + e0 + 8) = gr[1]; }
        }
        const float h0u = h0;
        if (it + (int)gridDim.x < 1024) prefetch(it + gridDim.x);
        LBAR();
        {
            const int t = 16 * w + fr;
            bf16x8 xb[2];
#pragma unroll
            for (int kk = 0; kk < 2; ++kk) xb[kk] = *(const bf16x8*)(xcb + t * 72 + 32 * kk + 8 * fq);
            const bool first = (c == 0 && t == 0);
#pragma unroll
            for (int eb = 0; eb < 4; ++eb) {
                f32x4 ar = (f32x4){0.f, 0.f, 0.f, 0.f}, ai = (f32x4){0.f, 0.f, 0.f, 0.f};
#pragma unroll
                for (int kk = 0; kk < 2; ++kk) {
                    const bf16x8 wr_ = *(const bf16x8*)(wT + (16 * eb + fr) * 72 + 32 * kk + 8 * fq);
                    const bf16x8 wi_ = *(const bf16x8*)(wT + (64 + 16 * eb + fr) * 72 + 32 * kk + 8 * fq);
                    ar = __builtin_amdgcn_mfma_f32_16x16x32_bf16(wr_, xb[kk], ar, 0, 0, 0);
                    ai = __builtin_amdgcn_mfma_f32_16x16x32_bf16(wi_, xb[kk], ai, 0, 0, 0);
                }
                const int e = 16 * eb + 4 * fq;
                const f32x4 br = *(const f32x4*)(cwL + 5 * 64 + e), bi = *(const f32x4*)(cwL + 6 * 64 + e), sp = *(const f32x4*)(cwL + 7 * 64 + e);
                const f32x4 xc4 = *(const f32x4*)(xcf + t * XP + e);
                f32x4 av, bv;
#pragma unroll
                for (int r = 0; r < 4; ++r) {
                    const float rr = sigmoidf_(ar[r] + br[r]), ii = sigmoidf_(ai[r] + bi[r]);
                    const float la = -sp[r] * rr, a = fexp2(1.4426950408889634f * la), x2 = 2.f * la;
                    const float em = -x2 * (1.f + 0.5f * x2 * (1.f + (1.f / 3.f) * x2 * (1.f + 0.25f * x2 * (1.f + 0.2f * x2 * (1.f + (1.f / 6.f) * x2)))));
                    const float mult = first ? 1.f : __builtin_amdgcn_sqrtf(em);
                    av[r] = a; bv[r] = mult * ii * xc4[r];
                }
                *(f32x4*)(af + t * XP + e) = av; *(f32x4*)(xcf + t * XP + e) = bv;
            }
        }
        LBAR();
        const int e = tid & 63, seg = tid >> 6;
        {
            float A = 1.f, B = 0.f;
#pragma unroll
            for (int i = 0; i < 16; ++i) { const int t = seg * 16 + i; const float a = af[t * XP + e]; B = a * B + xcf[t * XP + e]; A *= a; }
            segA[seg * 64 + e] = A; segB[seg * 64 + e] = B;
        }
        LBAR();
        if (!FINAL) {
            if (tid < 64) {
                float A = 1.f, B = 0.f;
#pragma unroll
                for (int s = 0; s < 8; ++s) { const float a = segA[s * 64 + tid]; B = a * B + segB[s * 64 + tid]; A *= a; }
                agg[(size_t)unit * 128 + tid] = A; agg[(size_t)unit * 128 + 64 + tid] = B;
            }
        } else {
            if (tid < 64) {
                float hh = h0u;
#pragma unroll
                for (int s = 0; s < 8; ++s) { hin[s * 64 + tid] = hh; hh = segA[s * 64 + tid] * hh + segB[s * 64 + tid]; }
            }
            LBAR();
            float hh = hin[seg * 64 + e];
#pragma unroll
            for (int i = 0; i < 16; ++i) {
                const int t = seg * 16 + i;
                hh = af[t * XP + e] * hh + xcf[t * XP + e];
                gbuf[t * 64 + e] = f2bf(hh * geluf_(bf2f(gbuf[t * 64 + e])));
            }
            if (c == 15 && seg == 7) {
                p.out[O_LHP + b * 512 + ch0 + e] = hh;
#pragma unroll
                for (int k = 0; k < 3; ++k) p.out[O_LCP + (size_t)(b * 3 + k) * 512 + ch0 + e] = bf2f(proj[(size_t)(b * TSEQ + 2045 + k) * DP + 2048 + ch0 + e]);
            }
            LBAR();
            { bf16_t* op = mix + (size_t)(row0 + tt) * D + 512 + ch0 + e0; *(u32x4*)op = *(const u32x4*)(gbuf + tt * 64 + e0); *(u32x4*)(op + 8) = *(const u32x4*)(gbuf + tt * 64 + e0 + 8); }
        }
        LBAR();
    }
    __syncthreads();
}

DEV void phase_scan(const Params& p) {
    unsigned char* ws = p.ws;
    const float* KVT = (const float*)(ws + W_KVT); bf16_t* STg = (bf16_t*)(ws + W_H);
    const float* agg = (const float*)(ws + W_AGG); float* hin0g = (float*)(ws + W_HIN0);
    const int gt = BIDX() * 512 + TIDX(), GT = gridDim.x * 512;
    for (int gid = gt; gid < 32 * 4096; gid += GT) {
        const int bh = gid >> 12, idx = gid & 4095, dv = idx >> 5, dk0 = (idx & 31) * 4, h = bh & 3;
        const float cd = exp2f(gamma_log2(h) * 128.f);
        const float* src = KVT + (size_t)bh * 16 * 16384 + dv * 128 + dk0;
        f32x4 kv[16];
#pragma unroll
        for (int m = 0; m < 16; ++m) kv[m] = *(const f32x4*)(src + (size_t)m * 16384);
        f32x4 S = (f32x4){0.f, 0.f, 0.f, 0.f};
        bf16_t* dst = STg + (size_t)bh * 16 * 16384 + dv * 128 + dk0;
#pragma unroll
        for (int m = 0; m < 16; ++m) {
            u32x2 o; o.x = cvt_pk_bf16(S.x, S.y); o.y = cvt_pk_bf16(S.z, S.w);
            *(u32x2*)(dst + (size_t)m * 16384) = o;
            S = S * cd + kv[m];
        }
        float* rp = p.out + O_RETP + (size_t)bh * 16384 + dv;
        rp[(dk0 + 0) * 128] = S.x; rp[(dk0 + 1) * 128] = S.y; rp[(dk0 + 2) * 128] = S.z; rp[(dk0 + 3) * 128] = S.w;
    }
    for (int gid = gt; gid < 64 * 64; gid += GT) {
        const int bjb = gid >> 6, e = gid & 63;
        float A[16], B[16];
#pragma unroll
        for (int c = 0; c < 16; ++c) { A[c] = agg[(size_t)(bjb * 16 + c) * 128 + e]; B[c] = agg[(size_t)(bjb * 16 + c) * 128 + 64 + e]; }
        float hh = 0.f;
#pragma unroll
        for (int c = 0; c < 16; ++c) { hin0g[(size_t)(bjb * 16 + c) * 64 + e] = hh; hh = A[c] * hh + B[c]; }
    }
}

DEV void sample_ret2(const Params& p, int unit) {
    unsigned char* ws = p.ws;
    const float* projS = (const float*)(ws + W_PROJS); const float* rope = (const float*)(ws + W_ROPE) + (size_t)TSEQ * 128; bf16_t* mix = (bf16_t*)(ws + W_MIX);
    const int h = unit & 3, b = unit >> 2, tid = TIDX();
    float* qs = (float*)shm_raw; float* ks = qs + 128; float* vs = ks + 128; float* part = vs + 128;
    float* red = part + 16 * 128;
    const float* pr = projS + (size_t)b * DP;
    const float gam = 1.f - exp2f(-5.f - (float)h);
    if (tid < 64) {
        const float c = rope[tid], s = rope[64 + tid];
        const float q1 = pr[h * 128 + tid], q2 = pr[h * 128 + 64 + tid], k1 = pr[512 + h * 128 + tid], k2 = pr[512 + h * 128 + 64 + tid];
        const float qa = q1 * c - q2 * s, qb = q1 * s + q2 * c, ka = (k1 * c - k2 * s) * 0.08838834764831845f, kb = (k1 * s + k2 * c) * 0.08838834764831845f;
        qs[tid] = qa; qs[64 + tid] = qb; ks[tid] = ka; ks[64 + tid] = kb;
        const float qkp = wave_sum(qa * ka + qb * kb);
        if (tid == 0) red[4] = qkp;
    } else if (tid < 192) vs[tid - 64] = pr[1024 + h * 128 + tid - 64];
    __syncthreads();
    {
        const int dv4 = (tid & 31) * 4, dkg = tid >> 5;
        const f32x4 v4 = *(const f32x4*)(vs + dv4);
        const float* S0 = p.st_ret + (size_t)unit * 16384; float* S1 = p.out + O_RETS + (size_t)unit * 16384;
        f32x4 po = (f32x4){0.f, 0.f, 0.f, 0.f};
#pragma unroll
        for (int i = 0; i < 8; ++i) {
            const int dk = dkg * 8 + i;
            const f32x4 s0 = *(const f32x4*)(S0 + dk * 128 + dv4);
            *(f32x4*)(S1 + dk * 128 + dv4) = s0 * gam + ks[dk] * v4;
            po = po + qs[dk] * s0;
        }
        *(f32x4*)(part + dkg * 128 + dv4) = po;
    }
    __syncthreads();
    float o = 0.f;
    if (tid < 128) {
        const float qk = red[4];
#pragma unroll
        for (int g = 0; g < 16; ++g) o += part[g * 128 + tid];
        o = qk * vs[tid] + gam * o;
        const float s1 = wave_sum(o);
        if ((tid & 63) == 0) red[tid >> 6] = s1;
    }
    __syncthreads();
    float mu = 0.f, dlt = 0.f;
    if (tid < 128) {
        mu = (red[0] + red[1]) * (1.f / 128.f); dlt = o - mu;
        const float s2 = wave_sum(dlt * dlt);
        if ((tid & 63) == 0) red[2 + (tid >> 6)] = s2;
    }
    __syncthreads();
    if (tid < 128) {
        const float rstd = __builtin_amdgcn_rsqf((red[2] + red[3]) * (1.f / 128.f) + EPS);
        const float g = pr[1536 + h * 128 + tid];
        mix[(size_t)(NTOK + b) * D + h * 128 + tid] = f2bf(dlt * rstd * siluf_(g));
    }
    __syncthreads();
}

DEV void sample_lru(const Params& p, int b) {
    unsigned char* ws = p.ws;
    const float* projS = (const float*)(ws + W_PROJS); bf16_t* mix = (bf16_t*)(ws + W_MIX); const float* spl = (const float*)(ws + W_SPL);
    float* xcS = (float*)shm_raw;
    const int ch = TIDX();
    const float* pr = projS + (size_t)b * DP;
    const float s0 = p.st_cl[(size_t)(b * 3 + 0) * 512 + ch], s1 = p.st_cl[(size_t)(b * 3 + 1) * 512 + ch], s2 = p.st_cl[(size_t)(b * 3 + 2) * 512 + ch], x = pr[2048 + ch];
    const float xc = p.cl_b[ch] + p.cl_w[ch] * s0 + p.cl_w[512 + ch] * s1 + p.cl_w[1024 + ch] * s2 + p.cl_w[1536 + ch] * x;
    xcS[ch] = xc;
    __syncthreads();
    const int jb = ch >> 6, e = ch & 63;
    float pr_ = 0.f, pi_ = 0.f;
    const float* wr = p.w_r + (size_t)jb * 4096 + e; const float* wi = p.w_i + (size_t)jb * 4096 + e;
#pragma unroll 8
    for (int d = 0; d < 64; ++d) { const float xv = xcS[64 * jb + d]; pr_ += xv * wr[d * 64]; pi_ += xv * wi[d * 64]; }
    const float rr = sigmoidf_(pr_ + p.b_r[ch]), ii = sigmoidf_(pi_ + p.b_i[ch]);
    const float la = -spl[ch] * rr, a = __expf(la), mult = sqrtf(-expm1f(2.f * la));
    const float hh = a * p.st_h[(size_t)b * 512 + ch] + mult * ii * xc;
    p.out[O_LHS + (size_t)b * 512 + ch] = hh;
    p.out[O_LCS + (size_t)(b * 3 + 0) * 512 + ch] = s1; p.out[O_LCS + (size_t)(b * 3 + 1) * 512 + ch] = s2; p.out[O_LCS + (size_t)(b * 3 + 2) * 512 + ch] = x;
    mix[(size_t)(NTOK + b) * D + 512 + ch] = f2bf(hh * geluf_(pr[2560 + ch]));
    __syncthreads();
}

DEV void phase_mixA(const Params& p) {
    constexpr int N1 = 512, N3 = 512, N4 = 128;
    {
        const float* mod = (const float*)(p.ws + W_MOD); bf16_t* shf = (bf16_t*)(p.ws + W_SHF);
        const int gt = BIDX() * 512 + TIDX(), GT = gridDim.x * 512;
        for (int i = gt; i < NMODROWS * D; i += GT) { const int row = i >> 10, k = i & 1023; shf[i] = f2bf(row < 136 ? mod[(size_t)row * 6144 + 3 * D + k] : 0.f); }
    }
    lru_phase<false>(p);
    for (int it = BIDX(); it < N1 + N3 + N4; it += gridDim.x) {
        if (it < N1) ret_passA(p, it);
        else if (it < N1 + N3) sample_ret2(p, it - N1);
        else sample_lru(p, it - N1 - N3);
    }
}
DEV void phase_mixC(const Params& p) {
    constexpr int N1 = 512;
    lru_phase<true>(p);
    for (int it = BIDX(); it < N1; it += gridDim.x) {
        { const int u = it; const int n = u & 15; const int nn = (((u >> 4) ^ (u >> 8)) & 1) ? 15 - n : n; ret_passC(p, (u & ~15) | nn); }
    }
}

DEV void phase_outproj(const Params& p) {
    unsigned char* ws = p.ws;
    const bf16_t* mix = (const bf16_t*)(ws + W_MIX); const bf16_t* BtOut = (const bf16_t*)(ws + W_BTOUT); bf16_t* xs = (bf16_t*)(ws + W_H);
    const float* mod = (const float*)(ws + W_MOD); float* rss1 = (float*)(ws + W_RSS1);
    constexpr int NBIG = 64 * 4;
    gemm_phase<false>(mix, BtOut, D, 64, 4, NBIG, nullptr, [&](const f32x4 (&acc)[2][2][4][2], int pm, int pn, int brow, int bcol, int wr, int wc, int fr, int fq) {
                const int b = brow >> 11;
                const float* mrow = mod + (size_t)b * 6144;
                f32x4 gt[2][2], sf[2][2];
#pragma unroll
                for (int bj = 0; bj < 2; ++bj)
#pragma unroll
                    for (int n = 0; n < 2; ++n) {
                        const int col = bcol + bj * HALF + wc * 32 + 8 * fq + 4 * n;
                        gt[bj][n] = *(const f32x4*)(mrow + 2 * D + col);
                        sf[bj][n] = *(const f32x4*)(p.g_ffn + col) * (1.f + *(const f32x4*)(mrow + 4 * D + col));
                    }
#pragma unroll
                for (int ai = 0; ai < 2; ++ai)
#pragma unroll
                    for (int m = 0; m < 4; ++m) {
                        const int row = brow + ai * HALF + wr * 64 + m * 16 + fr;
                        float ss = 0.f;
#pragma unroll
                        for (int bj = 0; bj < 2; ++bj) {
                            const int col = bcol + bj * HALF + wc * 32 + 8 * fq;
                            f32x4 y[2];
#pragma unroll
                            for (int n = 0; n < 2; ++n) {
                                y[n] = *(const f32x4*)(p.x_p + (size_t)row * D + col + 4 * n) + gt[bj][n] * acc[ai][bj][m][n];
                                ss += (y[n].x * y[n].x + y[n].y * y[n].y) + (y[n].z * y[n].z + y[n].w * y[n].w);
                                y[n] = y[n] * sf[bj][n];
                            }
                            u32x4 w; w.x = cvt_pk_bf16(y[0].x, y[0].y); w.y = cvt_pk_bf16(y[0].z, y[0].w); w.z = cvt_pk_bf16(y[1].x, y[1].y); w.w = cvt_pk_bf16(y[1].z, y[1].w);
                            *(u32x4*)(xs + (size_t)row * D + col) = w;
                        }
                        ss += __shfl_xor(ss, 16); ss += __shfl_xor(ss, 32);
                        if (fq == 0) atomicAdd(rss1 + row, ss);
                    }
            });
    const bf16_t* BtUp = (const bf16_t*)(ws + W_BTUP); const bf16_t* shf = (const bf16_t*)(ws + W_SHF); float* sW = (float*)(ws + W_SW);
    SKINNY_LOOP(j, NBIG, 64 + 176) {
        if (j < 64) {
            const int g = j >> 1, n = j & 1;
            const bf16_t* B0 = BtOut + (size_t)(32 * g + 16 * n) * D;
            skinny_tile<8, 1, 4>(mix + (size_t)NTOK * D, D, B0, B0, D, [&](int row, int s, float v0, float v1) {
                const float* mrow = mod + (size_t)(8 + row) * 6144;
                const int c0 = 32 * g + slotcol(n, s);
                const float y0 = p.x_s[(size_t)row * D + c0] + mrow[2 * D + c0] * v0;
                p.out[O_YS + (size_t)row * D + c0] = y0;
                xs[(size_t)(NTOK + row) * D + c0] = f2bf(y0 * p.g_ffn[c0] * (1.f + mrow[4 * D + c0]));
                return y0 * y0;
            }, [&](int row, float ss) { atomicAdd(rss1 + NTOK + row, ss); });
        } else {
            const int t = j - 64, pn = t >> 3, bj = (t >> 2) & 1, g4 = t & 3;
            const bf16_t* B0 = BtUp + (size_t)(256 * pn + 128 * bj + 32 * g4) * D;
            skinny_tile<9, 2, 4>(shf, D, B0, B0 + 16 * D, D, [&](int row, int s, float v0, float v1) {
                const int c0 = bj * DFF + 128 * pn + 32 * g4 + slotcol(0, s); sW[(size_t)row * (2 * DFF) + c0] = v0; sW[(size_t)row * (2 * DFF) + c0 + 4] = v1; return 0.f;
            });
        }
    }
}

DEV void phase_up(const Params& p) {
    unsigned char* ws = p.ws;
    const bf16_t* xs = (const bf16_t*)(ws + W_H); const bf16_t* BtUp = (const bf16_t*)(ws + W_BTUP); bf16_t* fin = (bf16_t*)(ws + W_PROJ);
    const float* sW = (const float*)(ws + W_SW); const float* rss1 = (const float*)(ws + W_RSS1);
    float* edgeU = (float*)(ws + W_EDGEU); float* edgeG = (float*)(ws + W_EDGEG); float* tailU = (float*)(ws + W_TAILU);
    constexpr int NBIG = 64 * 22, NSK = 176;
    gemm_phase<false>(xs, BtUp, D, 64, 22, NBIG, nullptr, [&](f32x4 (&acc)[2][2][4][2], int pm, int pn, int brow, int bcol, int wr, int wc, int fr, int fq) {
        float* halo = (float*)(shm_raw + 131072);
        const int b = brow >> 11;
        const int ff0 = 128 * pn + wc * 32 + 8 * fq;
        const int cl0 = wc * 32 + 8 * fq;
        {
            f32x4 swc[2], swg[2];
#pragma unroll
            for (int n = 0; n < 2; ++n) { swc[n] = *(const f32x4*)(sW + (size_t)b * (2 * DFF) + ff0 + 4 * n); swg[n] = *(const f32x4*)(sW + (size_t)b * (2 * DFF) + DFF + ff0 + 4 * n); }
#pragma unroll
            for (int ai = 0; ai < 2; ++ai)
#pragma unroll
                for (int m = 0; m < 4; ++m) {
                    const int rl = ai * HALF + wr * 64 + m * 16 + fr;
                    const float rstd = __builtin_amdgcn_rsqf(rss1[brow + rl] * (1.f / D) + EPS);
#pragma unroll
                    for (int n = 0; n < 2; ++n) { acc[ai][0][m][n] = acc[ai][0][m][n] * rstd + swc[n]; acc[ai][1][m][n] = acc[ai][1][m][n] * rstd + swg[n]; }
                }
        }
        if (fr >= 14) {
#pragma unroll
            for (int ai = 0; ai < 2; ++ai)
#pragma unroll
                for (int n = 0; n < 2; ++n) *(f32x4*)(halo + ((ai * 2 + wr) * 2 + fr - 14) * 128 + cl0 + 4 * n) = acc[ai][0][3][n];
        }
        __syncthreads();
        {
            f32x4 cw0[2], cw1[2], cw2[2], cb[2];
#pragma unroll
            for (int n = 0; n < 2; ++n) {
                cw0[n] = *(const f32x4*)(p.cf_w + ff0 + 4 * n); cw1[n] = *(const f32x4*)(p.cf_w + DFF + ff0 + 4 * n); cw2[n] = *(const f32x4*)(p.cf_w + 2 * DFF + ff0 + 4 * n);
                cb[n] = *(const f32x4*)(p.cf_b + ff0 + 4 * n);
            }
#pragma unroll
            for (int ai = 0; ai < 2; ++ai) {
                const int st = ai * 2 + wr;
                f32x4 um1[2];
#pragma unroll
                for (int n = 0; n < 2; ++n) {
                    um1[n] = (f32x4){0.f, 0.f, 0.f, 0.f};
                    if (st > 0 && fr >= 14) um1[n] = *(const f32x4*)(halo + ((st - 1) * 2 + fr - 14) * 128 + cl0 + 4 * n);
                }
#pragma unroll
                for (int m = 0; m < 4; ++m) {
                    const int rl = ai * HALF + wr * 64 + m * 16 + fr;
                    unsigned wv[4];
#pragma unroll
                    for (int n = 0; n < 2; ++n) {
                        const f32x4 u = acc[ai][0][m][n], g = acc[ai][1][m][n];
                        f32x4 p1, p2;
#pragma unroll
                        for (int c = 0; c < 4; ++c) { p1[c] = dpp_shr1(dpp_ror1(um1[n][c]), u[c]); p2[c] = dpp_shr2(dpp_ror2(um1[n][c]), u[c]); }
                        const f32x4 uc = cb[n] + cw0[n] * p2 + cw1[n] * p1 + cw2[n] * u;
                        wv[2 * n] = cvt_pk_bf16(geluf_(uc.x) * g.x, geluf_(uc.y) * g.y); wv[2 * n + 1] = cvt_pk_bf16(geluf_(uc.z) * g.z, geluf_(uc.w) * g.w);
                        um1[n] = u;
                    }
                    if (rl >= 2) {
                        u32x4 w; w.x = wv[0]; w.y = wv[1]; w.z = wv[2]; w.w = wv[3];
                        *(u32x4*)(fin + (size_t)(brow + rl) * DFF + ff0) = w;
                    } else {
#pragma unroll
                        for (int n = 0; n < 2; ++n) {
                            *(f32x4*)(edgeU + (size_t)(pm * 2 + rl) * DFF + ff0 + 4 * n) = acc[ai][0][m][n];
                            *(f32x4*)(edgeG + (size_t)(pm * 2 + rl) * DFF + ff0 + 4 * n) = acc[ai][1][m][n];
                        }
                    }
                    if (rl >= 254) {
#pragma unroll
                        for (int n = 0; n < 2; ++n) {
                            *(f32x4*)(tailU + (size_t)(pm * 2 + rl - 254) * DFF + ff0 + 4 * n) = acc[ai][0][m][n];
                            if ((pm & 7) == 7) *(f32x4*)(p.out + O_FCP + (size_t)(b * 2 + rl - 254) * DFF + ff0 + 4 * n) = acc[ai][0][m][n];
                        }
                    }
                }
            }
        }
    });
    SKINNY_LOOP(j, NBIG, NSK) {
            const int t = j, pn = t >> 3, g4 = (t >> 1) & 3, n = t & 1;
            const bf16_t* B0 = BtUp + (size_t)(256 * pn + 32 * g4 + 16 * n) * D;
            skinny_tile<8, 2, 4>(xs + (size_t)NTOK * D, D, B0, B0 + 128 * D, D, [&](int row, int s, float v0, float v1) {
                const int ff = 128 * pn + 32 * g4 + slotcol(n, s);
                const float rstd = __builtin_amdgcn_rsqf(rss1[NTOK + row] * (1.f / D) + EPS);
                const float u = v0 * rstd + sW[(size_t)(8 + row) * (2 * DFF) + ff], g = v1 * rstd + sW[(size_t)(8 + row) * (2 * DFF) + DFF + ff];
                const float s0 = p.st_cf[(size_t)(row * 2 + 0) * DFF + ff], s1 = p.st_cf[(size_t)(row * 2 + 1) * DFF + ff];
                const float uc = p.cf_b[ff] + p.cf_w[ff] * s0 + p.cf_w[DFF + ff] * s1 + p.cf_w[2 * DFF + ff] * u;
                fin[(size_t)(NTOK + row) * DFF + ff] = f2bf(geluf_(uc) * g);
                p.out[O_FCS + (size_t)(row * 2 + 0) * DFF + ff] = s1; p.out[O_FCS + (size_t)(row * 2 + 1) * DFF + ff] = u; return 0.f;
            });
    }
}

DEV void phase_down(const Params& p) {
    unsigned char* ws = p.ws;
    const bf16_t* fin = (const bf16_t*)(ws + W_PROJ); const bf16_t* BtDown = (const bf16_t*)(ws + W_BTDOWN);
    const float* mod = (const float*)(ws + W_MOD); float* rss2 = (float*)(ws + W_RSS2);
    const float* edgeU = (const float*)(ws + W_EDGEU); const float* edgeG = (const float*)(ws + W_EDGEG); const float* tailU = (const float*)(ws + W_TAILU);
    constexpr int NBIG = 64 * 4;
    for (int it = BIDX(); it < NBIG; it += gridDim.x) {
        int pm, pn; tile_order(it, 64, 4, pm, pn);
        bf16_t* fix = (bf16_t*)(ws + W_FIX) + (size_t)it * 2 * DFF;
            {
                const bool hp = (pm & 7) != 0;
                for (int i = TIDX(); i < DFF / 4; i += 512) {
                    const int ff = 4 * i;
                    const f32x4 z = (f32x4){0.f, 0.f, 0.f, 0.f};
                    const f32x4 um1 = hp ? *(const f32x4*)(tailU + (size_t)((pm - 1) * 2 + 1) * DFF + ff) : z, um2 = hp ? *(const f32x4*)(tailU + (size_t)((pm - 1) * 2 + 0) * DFF + ff) : z;
                    const f32x4 u0 = *(const f32x4*)(edgeU + (size_t)(pm * 2) * DFF + ff), u1 = *(const f32x4*)(edgeU + (size_t)(pm * 2 + 1) * DFF + ff);
                    const f32x4 g0 = *(const f32x4*)(edgeG + (size_t)(pm * 2) * DFF + ff), g1 = *(const f32x4*)(edgeG + (size_t)(pm * 2 + 1) * DFF + ff);
                    const f32x4 cb = *(const f32x4*)(p.cf_b + ff), w0 = *(const f32x4*)(p.cf_w + ff), w1 = *(const f32x4*)(p.cf_w + DFF + ff), w2 = *(const f32x4*)(p.cf_w + 2 * DFF + ff);
                    const f32x4 c0 = cb + w0 * um2 + w1 * um1 + w2 * u0, c1 = cb + w0 * um1 + w1 * u0 + w2 * u1;
                    u32x2 o0, o1;
                    o0.x = cvt_pk_bf16(geluf_(c0.x) * g0.x, geluf_(c0.y) * g0.y); o0.y = cvt_pk_bf16(geluf_(c0.z) * g0.z, geluf_(c0.w) * g0.w);
                    o1.x = cvt_pk_bf16(geluf_(c1.x) * g1.x, geluf_(c1.y) * g1.y); o1.y = cvt_pk_bf16(geluf_(c1.z) * g1.z, geluf_(c1.w) * g1.w);
                    *(u32x2*)(fix + ff) = o0; *(u32x2*)(fix + DFF + ff) = o1;
                }
            }
    }
    asm volatile("s_waitcnt vmcnt(0)" ::: "memory");
    __syncthreads();
    gemm_phase<true>(fin, BtDown, DFF, 64, 4, NBIG, (const bf16_t*)(ws + W_FIX), [&](f32x4 (&acc)[2][2][4][2], int pm, int pn, int brow, int bcol, int wr, int wc, int fr, int fq) {
        const int b = brow >> 11;
        const float* mrow = mod + (size_t)b * 6144;
        const bf16_t* xs = (const bf16_t*)(ws + W_H);
        const bool fuse = (gridDim.x == 256);
        unsigned* cnt = (unsigned*)(ws + W_BAR) + 3456 + 64 * pm;
        {
            f32x4 gt[2][2], isf[2][2];
#pragma unroll
            for (int bj = 0; bj < 2; ++bj)
#pragma unroll
                for (int n = 0; n < 2; ++n) {
                    const int col = bcol + bj * HALF + wc * 32 + 8 * fq + 4 * n;
                    gt[bj][n] = *(const f32x4*)(mrow + 5 * D + col);
                    const f32x4 sf = *(const f32x4*)(p.g_ffn + col) * (1.f + *(const f32x4*)(mrow + 4 * D + col));
                    isf[bj][n] = (f32x4){__builtin_amdgcn_rcpf(sf.x), __builtin_amdgcn_rcpf(sf.y), __builtin_amdgcn_rcpf(sf.z), __builtin_amdgcn_rcpf(sf.w)};
                }
#pragma unroll
            for (int ai = 0; ai < 2; ++ai)
#pragma unroll
                for (int m = 0; m < 4; ++m) {
                    const int row = brow + ai * HALF + wr * 64 + m * 16 + fr;
                    float ss = 0.f;
#pragma unroll
                    for (int bj = 0; bj < 2; ++bj) {
                        const int col = bcol + bj * HALF + wc * 32 + 8 * fq;
                        float xv[8]; unpack8(*(const u32x4*)(xs + (size_t)row * D + col), xv);
#pragma unroll
                        for (int n = 0; n < 2; ++n) {
                            const f32x4 x1 = (f32x4){xv[4 * n], xv[4 * n + 1], xv[4 * n + 2], xv[4 * n + 3]} * isf[bj][n];
                            const f32x4 y = x1 + gt[bj][n] * acc[ai][bj][m][n];
                            acc[ai][bj][m][n] = y;
                            ss += (y.x * y.x + y.y * y.y) + (y.z * y.z + y.w * y.w);
                        }
                    }
                    ss += __shfl_xor(ss, 16); ss += __shfl_xor(ss, 32);
                    if (fq == 0) atomicAdd(rss2 + row, ss);
                }
        }
        asm volatile("s_waitcnt vmcnt(0)" ::: "memory");
        __syncthreads();
        if (fuse && TIDX() == 0) {
            __hip_atomic_fetch_add(cnt, 1u, __ATOMIC_RELAXED, __HIP_MEMORY_SCOPE_AGENT);
            unsigned sp = 0;
            while (__hip_atomic_load(cnt, __ATOMIC_RELAXED, __HIP_MEMORY_SCOPE_AGENT) < 4u) { __builtin_amdgcn_s_sleep(2); if (++sp > (1u << 22)) break; }
        }
        __syncthreads();
        {
            f32x4 gf[2][2];
#pragma unroll
            for (int bj = 0; bj < 2; ++bj)
#pragma unroll
                for (int n = 0; n < 2; ++n) gf[bj][n] = *(const f32x4*)(p.g_final + bcol + bj * HALF + wc * 32 + 8 * fq + 4 * n);
            float tot[2][4];
#pragma unroll
            for (int ai = 0; ai < 2; ++ai)
#pragma unroll
                for (int m = 0; m < 4; ++m) tot[ai][m] = fuse ? __hip_atomic_load(rss2 + brow + ai * HALF + wr * 64 + m * 16 + fr, __ATOMIC_RELAXED, __HIP_MEMORY_SCOPE_AGENT) : 0.f;
#pragma unroll
            for (int ai = 0; ai < 2; ++ai)
#pragma unroll
                for (int m = 0; m < 4; ++m) {
                    const int row = brow + ai * HALF + wr * 64 + m * 16 + fr;
                    const float rstd = fuse ? __builtin_amdgcn_rsqf(tot[ai][m] * (1.f / D) + EPS) : 1.f;
#pragma unroll
                    for (int bj = 0; bj < 2; ++bj)
#pragma unroll
                        for (int n = 0; n < 2; ++n)
                            *(f32x4*)(p.out + O_YP + (size_t)row * D + bcol + bj * HALF + wc * 32 + 8 * fq + 4 * n) = fuse ? acc[ai][bj][m][n] * rstd * gf[bj][n] : acc[ai][bj][m][n];
                }
        }
    });
    for (int j = BIDX(); j < 32 * 11; j += gridDim.x) {
        const int g = j / 11, ksl = j - g * 11;
        const bf16_t* B0 = BtDown + (size_t)(32 * g) * DFF + ksl * 256;
        float* part = (float*)(ws + W_KVT) + (size_t)ksl * NSMP * D;
        skinny_tile<8, 2, 2>(fin + (size_t)NTOK * DFF + ksl * 256, DFF, B0, B0 + 16 * DFF, 256, [&](int row, int s, float v0, float v1) {
            const int c0 = 32 * g + slotcol(0, s);
            part[(size_t)row * D + c0] = v0; part[(size_t)row * D + c0 + 4] = v1; return 0.f;
        }, NoRowFn(), DFF);
    }
}

DEV void phase_final(const Params& p) {
    const float* rss2 = (const float*)(p.ws + W_RSS2);
    const int gt = BIDX() * 512 + TIDX(), GT = gridDim.x * 512;
    if (gridDim.x != 256)
    for (int i = gt; i < NTOK * 256; i += GT) {
        const int row = i >> 8, k = (i & 255) * 4;
        const float rstd = __builtin_amdgcn_rsqf(rss2[row] * (1.f / D) + EPS);
        f32x4* yp = (f32x4*)(p.out + (size_t)row * D + k);
        *yp = *yp * rstd * *(const f32x4*)(p.g_final + k);
    }
    const float* part = (const float*)(p.ws + W_KVT); const float* mod = (const float*)(p.ws + W_MOD);
    const int lane = TIDX() & 63, gw = BIDX() * 8 + (TIDX() >> 6), NGW = gridDim.x * 8;
    for (int row = gw; row < NSMP; row += NGW) {
        float* yp = p.out + O_YS + (size_t)row * D; const float* mrow = mod + (size_t)(8 + row) * 6144 + 5 * D;
        f32x4 y[4]; float ss = 0.f;
#pragma unroll
        for (int j = 0; j < 4; ++j) {
            const int k = 4 * lane + 256 * j;
            f32x4 a = (f32x4){0.f, 0.f, 0.f, 0.f};
#pragma unroll
            for (int sl = 0; sl < 11; ++sl) a = a + *(const f32x4*)(part + ((size_t)sl * NSMP + row) * D + k);
            y[j] = *(const f32x4*)(yp + k) + *(const f32x4*)(mrow + k) * a;
            ss += y[j].x * y[j].x + y[j].y * y[j].y + y[j].z * y[j].z + y[j].w * y[j].w;
        }
        const float rstd = __builtin_amdgcn_rsqf(wave_sum(ss) * (1.f / D) + EPS);
#pragma unroll
        for (int j = 0; j < 4; ++j) { const int k = 4 * lane + 256 * j; *(f32x4*)(yp + k) = y[j] * rstd * *(const f32x4*)(p.g_final + k); }
    }
}

#define XB_TMO      128
#define XB_XCNT(j)  (256  + 64 * (j))
#define XB_XSUB(j)  (1280 + 64 * (j))
#define XB_XGEN(j)  (2304 + 64 * (j))
#define XB_TOP      3328
#define XB_TOPGEN   3392
#define XCD_BAR_WORDS 3456
#define XB_SPIN_CAP (1u << 20)
DEV unsigned xb_ld(unsigned* p) { return __hip_atomic_load(p, __ATOMIC_RELAXED, __HIP_MEMORY_SCOPE_AGENT); }
DEV unsigned xb_add(unsigned* p, unsigned v) { return __hip_atomic_fetch_add(p, v, __ATOMIC_RELAXED, __HIP_MEMORY_SCOPE_AGENT); }
DEV unsigned xb_xcc_id() { return (unsigned)__builtin_amdgcn_s_getreg((3 << 11) | 20) & 0xFu; }
#define XB_SPIN(cond, bar) do { unsigned _sp = 0; while (cond) { __builtin_amdgcn_s_sleep(1); \
    if ((++_sp & 255u) == 0u) { if (xb_ld(&(bar)[XB_TMO])) break; if (_sp > XB_SPIN_CAP) { atomicAdd(&(bar)[XB_TMO], 1u); break; } } } } while (0)
struct XcdBarrier { unsigned* bar; unsigned x; volatile LAS unsigned* st; };
DEV XcdBarrier xcd_barrier_post(unsigned* bar, volatile LAS unsigned* st) {
    XcdBarrier b; b.bar = bar; b.x = xb_xcc_id(); b.st = st;
    if (threadIdx.x == 0) (void)xb_add(&bar[XB_XCNT(b.x)], 1u);
    return b;
}
DEV void xcd_barrier_complete(unsigned* bar, unsigned x, unsigned& nloc, unsigned& nx) {
    const unsigned G = gridDim.x * gridDim.y * gridDim.z;
    unsigned sum, cnt, mine, sp = 0u;
    for (;;) {
        sum = 0u; cnt = 0u; mine = 0u;
#pragma unroll
        for (unsigned j = 0; j < 16; ++j) { const unsigned c = xb_ld(&bar[XB_XCNT(j)]); sum += c; cnt += (c > 0u) ? 1u : 0u; mine = (j == x) ? c : mine; }
        if (sum == G) break;
        __builtin_amdgcn_s_sleep(1);
        if ((++sp & 255u) == 0u) { if (xb_ld(&bar[XB_TMO])) break; if (sp > XB_SPIN_CAP) { atomicAdd(&bar[XB_TMO], 1u); break; } }
    }
    nloc = mine > 0u ? mine : 1u; nx = cnt > 0u ? cnt : 1u;
}
DEV void xcd_barrier(const XcdBarrier& b) {
    asm volatile("s_waitcnt vmcnt(0)" ::: "memory");
    __syncthreads();
    if (threadIdx.x == 0) {
        unsigned* bar = b.bar;
        __builtin_amdgcn_s_waitcnt(0);
        unsigned nloc = b.st[0], nx = b.st[1];
        if (nloc == 0u) { xcd_barrier_complete(bar, b.x, nloc, nx); b.st[0] = nloc; b.st[1] = nx; }
        const unsigned old = xb_add(&bar[XB_XSUB(b.x)], 1u);
        const unsigned gen = old / nloc;
        if (old + 1u == (gen + 1u) * nloc) {
            __builtin_amdgcn_fence(__ATOMIC_RELEASE, "agent");
            asm volatile("s_waitcnt vmcnt(0)" ::: "memory");
            const unsigned og = xb_add(&bar[XB_TOP], 1u);
            const unsigned tg = og / nx;
            if (og + 1u == (tg + 1u) * nx) xb_add(&bar[XB_TOPGEN], 1u);
            else XB_SPIN(xb_ld(&bar[XB_TOPGEN]) == tg, bar);
            __builtin_amdgcn_fence(__ATOMIC_ACQUIRE, "agent");
            xb_add(&bar[XB_XGEN(b.x)], 1u);
            asm volatile("s_waitcnt vmcnt(0)" ::: "memory");
        } else {
            XB_SPIN(xb_ld(&bar[XB_XGEN(b.x)]) == gen, bar);
            __builtin_amdgcn_fence(__ATOMIC_ACQUIRE, "agent");
            asm volatile("s_waitcnt vmcnt(0)" ::: "memory");
        }
    }
    __syncthreads();
}

typedef const unsigned long long __attribute__((address_space(4)))* KWordPtr;
DEV Params kparams() {
    KWordPtr k = (KWordPtr)__builtin_amdgcn_kernarg_segment_ptr(); asm volatile("" : "+s"(k));
    Params q; unsigned long long* d = (unsigned long long*)&q;
#pragma unroll
    for (int i = 0; i < (int)(sizeof(Params) / 8); ++i) d[i] = k[i];
    return q;
}
__global__ void __launch_bounds__(512) fwd_kernel(Params p) {
    cg::grid_group grid = cg::this_grid();
    volatile LAS unsigned* xst = (volatile LAS unsigned*)((LAS unsigned char*)shm_raw + (LDS_BYTES - 16));
    if (threadIdx.x == 0) { xst[0] = 0u; xst[1] = 0u; }
    __syncthreads();
    const XcdBarrier xb = xcd_barrier_post((unsigned*)(p.ws + W_BAR), xst);
    const int lo = (int)p.ph_lo, hi = (int)p.ph_hi;
    if (hi < 0) grid.sync();
#ifdef ONLY_PHASE
#define RUNP(si, ph, call) if (ph == ONLY_PHASE) { const Params q = kparams(); call(q); }
#else
#define RUNP(si, ph, call) if (lo <= si && si < hi) { { const Params q = kparams(); call(q); } if (si + 1 < hi) { xcd_barrier(xb); } }
#endif
    RUNP(0, 0, phase_prep)
    RUNP(1, 1, phase_mod)
    RUNP(2, 2, phase_norm1)
    RUNP(3, 3, phase_inproj)
    RUNP(4, 4, phase_mixA)
    RUNP(5, 10, phase_scan)
    RUNP(6, 5, phase_mixC)
    RUNP(7, 6, phase_outproj)
    RUNP(8, 7, phase_up)
    RUNP(9, 8, phase_down)
    RUNP(10, 9, phase_final)
}

extern "C" void kernel_launch(void* const* d_in, const int* in_sizes, int n_in, void* d_out, int out_size, void* d_ws, size_t ws_size, hipStream_t stream) {
    static int grid_blocks = 0;
    if (grid_blocks == 0) {
        if (n_in != 27 || ws_size < W_END) { fprintf(stderr, "kernel_launch: unexpected n_in %d or ws_size %zu (< %zu)\n", n_in, ws_size, (size_t)W_END); grid_blocks = -1; return; }
        int dev = 0, cus = 0, per_cu = 0;
        hipGetDevice(&dev);
        hipDeviceGetAttribute(&cus, hipDeviceAttributeMultiprocessorCount, dev);
        if (hipFuncSetAttribute((const void*)fwd_kernel, hipFuncAttributeMaxDynamicSharedMemorySize, LDS_BYTES) != hipSuccess) { fprintf(stderr, "kernel_launch: hipFuncSetAttribute failed\n"); grid_blocks = -1; return; }
        if (hipOccupancyMaxActiveBlocksPerMultiprocessor(&per_cu, (const void*)fwd_kernel, 512, LDS_BYTES) != hipSuccess || per_cu < 1) { fprintf(stderr, "kernel_launch: occupancy query failed (%d)\n", per_cu); (void)hipGetLastError(); per_cu = 1; }
        grid_blocks = cus * 1;
    }
    if (grid_blocks < 0) return;
    Params p{};
    const float** pp = (const float**)&p;
    for (int i = 0; i < 27; ++i) pp[i] = (const float*)d_in[i];
    p.out = (float*)d_out; p.ws = (unsigned char*)d_ws;
    if (hipMemsetAsync((char*)d_ws + W_BAR, 0, (size_t)BAR_WORDS * 4, stream) != hipSuccess) { fprintf(stderr, "kernel_launch: memset failed\n"); return; }
#if MK_MULTI
    for (int ph = 0; ph < 11; ++ph) {
        p.ph_lo = ph; p.ph_hi = ph + 1;
        hipLaunchKernelGGL(fwd_kernel, dim3(grid_blocks), dim3(512), LDS_BYTES, stream, p);
    }
#else
    p.ph_lo = 0; p.ph_hi = 11;
    void* args[] = {&p};
    hipError_t e = hipLaunchCooperativeKernel((const void*)fwd_kernel, dim3(grid_blocks), dim3(512), args, LDS_BYTES, stream);
    if (e != hipSuccess) fprintf(stderr, "cooperative launch failed: %s (grid %d)\n", hipGetErrorString(e), grid_blocks);
#endif
}
```

```cpp
#include <hip/hip_runtime.h>
#include <hip/hip_cooperative_groups.h>
#include <cstdio>
#include <cstdint>
namespace cg = cooperative_groups;

#ifndef MK_MULTI
#define MK_MULTI 0
#endif

#define DEV __device__ __forceinline__
typedef unsigned short bf16_t;
typedef short bf16x8 __attribute__((ext_vector_type(8)));
typedef float f32x4 __attribute__((ext_vector_type(4)));
typedef unsigned u32x4 __attribute__((ext_vector_type(4)));
typedef unsigned u32x2 __attribute__((ext_vector_type(2)));

constexpr int D = 1024, TSEQ = 2048, NBATCH = 8, NTOK = 16384, NSMP = 128, NROWS = NTOK + NSMP;
constexpr int DP = 3072, DFF = 2816, DLRU = 512, NMODROWS = 144;
constexpr float EPS = 1e-6f;
constexpr int PAST_LEN = 16384;

constexpr size_t O_YP = 0, O_YS = O_YP + (size_t)NTOK * D, O_RETP = O_YS + (size_t)NSMP * D, O_LHP = O_RETP + 8 * 4 * 128 * 128,
                 O_LCP = O_LHP + 8 * 512, O_FCP = O_LCP + 8 * 3 * 512, O_RETS = O_FCP + 8 * 2 * DFF, O_LHS = O_RETS + (size_t)128 * 4 * 128 * 128,
                 O_LCS = O_LHS + 128 * 512, O_FCS = O_LCS + 128 * 3 * 512;

constexpr size_t al256(size_t x) { return (x + 255) & ~(size_t)255; }
constexpr size_t W_BTIN = 0;
constexpr size_t W_BTOUT = W_BTIN + (size_t)DP * D * 2;
constexpr size_t W_BTUP = W_BTOUT + (size_t)D * D * 2;
constexpr size_t W_BTDOWN = W_BTUP + (size_t)2 * DFF * D * 2;
constexpr size_t W_WRT = W_BTDOWN + (size_t)D * DFF * 2;
constexpr size_t W_H = W_WRT + 2 * 8 * 64 * 64 * 2;
constexpr size_t W_PROJ = W_H + (size_t)NROWS * D * 2;
constexpr size_t W_MIX = W_PROJ + (size_t)NTOK * DP * 2;
constexpr size_t W_KVT = W_MIX + (size_t)NROWS * D * 2;
constexpr size_t W_MOD = W_KVT + (size_t)512 * 65536;
constexpr size_t W_SW = W_MOD + (size_t)NMODROWS * 6144 * 4;
constexpr size_t W_PROJS = W_SW + (size_t)NMODROWS * 2 * DFF * 4;
constexpr size_t W_ROPE = W_PROJS + (size_t)NSMP * DP * 4;
constexpr size_t W_EDGEU = al256(W_ROPE + (size_t)(TSEQ + 1) * 128 * 4);
constexpr size_t W_EDGEG = W_EDGEU + (size_t)64 * 2 * DFF * 4;
constexpr size_t W_TAILU = W_EDGEG + (size_t)64 * 2 * DFF * 4;
constexpr size_t W_FIX = W_TAILU + (size_t)64 * 2 * DFF * 4;
constexpr size_t W_AGG = W_FIX + (size_t)256 * 2 * DFF * 2;
constexpr size_t W_RSS1 = W_AGG + (size_t)8 * 8 * 16 * 2 * 64 * 4;
constexpr size_t W_RSS2 = al256(W_RSS1 + (size_t)NROWS * 4);
constexpr size_t W_SPL = al256(W_RSS2 + (size_t)NROWS * 4);
constexpr size_t W_MODA = W_SPL + 512 * 4;
constexpr size_t W_SHF = W_MODA + (size_t)NMODROWS * D * 2;
constexpr size_t W_HIN0 = al256(W_SHF + (size_t)NMODROWS * D * 2);
constexpr size_t W_BAR = W_HIN0 + (size_t)1024 * 64 * 4;
constexpr int BAR_WORDS = 3456 + 64 * 64;
constexpr size_t W_END = W_BAR + (size_t)BAR_WORDS * 4;

constexpr int LDS_BYTES = 147456;

struct Params {
    const float *x_p, *x_s, *c_p, *c_s, *st_ret, *st_h, *st_cl, *st_cf, *w_ada, *b_ada, *g_mix, *w_in, *cl_w, *cl_b, *w_r, *b_r, *w_i, *b_i, *lam,
        *w_out, *g_ffn, *w_upc, *w_upg, *cf_w, *cf_b, *w_down, *g_final;
    float* out;
    unsigned char* ws;
    long long ph_lo, ph_hi;
};

extern __shared__ __attribute__((aligned(16))) unsigned char shm_raw[];

DEV int TIDX() { int t = threadIdx.x; asm volatile("" : "+v"(t)); return t; }
DEV int BIDX() { int b = blockIdx.x; asm volatile("" : "+s"(b)); return b; }
typedef float f32x2_ __attribute__((ext_vector_type(2)));
typedef __bf16 bf16x2_ __attribute__((ext_vector_type(2)));
DEV unsigned cvt_pk_bf16(float lo, float hi) { const f32x2_ v = {lo, hi}; const bf16x2_ r = __builtin_convertvector(v, bf16x2_); return __builtin_bit_cast(unsigned, r); }
DEV bf16_t f2bf(float x) { return (bf16_t)(cvt_pk_bf16(x, 0.f) & 0xffffu); }
DEV float bf2f(bf16_t v) { return __uint_as_float(((unsigned)v) << 16); }
DEV float bflo(unsigned w) { return __uint_as_float(w << 16); }
DEV float bfhi(unsigned w) { return __uint_as_float(w & 0xffff0000u); }
DEV float fexp2(float x) { return __builtin_amdgcn_exp2f(x); }
DEV float sigmoidf_(float x) { return __builtin_amdgcn_rcpf(1.f + fexp2(-1.4426950408889634f * x)); }
DEV float siluf_(float x) { return x * sigmoidf_(x); }
DEV float geluf_(float x) { const float y = 1.5957691216057308f * (x + 0.044715f * x * x * x); return x * sigmoidf_(y); }
DEV float wave_sum(float v) {
#pragma unroll
    for (int o = 1; o < 64; o <<= 1) v += __shfl_xor(v, o);
    return v;
}
DEV void unpack8(u32x4 w, float* f) { f[0] = bflo(w.x); f[1] = bfhi(w.x); f[2] = bflo(w.y); f[3] = bfhi(w.y); f[4] = bflo(w.z); f[5] = bfhi(w.z); f[6] = bflo(w.w); f[7] = bfhi(w.w); }
DEV u32x4 pack8(const float* f) { u32x4 w; w.x = cvt_pk_bf16(f[0], f[1]); w.y = cvt_pk_bf16(f[2], f[3]); w.z = cvt_pk_bf16(f[4], f[5]); w.w = cvt_pk_bf16(f[6], f[7]); return w; }
DEV int rhoinv(int w) { return 16 * ((w >> 2) & 1) + 4 * (w >> 3) + (w & 3); }
DEV int permpos(int c) { return (c & ~31) | rhoinv(c & 31); }
DEV int slotcol(int n, int s) { return 8 * (s >> 2) + 4 * n + (s & 3); }
DEV float gamma_log2(int h) { return __log2f(1.f - exp2f(-5.f - (float)h)); }

constexpr int BM = 256, BK = 64, HALF = 128, HT = HALF * BK;
DEV int lds_byte(int r, int c) { int st = (r >> 4) * 2 + (c >> 5), rr = r & 15, cc = c & 31, ob = rr * 64 + cc * 2; return st * 1024 + (ob ^ (((ob >> 9) & 1) << 5)); }
DEV void stage_rc(int b, int& R, int& C) { int st = b / 1024, sb = b % 1024, swz = sb ^ (((sb >> 9) & 1) << 5); R = (st >> 1) * 16 + swz / 64; C = (st & 1) * 32 + (swz % 64) / 2; }

#define LAS __attribute__((address_space(3)))
template <bool FIX, class Epi>
DEV void gemm_tile(const bf16_t* __restrict__ A, const bf16_t* __restrict__ Bt, const int K, const int brow, const int bcol, const bf16_t* fixA, Epi&& epi) {
    LAS unsigned char* lds = (LAS unsigned char*)shm_raw;
    const int tid = TIDX(), wid = __builtin_amdgcn_readfirstlane(tid >> 6), lane = tid & 63, wr = wid >> 2, wc = wid & 3, fr = lane & 15, fq = lane >> 4;
    const int nt = K / BK;
    constexpr int HTB = HALF * BK * 2;
    unsigned voff[2], voffF[2];
#pragma unroll
    for (int i = 0; i < 2; ++i) {
        int R, C; stage_rc(tid * 16 + i * 8192, R, C);
        voff[i] = (unsigned)(R * K + C) * 2u; voffF[i] = voff[i];
        if (FIX) { if (R < 2) voffF[i] = (unsigned)(((const char*)fixA - (const char*)(A + (size_t)brow * K)) + (long)(R * K + C) * 2); }
    }
    const size_t kstep = (size_t)(BK * 2), hstep = (size_t)HALF * K * 2;
    const unsigned ldsw = (unsigned)wid * 1024u;
    const int aoff = lds_byte(wr * 64 + fr, fq * 8), boff = lds_byte(wc * 32 + fr, fq * 8);
    const char* cA = (const char*)(A + (size_t)brow * K); const char* cB = (const char*)(Bt + (size_t)bcol * K);
#define SA(b, h) (((b) * 2 + (h)) * HTB)
#define SB(b, h) ((4 + (b) * 2 + (h)) * HTB)
#define STAGE(bufoff, gbase, vo) do { _Pragma("unroll") for (int _i = 0; _i < 2; ++_i) \
        __builtin_amdgcn_global_load_lds((const unsigned*)((const char*)(gbase) + (vo)[_i]), (LAS unsigned*)(lds + (bufoff) + ldsw + _i * 8192), 16, 0, 0); } while (0)
#define LDA(dst, b, h) do { _Pragma("unroll") for (int m = 0; m < 4; ++m) _Pragma("unroll") for (int k = 0; k < 2; ++k) dst[m][k] = *(const LAS bf16x8*)(lds + SA(b, h) + aoff + m * 2048 + k * 1024); } while (0)
#define LDB(dst, b, h) do { _Pragma("unroll") for (int n = 0; n < 2; ++n) _Pragma("unroll") for (int k = 0; k < 2; ++k) dst[n][k] = *(const LAS bf16x8*)(lds + SB(b, h) + boff + n * 2048 + k * 1024); } while (0)
#define MMA(ai, bj, At_, Bt_) do { __builtin_amdgcn_s_setprio(1); _Pragma("unroll") for (int m = 0; m < 4; ++m) _Pragma("unroll") for (int n = 0; n < 2; ++n) _Pragma("unroll") for (int k = 0; k < 2; ++k) \
        acc[ai][bj][m][n] = __builtin_amdgcn_mfma_f32_16x16x32_bf16(Bt_[n][k], At_[m][k], acc[ai][bj][m][n], 0, 0, 0); __builtin_amdgcn_s_setprio(0); } while (0)
#define WAIT_V(n) asm volatile("s_waitcnt vmcnt(" #n ")" ::: "memory")
#define WAIT_L(n) asm volatile("s_waitcnt lgkmcnt(" #n ")" ::: "memory")
#define BAR __builtin_amdgcn_s_barrier()
#define SCHED __builtin_amdgcn_sched_barrier(0)
    f32x4 acc[2][2][4][2];
#pragma unroll
    for (int a = 0; a < 2; ++a)
#pragma unroll
        for (int b = 0; b < 2; ++b)
#pragma unroll
            for (int m = 0; m < 4; ++m)
#pragma unroll
                for (int n = 0; n < 2; ++n) acc[a][b][m][n] = (f32x4){0.f, 0.f, 0.f, 0.f};
    bf16x8 At[4][2], B0[2][2], B1[2][2];
    STAGE(SB(0, 0), cB, voff); STAGE(SA(0, 0), cA, voffF); STAGE(SB(0, 1), cB + hstep, voff); STAGE(SA(0, 1), cA + hstep, voff);
    if (wr == 1) BAR;
    WAIT_V(4); BAR;
    STAGE(SB(1, 0), cB + kstep, voff); STAGE(SA(1, 0), cA + kstep, voffF); STAGE(SB(1, 1), cB + hstep + kstep, voff);
    WAIT_V(6); BAR;
    for (int t = 0; t < nt - 2; t += 2) {
        const char* a1 = cA + (size_t)(t + 1) * kstep; const char* a2 = a1 + kstep; const char* a3 = a2 + kstep;
        const char* b2 = cB + (size_t)(t + 2) * kstep; const char* b3 = b2 + kstep;
        LDB(B0, 0, 0); SCHED; LDA(At, 0, 0); STAGE(SA(1, 1), a1 + hstep, voff);
        WAIT_L(8); BAR; WAIT_L(0); MMA(0, 0, At, B0); BAR; SCHED;
        LDB(B1, 0, 1); STAGE(SB(0, 0), b2, voff);
        BAR; WAIT_L(0); MMA(0, 1, At, B1); BAR;
        LDA(At, 0, 1); STAGE(SA(0, 0), a2, voffF);
        BAR; WAIT_L(0); MMA(1, 0, At, B0); BAR; SCHED;
        STAGE(SB(0, 1), b2 + hstep, voff);
        WAIT_V(6); BAR; MMA(1, 1, At, B1); BAR;
        LDB(B0, 1, 0); SCHED; LDA(At, 1, 0); STAGE(SA(0, 1), a2 + hstep, voff);
        WAIT_L(8); BAR; WAIT_L(0); MMA(0, 0, At, B0); BAR; SCHED;
        LDB(B1, 1, 1); STAGE(SB(1, 0), b3, voff);
        BAR; WAIT_L(0); MMA(0, 1, At, B1); BAR;
        LDA(At, 1, 1); STAGE(SA(1, 0), a3, voffF);
        BAR; WAIT_L(0); MMA(1, 0, At, B0); BAR; SCHED;
        STAGE(SB(1, 1), b3 + hstep, voff);
        WAIT_V(6); BAR; MMA(1, 1, At, B1); BAR;
    }
    { LDB(B0, 0, 0); LDA(At, 0, 0); STAGE(SA(1, 1), cA + (size_t)(nt - 1) * kstep + hstep, voff);
      BAR; WAIT_L(0); MMA(0, 0, At, B0); BAR;
      LDB(B1, 0, 1); BAR; WAIT_L(0); MMA(0, 1, At, B1); BAR;
      LDA(At, 0, 1); WAIT_V(4); BAR; WAIT_L(0); MMA(1, 0, At, B0); MMA(1, 1, At, B1); BAR; }
    { LDB(B0, 1, 0); LDA(At, 1, 0); WAIT_V(2); BAR; WAIT_L(0); MMA(0, 0, At, B0); BAR;
      LDB(B1, 1, 1); WAIT_V(0); BAR; WAIT_L(0); MMA(0, 1, At, B1); BAR;
      LDA(At, 1, 1); BAR; WAIT_L(0); MMA(1, 0, At, B0); MMA(1, 1, At, B1); BAR; }
    if (wr == 0) BAR;
    asm volatile("" ::: "memory");
    epi(acc, brow, bcol, wr, wc, fr, fq);
#undef SA
#undef SB
#undef STAGE
#undef LDA
#undef LDB
#undef MMA
}

DEV void tile_order(int L, int nM, int nN, int& pm, int& pn) {
    const int nwg = nM * nN, NX = 8, WGM = 8;
    int wgid = L; { const int q = nwg / NX, r = nwg % NX, xcd = wgid % NX, off = wgid / NX; wgid = (xcd < r ? xcd * (q + 1) : r * (q + 1) + (xcd - r) * q) + off; }
    const int nig = WGM * nN, gid = wgid / nig, fm = gid * WGM, gsz = (nM - fm) < WGM ? (nM - fm) : WGM;
    pm = fm + ((wgid % nig) % gsz); pn = (wgid % nig) / gsz;
}

DEV float dpp_ror1(float x) { return __int_as_float(__builtin_amdgcn_update_dpp(0, __float_as_int(x), 0x121, 0xf, 0xf, false)); }
DEV float dpp_ror2(float x) { return __int_as_float(__builtin_amdgcn_update_dpp(0, __float_as_int(x), 0x122, 0xf, 0xf, false)); }
DEV float dpp_shr1(float old, float x) { return __int_as_float(__builtin_amdgcn_update_dpp(__float_as_int(old), __float_as_int(x), 0x111, 0xf, 0xf, false)); }
DEV float dpp_shr2(float old, float x) { return __int_as_float(__builtin_amdgcn_update_dpp(__float_as_int(old), __float_as_int(x), 0x112, 0xf, 0xf, false)); }
#define SKINNY_LOOP(j, NBIG_, NSK_) const int _nb = gridDim.x, _first = (NBIG_) % _nb, _bb = BIDX(); if (_bb >= _first) for (int j = _bb - _first; j < (NSK_); j += _nb - _first)
template <bool FIX, class Epi>
DEV void gemm_phase(const bf16_t* __restrict__ A, const bf16_t* __restrict__ Bt, const int K, const int nM, const int nN, const int nbig, const bf16_t* fixbase, Epi&& epi) {
    LAS unsigned char* lds = (LAS unsigned char*)shm_raw;
    const int tid = TIDX(), wid = __builtin_amdgcn_readfirstlane(tid >> 6), lane = tid & 63, wr = wid >> 2, wc = wid & 3, fr = lane & 15, fq = lane >> 4;
    const int nt = K / BK, G = gridDim.x;
    int it = BIDX();
    if (it >= nbig) return;
    constexpr int HTB = HALF * BK * 2;
    unsigned voff[2], voffF[2], voffFn[2];
    int sR[2], sC[2];
#pragma unroll
    for (int i = 0; i < 2; ++i) { stage_rc(tid * 16 + i * 8192, sR[i], sC[i]); voff[i] = (unsigned)(sR[i] * K + sC[i]) * 2u; voffF[i] = voff[i]; voffFn[i] = voff[i]; }
    const size_t kstep = (size_t)(BK * 2), hstep = (size_t)HALF * K * 2, tstep = 2 * hstep;
    const unsigned ldsw = (unsigned)wid * 1024u;
    const int aoff = lds_byte(wr * 64 + fr, fq * 8), boff = lds_byte(wc * 32 + fr, fq * 8);
    int pm, pn; tile_order(it, nM, nN, pm, pn);
    const char* cA = (const char*)A + (size_t)pm * tstep; const char* cB = (const char*)Bt + (size_t)pn * tstep;
    if (FIX) {
#pragma unroll
        for (int i = 0; i < 2; ++i) if (sR[i] < 2) voffF[i] = (unsigned)(((const char*)(fixbase + (size_t)it * 2 * K) - cA) + (long)(sR[i] * K + sC[i]) * 2);
    }
#define SA(b, h) (((b) * 2 + (h)) * HTB)
#define SB(b, h) ((4 + (b) * 2 + (h)) * HTB)
#define STAGE(bufoff, gbase, vo) do { _Pragma("unroll") for (int _i = 0; _i < 2; ++_i) \
        __builtin_amdgcn_global_load_lds((const unsigned*)((const char*)(gbase) + (vo)[_i]), (LAS unsigned*)(lds + (bufoff) + ldsw + _i * 8192), 16, 0, 0); } while (0)
#define LDA(dst, b, h) do { _Pragma("unroll") for (int m = 0; m < 4; ++m) _Pragma("unroll") for (int k = 0; k < 2; ++k) dst[m][k] = *(const LAS bf16x8*)(lds + SA(b, h) + aoff + m * 2048 + k * 1024); } while (0)
#define LDB(dst, b, h) do { _Pragma("unroll") for (int n = 0; n < 2; ++n) _Pragma("unroll") for (int k = 0; k < 2; ++k) dst[n][k] = *(const LAS bf16x8*)(lds + SB(b, h) + boff + n * 2048 + k * 1024); } while (0)
#define MMA(ai, bj, At_, Bt_) do { __builtin_amdgcn_s_setprio(1); _Pragma("unroll") for (int m = 0; m < 4; ++m) _Pragma("unroll") for (int n = 0; n < 2; ++n) _Pragma("unroll") for (int k = 0; k < 2; ++k) \
        acc[ai][bj][m][n] = __builtin_amdgcn_mfma_f32_16x16x32_bf16(Bt_[n][k], At_[m][k], acc[ai][bj][m][n], 0, 0, 0); __builtin_amdgcn_s_setprio(0); } while (0)
    f32x4 acc[2][2][4][2];
#define ZACC() do { _Pragma("unroll") for (int a_ = 0; a_ < 2; ++a_) _Pragma("unroll") for (int b_ = 0; b_ < 2; ++b_) _Pragma("unroll") for (int m_ = 0; m_ < 4; ++m_) _Pragma("unroll") for (int n_ = 0; n_ < 2; ++n_) acc[a_][b_][m_][n_] = (f32x4){0.f, 0.f, 0.f, 0.f}; } while (0)
    ZACC();
    bf16x8 At[4][2], B0[2][2], B1[2][2];
    STAGE(SB(0, 0), cB, voff); STAGE(SB(0, 1), cB + hstep, voff); STAGE(SA(0, 0), cA, voffF); STAGE(SA(0, 1), cA + hstep, voff);
    if (wr == 1) BAR;
    WAIT_V(2); BAR;
    STAGE(SB(1, 0), cB + kstep, voff); STAGE(SA(1, 0), cA + kstep, voffF); STAGE(SB(1, 1), cB + hstep + kstep, voff);
    WAIT_V(6); BAR;
    for (;;) {
        const int itn = it + G; const bool has_next = itn < nbig;
        int pmn = pm, pnn = pn; if (has_next) tile_order(itn, nM, nN, pmn, pnn);
        const char* nA = (const char*)A + (size_t)pmn * tstep; const char* nB = (const char*)Bt + (size_t)pnn * tstep;
        if (FIX) {
#pragma unroll
            for (int i = 0; i < 2; ++i) { voffFn[i] = voff[i]; if (sR[i] < 2) voffFn[i] = (unsigned)(((const char*)(fixbase + (size_t)(has_next ? itn : it) * 2 * K) - nA) + (long)(sR[i] * K + sC[i]) * 2); }
        }
        for (int t = 0; t < nt; t += 2) {
            const bool last = (t == nt - 2);
            const char* a1 = cA + (size_t)(t + 1) * kstep;
            const char* a2 = last ? nA : cA + (size_t)(t + 2) * kstep; const char* b2 = last ? nB : cB + (size_t)(t + 2) * kstep;
            const char* a3 = a2 + kstep; const char* b3 = b2 + kstep;
            unsigned vF2[2];
#pragma unroll
            for (int i = 0; i < 2; ++i) vF2[i] = FIX ? (last ? voffFn[i] : voffF[i]) : voff[i];
            LDB(B0, 0, 0); LDB(B1, 0, 1); SCHED; LDA(At, 0, 0); STAGE(SA(1, 1), a1 + hstep, voff);
            WAIT_V(8); WAIT_L(0); BAR; MMA(0, 0, At, B0); MMA(0, 1, At, B1); BAR; SCHED;
            LDA(At, 0, 1); STAGE(SB(0, 0), b2, voff); STAGE(SB(0, 1), b2 + hstep, voff); STAGE(SA(0, 0), a2, vF2);
            WAIT_V(8); WAIT_L(0); BAR; MMA(1, 0, At, B0); MMA(1, 1, At, B1); BAR; SCHED;
            LDB(B0, 1, 0); LDB(B1, 1, 1); SCHED; LDA(At, 1, 0); STAGE(SA(0, 1), a2 + hstep, voff);
            WAIT_V(8); WAIT_L(0); BAR; MMA(0, 0, At, B0); MMA(0, 1, At, B1); BAR; SCHED;
            LDA(At, 1, 1); STAGE(SB(1, 0), b3, voff); STAGE(SB(1, 1), b3 + hstep, voff); STAGE(SA(1, 0), a3, vF2);
            WAIT_V(8); WAIT_L(0); BAR; MMA(1, 0, At, B0); MMA(1, 1, At, B1); BAR; SCHED;
        }
        if (wr == 0) BAR;
        asm volatile("" ::: "memory");
        epi(acc, pm, pn, pm * BM, pn * BM, wr, wc, fr, fq);
        asm volatile("s_waitcnt vmcnt(0)" ::: "memory");
        if (!has_next) break;
        ZACC();
        it = itn; pm = pmn; pn = pnn; cA = nA; cB = nB;
        if (FIX) { voffF[0] = voffFn[0]; voffF[1] = voffFn[1]; }
        if (wr == 1) BAR;
    }
    BAR;
#undef SA
#undef SB
#undef STAGE
#undef LDA
#undef LDB
#undef MMA
#undef ZACC
}

struct NoRowFn { DEV void operator()(int, float) const {} };
template <int RB, int NBLK, int U, class Epi, class RowFn = NoRowFn>
DEV void skinny_tile(const bf16_t* __restrict__ A, const int lda, const bf16_t* __restrict__ B0, const bf16_t* __restrict__ B1, const int K, Epi&& epi, RowFn&& rowfn = NoRowFn(), const int ldb_ = 0) {
    const int ldb = ldb_ ? ldb_ : K;
    float* red = (float*)shm_raw;
    const int tid = TIDX(), w = tid >> 6, lane = tid & 63, fr = lane & 15, fq = lane >> 4;
    constexpr int KG = (NBLK == 2) ? 4 : 8;
    const int kg = (NBLK == 2) ? (w & 3) : w, nb = (NBLK == 2) ? (w >> 2) : 0;
    const bf16_t* Bp = (nb ? B1 : B0) + (long)fr * ldb + fq * 8;
    const bf16_t* Ap = A + (long)fr * lda + fq * 8;
    const int kper = K / KG, kbeg = kg * kper, kend = kbeg + kper;
    f32x4 acc[RB];
#pragma unroll
    for (int rb = 0; rb < RB; ++rb) acc[rb] = (f32x4){0.f, 0.f, 0.f, 0.f};
    int k = kbeg;
    for (; k + 32 * U <= kend; k += 32 * U) {
        bf16x8 b[U], a[U][RB];
#pragma unroll
        for (int u = 0; u < U; ++u) {
            b[u] = *(const bf16x8*)(Bp + k + 32 * u);
#pragma unroll
            for (int rb = 0; rb < RB; ++rb) a[u][rb] = *(const bf16x8*)(Ap + (long)rb * 16 * lda + k + 32 * u);
        }
#pragma unroll
        for (int u = 0; u < U; ++u)
#pragma unroll
            for (int rb = 0; rb < RB; ++rb) acc[rb] = __builtin_amdgcn_mfma_f32_16x16x32_bf16(b[u], a[u][rb], acc[rb], 0, 0, 0);
    }
    for (; k < kend; k += 32) {
        const bf16x8 b = *(const bf16x8*)(Bp + k);
        bf16x8 a[RB];
#pragma unroll
        for (int rb = 0; rb < RB; ++rb) a[rb] = *(const bf16x8*)(Ap + (long)rb * 16 * lda + k);
#pragma unroll
        for (int rb = 0; rb < RB; ++rb) acc[rb] = __builtin_amdgcn_mfma_f32_16x16x32_bf16(b, a[rb], acc[rb], 0, 0, 0);
    }
    f32x4* r4 = (f32x4*)red;
#pragma unroll
    for (int rb = 0; rb < RB; ++rb) r4[(w * RB + rb) * 64 + lane] = acc[rb];
    __syncthreads();
    for (int e = tid; e < RB * 256; e += 512) {
        const int row = e >> 4, s = e & 15, rb = row >> 4, l2 = (row & 15) + 16 * (s >> 2), r = s & 3;
        float v0 = 0.f, v1 = 0.f;
        if (NBLK == 2) {
#pragma unroll
            for (int g = 0; g < 4; ++g) { v0 += red[((g * RB + rb) * 64 + l2) * 4 + r]; v1 += red[(((4 + g) * RB + rb) * 64 + l2) * 4 + r]; }
        } else {
#pragma unroll
            for (int g = 0; g < 8; ++g) v0 += red[((g * RB + rb) * 64 + l2) * 4 + r];
        }
        float ss = epi(row, s, v0, v1);
        ss += __shfl_xor(ss, 1); ss += __shfl_xor(ss, 2); ss += __shfl_xor(ss, 4); ss += __shfl_xor(ss, 8);
        if (s == 0) rowfn(row, ss);
    }
    __syncthreads();
}

template <class RowMap>
DEV void transpose_tile(const float* __restrict__ src, const int N, const int K, const int k0, const int c0, bf16_t* __restrict__ dst, RowMap&& rowmap) {
    float* lds = (float*)shm_raw;
    const int tid = TIDX();
#pragma unroll
    for (int i = 0; i < 2; ++i) {
        const int idx = tid * 4 + i * 2048, kk = idx >> 6, cc = idx & 63;
        const f32x4 v = *(const f32x4*)(src + (size_t)(k0 + kk) * N + c0 + cc);
        lds[kk * 65 + cc] = v.x; lds[kk * 65 + cc + 1] = v.y; lds[kk * 65 + cc + 2] = v.z; lds[kk * 65 + cc + 3] = v.w;
    }
    __syncthreads();
    {
        const int c = tid >> 3, ks = (tid & 7) * 8;
        float f[8];
#pragma unroll
        for (int e = 0; e < 8; ++e) f[e] = lds[(ks + e) * 65 + c];
        *(u32x4*)(dst + (size_t)rowmap(c0 + c) * K + k0 + ks) = pack8(f);
    }
    __syncthreads();
}

DEV void phase_prep(const Params& p) {
    unsigned char* ws = p.ws;
    bf16_t* BtIn = (bf16_t*)(ws + W_BTIN); bf16_t* BtOut = (bf16_t*)(ws + W_BTOUT); bf16_t* BtUp = (bf16_t*)(ws + W_BTUP);
    bf16_t* BtDown = (bf16_t*)(ws + W_BTDOWN); bf16_t* BtAda = (bf16_t*)(ws + W_KVT); bf16_t* WrT = (bf16_t*)(ws + W_WRT);
    constexpr int T_IN = 16 * 48, T_OUT = 16 * 16, T_UP = 16 * 44, T_DOWN = 44 * 16, T_ADA = 16 * 96, T_G = 16;
    constexpr int T_ALL = T_IN + T_OUT + 2 * T_UP + T_DOWN + T_ADA + T_G;
    for (int it = BIDX(); it < T_ALL; it += gridDim.x) {
        int r = it;
        if (r < T_ADA) { transpose_tile(p.w_ada, 6144, 1024, (r / 96) * 64, (r % 96) * 64, BtAda, [](int c) { return permpos(c); }); continue; } r -= T_ADA;
        if (r < T_IN) { transpose_tile(p.w_in, DP, 1024, (r / 48) * 64, (r % 48) * 64, BtIn, [](int c) { return permpos(c); }); continue; } r -= T_IN;
        if (r < T_OUT) { transpose_tile(p.w_out, D, 1024, (r / 16) * 64, (r % 16) * 64, BtOut, [](int c) { return permpos(c); }); continue; } r -= T_OUT;
        if (r < T_UP) { transpose_tile(p.w_upc, DFF, 1024, (r / 44) * 64, (r % 44) * 64, BtUp, [](int c) { return 256 * (c >> 7) + permpos(c & 127); }); continue; } r -= T_UP;
        if (r < T_UP) { transpose_tile(p.w_upg, DFF, 1024, (r / 44) * 64, (r % 44) * 64, BtUp, [](int c) { return 256 * (c >> 7) + 128 + permpos(c & 127); }); continue; } r -= T_UP;
        if (r < T_DOWN) { transpose_tile(p.w_down, D, DFF, (r / 16) * 64, (r % 16) * 64, BtDown, [](int c) { return permpos(c); }); continue; } r -= T_DOWN;
        { const int g = r >> 3, jb = r & 7; transpose_tile((g ? p.w_i : p.w_r) + jb * 4096, 64, 64, 0, 0, WrT + (g * 8 + jb) * 4096, [](int c) { return c; }); }
    }
    const int gt = BIDX() * 512 + TIDX(), GT = gridDim.x * 512;
    bf16_t* modA = (bf16_t*)(ws + W_MODA);
    for (int i = gt; i < NMODROWS * D; i += GT) {
        const int row = i >> 10, k = i & 1023;
        float v = 0.f;
        if (row < 8) v = siluf_(p.c_p[row * D + k]); else if (row < 136) v = siluf_(p.c_s[(row - 8) * D + k]);
        modA[i] = f2bf(v);
    }
    float* rope = (float*)(ws + W_ROPE);
    for (int i = gt; i < (TSEQ + 1) * 64; i += GT) {
        const int t = i >> 6, j = i & 63;
        const float pos = (t < TSEQ) ? (float)t : (float)PAST_LEN;
        const float invf = exp2f(-(float)(2 * j) * (13.287712379549449f / 128.f));
        const float ang = pos * invf;
        float s, c; sincosf(ang, &s, &c);
        rope[t * 128 + j] = c; rope[t * 128 + 64 + j] = s;
    }
    float* rss1 = (float*)(ws + W_RSS1); float* rss2 = (float*)(ws + W_RSS2); float* spl = (float*)(ws + W_SPL);
    for (int i = gt; i < NROWS; i += GT) { rss1[i] = 0.f; rss2[i] = 0.f; }
    for (int i = gt; i < 512; i += GT) spl[i] = 8.f * log1pf(__expf(-p.lam[i]));
}

DEV void phase_mod(const Params& p) {
    unsigned char* ws = p.ws;
    const bf16_t* modA = (const bf16_t*)(ws + W_MODA); const bf16_t* BtAda = (const bf16_t*)(ws + W_KVT); float* mod = (float*)(ws + W_MOD);
    for (int it = BIDX(); it < 256; it += gridDim.x) {
        if (it < 128) {
            const int g = it >> 1, n = it & 1;
            const bf16_t* B0 = BtAda + (size_t)(32 * g + 16 * n) * D;
            skinny_tile<9, 1, 4>(modA, D, B0, B0, D, [&](int row, int s, float v0, float v1) {
                if (row < 136) { const int c0 = 32 * g + slotcol(n, s); mod[(size_t)row * 6144 + c0] = v0 + p.b_ada[c0]; }
                return 0.f;
            });
        } else {
            const int g = 64 + (it - 128);
            const bf16_t* B0 = BtAda + (size_t)(32 * g) * D;
            skinny_tile<9, 2, 4>(modA, D, B0, B0 + 16 * D, D, [&](int row, int s, float v0, float v1) {
                if (row < 136) { const int c0 = 32 * g + slotcol(0, s), c1 = c0 + 4; mod[(size_t)row * 6144 + c0] = v0 + p.b_ada[c0]; mod[(size_t)row * 6144 + c1] = v1 + p.b_ada[c1]; }
                return 0.f;
            });
        }
    }
}

DEV void phase_norm1(const Params& p) {
    unsigned char* ws = p.ws;
    const float* mod = (const float*)(ws + W_MOD); bf16_t* H = (bf16_t*)(ws + W_H); bf16_t* shf = (bf16_t*)(ws + W_SHF);
    const int lane = TIDX() & 63, gw = BIDX() * 8 + (TIDX() >> 6), NGW = gridDim.x * 8;
    for (int row = gw; row < NROWS; row += NGW) {
        const float* xr = (row < NTOK) ? p.x_p + (size_t)row * D : p.x_s + (size_t)(row - NTOK) * D;
        const int b = (row < NTOK) ? (row >> 11) : 8 + (row - NTOK);
        const float* mrow = mod + (size_t)b * 6144;
        f32x4 v[4]; float ss = 0.f;
#pragma unroll
        for (int j = 0; j < 4; ++j) { v[j] = *(const f32x4*)(xr + 4 * lane + 256 * j); ss += v[j].x * v[j].x + v[j].y * v[j].y + v[j].z * v[j].z + v[j].w * v[j].w; }
        const float rstd = __builtin_amdgcn_rsqf(wave_sum(ss) * (1.f / D) + EPS);
#pragma unroll
        for (int j = 0; j < 4; ++j) {
            const int k = 4 * lane + 256 * j;
            const f32x4 g = *(const f32x4*)(p.g_mix + k), sh = *(const f32x4*)(mrow + k), sc = *(const f32x4*)(mrow + D + k);
            const f32x4 h = v[j] * rstd * g * (1.f + sc) + sh;
            u32x2 o; o.x = cvt_pk_bf16(h.x, h.y); o.y = cvt_pk_bf16(h.z, h.w);
            *(u32x2*)(H + (size_t)row * D + k) = o;
        }
    }
}

DEV void phase_inproj(const Params& p) {
    unsigned char* ws = p.ws;
    const bf16_t* H = (const bf16_t*)(ws + W_H); const bf16_t* BtIn = (const bf16_t*)(ws + W_BTIN); bf16_t* proj = (bf16_t*)(ws + W_PROJ);
    float* projS = (float*)(ws + W_PROJS);
    constexpr int NBIG = 64 * 12, NSK1 = 96;
    gemm_phase<false>(H, BtIn, D, 64, 12, NBIG, nullptr, [&](const f32x4 (&acc)[2][2][4][2], int pm, int pn, int brow, int bcol, int wr, int wc, int fr, int fq) {
#pragma unroll
        for (int ai = 0; ai < 2; ++ai)
#pragma unroll
            for (int m = 0; m < 4; ++m) {
                bf16_t* rp = proj + (size_t)(brow + ai * HALF + wr * 64 + m * 16 + fr) * DP + bcol + wc * 32 + 8 * fq;
#pragma unroll
                for (int bj = 0; bj < 2; ++bj) {
                    const f32x4 a = acc[ai][bj][m][0], b = acc[ai][bj][m][1];
                    u32x4 w; w.x = cvt_pk_bf16(a[0], a[1]); w.y = cvt_pk_bf16(a[2], a[3]); w.z = cvt_pk_bf16(b[0], b[1]); w.w = cvt_pk_bf16(b[2], b[3]);
                    *(u32x4*)(rp + bj * HALF) = w;
                }
            }
    });
    const bf16_t* modA = (const bf16_t*)(ws + W_MODA); const bf16_t* BtAda = (const bf16_t*)(ws + W_KVT); float* mod = (float*)(ws + W_MOD);
    SKINNY_LOOP(j, NBIG, 2 * NSK1) {
        const int g = j >> 1, n = j & 1;
        const bf16_t* B0 = BtIn + (size_t)(32 * g + 16 * n) * D;
        skinny_tile<8, 1, 4>(H + (size_t)NTOK * D, D, B0, B0, D, [&](int row, int s, float v0, float v1) {
            projS[row * DP + 32 * g + slotcol(n, s)] = v0; return 0.f;
        });
    }
}

constexpr int RP = 136;
DEV void rot8(const float* x1, const float* x2, const float* tr, int d0, float scale, float* o1, float* o2) {
    const f32x4 c0 = *(const f32x4*)(tr + d0), c1 = *(const f32x4*)(tr + d0 + 4), s0 = *(const f32x4*)(tr + 64 + d0), s1 = *(const f32x4*)(tr + 64 + d0 + 4);
    const float c[8] = {c0.x, c0.y, c0.z, c0.w, c1.x, c1.y, c1.z, c1.w}, s[8] = {s0.x, s0.y, s0.z, s0.w, s1.x, s1.y, s1.z, s1.w};
#pragma unroll
    for (int e = 0; e < 8; ++e) { o1[e] = (x1[e] * c[e] - x2[e] * s[e]) * scale; o2[e] = (x1[e] * s[e] + x2[e] * c[e]) * scale; }
}

DEV void rot8v(const u32x4 a, const u32x4 b, const f32x4 c0, const f32x4 c1, const f32x4 s0, const f32x4 s1, float scale, float* o1, float* o2) {
    float x1[8], x2[8]; unpack8(a, x1); unpack8(b, x2);
    const float c[8] = {c0.x, c0.y, c0.z, c0.w, c1.x, c1.y, c1.z, c1.w}, s[8] = {s0.x, s0.y, s0.z, s0.w, s1.x, s1.y, s1.z, s1.w};
#pragma unroll
    for (int e = 0; e < 8; ++e) { o1[e] = (x1[e] * c[e] - x2[e] * s[e]) * scale; o2[e] = (x1[e] * s[e] + x2[e] * c[e]) * scale; }
}
DEV void scatter_vT(const u32x4 w, int j, int d0, bf16_t* vT) {
    const unsigned ww[4] = {w.x, w.y, w.z, w.w};
#pragma unroll
    for (int e = 0; e < 4; ++e) { vT[(d0 + 2 * e) * RP + j] = (bf16_t)(ww[e] & 0xffffu); vT[(d0 + 2 * e + 1) * RP + j] = (bf16_t)(ww[e] >> 16); }
}
DEV void stage_vT(const bf16_t* proj, int row0, int h, bf16_t* vT) {
    for (int item = TIDX(); item < 2048; item += 512) {
        const int j = item >> 4, d0 = (item & 15) * 8;
        const u32x4 w = *(const u32x4*)(proj + (size_t)(row0 + j) * DP + 1024 + h * 128 + d0);
        const unsigned ww[4] = {w.x, w.y, w.z, w.w};
#pragma unroll
        for (int e = 0; e < 4; ++e) { vT[(d0 + 2 * e) * RP + j] = (bf16_t)(ww[e] & 0xffffu); vT[(d0 + 2 * e + 1) * RP + j] = (bf16_t)(ww[e] >> 16); }
    }
}

DEV void ret_passA(const Params& p, int unit) {
    unsigned char* ws = p.ws;
    const bf16_t* proj = (const bf16_t*)(ws + W_PROJ); const float* rope = (const float*)(ws + W_ROPE); float* KVT = (float*)(ws + W_KVT) + (size_t)unit * 16384;
    const int n = unit & 15, h = (unit >> 4) & 3, b = unit >> 6, row0 = b * TSEQ + n * 128;
    bf16_t* kT = (bf16_t*)shm_raw; bf16_t* vT = kT + 128 * RP;
    const float lg = gamma_log2(h);
    {
        const int tid = TIDX();
        u32x4 kA[2], kB[2], vv[4]; f32x4 rc[2][4];
#pragma unroll
        for (int i = 0; i < 2; ++i) {
            const int item = tid + 512 * i, j = item >> 3, d0 = (item & 7) * 8;
            const bf16_t* kr = proj + (size_t)(row0 + j) * DP + 512 + h * 128; const float* tr = rope + (size_t)(n * 128 + j) * 128;
            kA[i] = *(const u32x4*)(kr + d0); kB[i] = *(const u32x4*)(kr + 64 + d0);
            rc[i][0] = *(const f32x4*)(tr + d0); rc[i][1] = *(const f32x4*)(tr + d0 + 4); rc[i][2] = *(const f32x4*)(tr + 64 + d0); rc[i][3] = *(const f32x4*)(tr + 64 + d0 + 4);
        }
#pragma unroll
        for (int i = 0; i < 4; ++i) { const int item = tid + 512 * i, j = item >> 4, d0 = (item & 15) * 8; vv[i] = *(const u32x4*)(proj + (size_t)(row0 + j) * DP + 1024 + h * 128 + d0); }
#pragma unroll
        for (int i = 0; i < 2; ++i) {
            const int item = tid + 512 * i, j = item >> 3, d0 = (item & 7) * 8;
            float o1[8], o2[8];
            rot8v(kA[i], kB[i], rc[i][0], rc[i][1], rc[i][2], rc[i][3], 0.08838834764831845f * fexp2(lg * (float)(127 - j)), o1, o2);
#pragma unroll
            for (int e = 0; e < 8; ++e) { kT[(d0 + e) * RP + j] = f2bf(o1[e]); kT[(64 + d0 + e) * RP + j] = f2bf(o2[e]); }
        }
#pragma unroll
        for (int i = 0; i < 4; ++i) { const int item = tid + 512 * i; scatter_vT(vv[i], item >> 4, (item & 15) * 8, vT); }
    }
    __syncthreads();
    const int w = TIDX() >> 6, lane = TIDX() & 63, fr = lane & 15, fq = lane >> 4;
    f32x4 acc[8];
#pragma unroll
    for (int vb = 0; vb < 8; ++vb) acc[vb] = (f32x4){0.f, 0.f, 0.f, 0.f};
#pragma unroll
    for (int ks = 0; ks < 4; ++ks) {
        const bf16x8 a = *(const bf16x8*)(kT + (16 * w + fr) * RP + 32 * ks + 8 * fq);
#pragma unroll
        for (int vb = 0; vb < 8; ++vb) {
            const bf16x8 bb = *(const bf16x8*)(vT + (16 * vb + fr) * RP + 32 * ks + 8 * fq);
            acc[vb] = __builtin_amdgcn_mfma_f32_16x16x32_bf16(a, bb, acc[vb], 0, 0, 0);
        }
    }
#pragma unroll
    for (int vb = 0; vb < 8; ++vb) *(f32x4*)(KVT + (16 * vb + fr) * 128 + 16 * w + 4 * fq) = acc[vb];
    __syncthreads();
}

DEV void ret_passC(const Params& p, int unit) {
    unsigned char* ws = p.ws;
    const bf16_t* proj = (const bf16_t*)(ws + W_PROJ); const float* rope = (const float*)(ws + W_ROPE); bf16_t* mix = (bf16_t*)(ws + W_MIX);
    const int n = unit & 15, h = (unit >> 4) & 3, b = unit >> 6, row0 = b * TSEQ + n * 128;
    bf16_t* ks_ = (bf16_t*)shm_raw; bf16_t* vT = ks_ + 128 * RP; bf16_t* ST = vT + 128 * RP; bf16_t* P = ST + 128 * RP;
    const float lg = gamma_log2(h);
    const int tid = TIDX(), w = tid >> 6, lane = tid & 63, fr = lane & 15, fq = lane >> 4;
    const int i_loc = 16 * w + fr;
    bf16x8 qf[4];
    {
        u32x4 kA[2], kB[2], vv[4], st[4], qA[2], qB[2]; f32x4 rc[2][4], qc[2][4];
#pragma unroll
        for (int i = 0; i < 2; ++i) {
            const int item = tid + 512 * i, j = item >> 3, d0 = (item & 7) * 8;
            const bf16_t* kr = proj + (size_t)(row0 + j) * DP + 512 + h * 128; const float* tr = rope + (size_t)(n * 128 + j) * 128;
            kA[i] = *(const u32x4*)(kr + d0); kB[i] = *(const u32x4*)(kr + 64 + d0);
            rc[i][0] = *(const f32x4*)(tr + d0); rc[i][1] = *(const f32x4*)(tr + d0 + 4); rc[i][2] = *(const f32x4*)(tr + 64 + d0); rc[i][3] = *(const f32x4*)(tr + 64 + d0 + 4);
        }
#pragma unroll
        for (int i = 0; i < 4; ++i) { const int item = tid + 512 * i, j = item >> 4, d0 = (item & 15) * 8; vv[i] = *(const u32x4*)(proj + (size_t)(row0 + j) * DP + 1024 + h * 128 + d0); }
        {
            const int dv = tid >> 2, sg = tid & 3;
            const bf16_t* src = (const bf16_t*)(ws + W_H) + (size_t)unit * 16384 + dv * 128 + sg * 32;
#pragma unroll
            for (int i = 0; i < 4; ++i) st[i] = *(const u32x4*)(src + 8 * i);
        }
        {
            const bf16_t* qr = proj + (size_t)(row0 + i_loc) * DP + h * 128; const float* tr = rope + (size_t)(n * 128 + i_loc) * 128;
#pragma unroll
            for (int kk = 0; kk < 2; ++kk) {
                const int d0 = 32 * kk + 8 * fq;
                qA[kk] = *(const u32x4*)(qr + d0); qB[kk] = *(const u32x4*)(qr + 64 + d0);
                qc[kk][0] = *(const f32x4*)(tr + d0); qc[kk][1] = *(const f32x4*)(tr + d0 + 4); qc[kk][2] = *(const f32x4*)(tr + 64 + d0); qc[kk][3] = *(const f32x4*)(tr + 64 + d0 + 4);
            }
        }
#pragma unroll
        for (int i = 0; i < 2; ++i) {
            const int item = tid + 512 * i, j = item >> 3, d0 = (item & 7) * 8;
            float o1[8], o2[8];
            rot8v(kA[i], kB[i], rc[i][0], rc[i][1], rc[i][2], rc[i][3], 0.08838834764831845f, o1, o2);
            *(u32x4*)(ks_ + j * RP + d0) = pack8(o1); *(u32x4*)(ks_ + j * RP + 64 + d0) = pack8(o2);
        }
#pragma unroll
        for (int i = 0; i < 4; ++i) { const int item = tid + 512 * i; scatter_vT(vv[i], item >> 4, (item & 15) * 8, vT); }
        {
            const int dv = tid >> 2, sg = tid & 3;
#pragma unroll
            for (int i = 0; i < 4; ++i) *(u32x4*)(ST + dv * RP + sg * 32 + 8 * i) = st[i];
        }
#pragma unroll
        for (int kk = 0; kk < 2; ++kk) {
            float o1[8], o2[8];
            rot8v(qA[kk], qB[kk], qc[kk][0], qc[kk][1], qc[kk][2], qc[kk][3], 1.f, o1, o2);
            const u32x4 a = pack8(o1), c = pack8(o2);
            qf[kk] = __builtin_bit_cast(bf16x8, a); qf[kk + 2] = __builtin_bit_cast(bf16x8, c);
        }
    }
    __syncthreads();
#pragma unroll
    for (int jb = 0; jb < 8; ++jb) {
        u32x2 o; o.x = 0u; o.y = 0u;
        if (jb <= w) {
            f32x4 sc = (f32x4){0.f, 0.f, 0.f, 0.f};
#pragma unroll
            for (int kk = 0; kk < 4; ++kk) {
                const bf16x8 a = *(const bf16x8*)(ks_ + (16 * jb + fr) * RP + 32 * kk + 8 * fq);
                sc = __builtin_amdgcn_mfma_f32_16x16x32_bf16(a, qf[kk], sc, 0, 0, 0);
            }
            float pv[4];
#pragma unroll
            for (int r = 0; r < 4; ++r) { const int dj = i_loc - (16 * jb + 4 * fq + r); pv[r] = dj >= 0 ? sc[r] * fexp2(lg * (float)dj) : 0.f; }
            o.x = cvt_pk_bf16(pv[0], pv[1]); o.y = cvt_pk_bf16(pv[2], pv[3]);
        }
        *(u32x2*)(P + i_loc * RP + 16 * jb + 4 * fq) = o;
    }
    __syncthreads();
    f32x4 a1[8], a2[8];
#pragma unroll
    for (int vb = 0; vb < 8; ++vb) { a1[vb] = (f32x4){0.f, 0.f, 0.f, 0.f}; a2[vb] = (f32x4){0.f, 0.f, 0.f, 0.f}; }
    for (int kk = 0; kk <= (w >> 1); ++kk) {
        const bf16x8 pb = *(const bf16x8*)(P + i_loc * RP + 32 * kk + 8 * fq);
#pragma unroll
        for (int vb = 0; vb < 8; ++vb) {
            const bf16x8 a = *(const bf16x8*)(vT + (16 * vb + fr) * RP + 32 * kk + 8 * fq);
            a1[vb] = __builtin_amdgcn_mfma_f32_16x16x32_bf16(a, pb, a1[vb], 0, 0, 0);
        }
    }
#pragma unroll
    for (int kk = 0; kk < 4; ++kk) {
#pragma unroll
        for (int vb = 0; vb < 8; ++vb) {
            const bf16x8 a = *(const bf16x8*)(ST + (16 * vb + fr) * RP + 32 * kk + 8 * fq);
            a2[vb] = __builtin_amdgcn_mfma_f32_16x16x32_bf16(a, qf[kk], a2[vb], 0, 0, 0);
        }
    }
    const float qd = fexp2(lg * (float)(i_loc + 1));
    float sum = 0.f;
#pragma unroll
    for (int vb = 0; vb < 8; ++vb) { a1[vb] = a1[vb] + qd * a2[vb]; sum += (a1[vb].x + a1[vb].y) + (a1[vb].z + a1[vb].w); }
    sum += __shfl_xor(sum, 16); sum += __shfl_xor(sum, 32);
    const float mu = sum * (1.f / 128.f);
    float var = 0.f;
#pragma unroll
    for (int vb = 0; vb < 8; ++vb) { const f32x4 d = a1[vb] - mu; var += (d.x * d.x + d.y * d.y) + (d.z * d.z + d.w * d.w); }
    var += __shfl_xor(var, 16); var += __shfl_xor(var, 32);
    const float rstd = __builtin_amdgcn_rsqf(var * (1.f / 128.f) + EPS);
    const bf16_t* gr = proj + (size_t)(row0 + i_loc) * DP + 1536 + h * 128 + 4 * fq;
    bf16_t* orow = mix + (size_t)(row0 + i_loc) * D + h * 128 + 4 * fq;
#pragma unroll
    for (int vb = 0; vb < 8; ++vb) {
        const u32x2 g = *(const u32x2*)(gr + 16 * vb);
        const f32x4 d = (a1[vb] - mu) * rstd;
        u32x2 o; o.x = cvt_pk_bf16(d.x * siluf_(bflo(g.x)), d.y * siluf_(bfhi(g.x))); o.y = cvt_pk_bf16(d.z * siluf_(bflo(g.y)), d.w * siluf_(bfhi(g.y)));
        *(u32x2*)(orow + 16 * vb) = o;
    }
    __syncthreads();
}

#define LBAR() do { asm volatile("s_waitcnt lgkmcnt(0)" ::: "memory"); __builtin_amdgcn_s_barrier(); asm volatile("" ::: "memory"); } while (0)
template <bool FINAL>
DEV void lru_phase(const Params& p) {
    unsigned char* ws = p.ws;
    const bf16_t* proj = (const bf16_t*)(ws + W_PROJ); bf16_t* mix = (bf16_t*)(ws + W_MIX); const bf16_t* WrT = (const bf16_t*)(ws + W_WRT);
    const float* spl = (const float*)(ws + W_SPL); float* agg = (float*)(ws + W_AGG); const float* hin0g = (const float*)(ws + W_HIN0);
    float* xcf = (float*)shm_raw;
    constexpr int XP = 68;
    float* af = xcf + 128 * XP;
    bf16_t* xcb = (bf16_t*)(af + 128 * XP);
    float* segA = (float*)(xcb + 128 * 72);
    float* segB = segA + 512;
    float* hin = segB + 512;
    bf16_t* wT = (bf16_t*)(hin + 512);
    float* cwL = (float*)(wT + 2 * 64 * 72);
    bf16_t* gbuf = (bf16_t*)(cwL + 8 * 64);
    const int tid = TIDX(), w = tid >> 6, lane = tid & 63, fr = lane & 15, fq = lane >> 4;
    const int tt = tid >> 2, e0 = (tid & 3) * 16;
    int key = -1;
    u32x4 xr[4][2]; u32x4 gr[2]; float h0 = 0.f;
    auto prefetch = [&](int unit) {
        const int c = unit & 15, jb = (unit >> 4) & 7, b = unit >> 7, ch0 = 64 * jb;
#pragma unroll
        for (int k = 0; k < 4; ++k) {
            const int tabs = c * 128 + tt - 3 + k;
            xr[k][0] = (u32x4){0u, 0u, 0u, 0u}; xr[k][1] = xr[k][0];
            if (tabs >= 0) { const bf16_t* xp = proj + (size_t)(b * TSEQ + tabs) * DP + 2048 + ch0 + e0; xr[k][0] = *(const u32x4*)xp; xr[k][1] = *(const u32x4*)(xp + 8); }
        }
        if (FINAL) {
            const bf16_t* gp = proj + (size_t)(b * TSEQ + c * 128 + tt) * DP + 2560 + ch0 + e0; gr[0] = *(const u32x4*)gp; gr[1] = *(const u32x4*)(gp + 8);
            if (tid < 64) h0 = hin0g[(size_t)unit * 64 + tid];
        }
    };
    int it = BIDX();
    if (it < 1024) prefetch(it);
    for (; it < 1024; it += gridDim.x) {
        const int unit = it, c = unit & 15, jb = (unit >> 4) & 7, b = unit >> 7, row0 = b * TSEQ + c * 128, ch0 = 64 * jb;
        if ((unit & 127) != key) {
            key = unit & 127;
            { const int g = tid >> 8, e = (tid >> 2) & 63, sg = tid & 3; const bf16_t* src = WrT + (size_t)((g * 8 + jb) * 64 + e) * 64 + sg * 16;
              *(u32x4*)(wT + (g * 64 + e) * 72 + sg * 16) = *(const u32x4*)src; *(u32x4*)(wT + (g * 64 + e) * 72 + sg * 16 + 8) = *(const u32x4*)(src + 8); }
            { const int q = tid >> 6, e = tid & 63; float v;
              if (q < 4) v = p.cl_w[q * DLRU + ch0 + e]; else if (q == 4) v = p.cl_b[ch0 + e]; else if (q == 5) v = p.b_r[ch0 + e]; else if (q == 6) v = p.b_i[ch0 + e]; else v = spl[ch0 + e];
              cwL[q * 64 + e] = v; }
            LBAR();
        }
        {
            float accv[16];
#pragma unroll
            for (int i = 0; i < 4; ++i) { const f32x4 cb = *(const f32x4*)(cwL + 4 * 64 + e0 + 4 * i); accv[4 * i] = cb.x; accv[4 * i + 1] = cb.y; accv[4 * i + 2] = cb.z; accv[4 * i + 3] = cb.w; }
#pragma unroll
            for (int k = 0; k < 4; ++k) {
                float xv[16]; unpack8(xr[k][0], xv); unpack8(xr[k][1], xv + 8);
#pragma unroll
                for (int i = 0; i < 4; ++i) { const f32x4 cw = *(const f32x4*)(cwL + k * 64 + e0 + 4 * i);
                    accv[4 * i] += cw.x * xv[4 * i]; accv[4 * i + 1] += cw.y * xv[4 * i + 1]; accv[4 * i + 2] += cw.z * xv[4 * i + 2]; accv[4 * i + 3] += cw.w * xv[4 * i + 3]; }
            }
#pragma unroll
            for (int i = 0; i < 4; ++i) *(f32x4*)(xcf + tt * XP + e0 + 4 * i) = (f32x4){accv[4 * i], accv[4 * i + 1], accv[4 * i + 2], accv[4 * i + 3]};
            *(u32x4*)(xcb + tt * 72 + e0) = pack8(accv); *(u32x4*)(xcb + tt * 72 + e0 + 8) = pack8(accv + 8);
            if (FINAL) { *(u32x4*)(gbuf + tt * 64 + e0) = gr[0]; *(u32x4*)(gbuf + tt * 64 + e0 + 8) = gr[1]; }
        }
        const float h0u = h0;
        if (it + (int)gridDim.x < 1024) prefetch(it + gridDim.x);
        LBAR();
        {
            const int t = 16 * w + fr;
            bf16x8 xb[2];
#pragma unroll
            for (int kk = 0; kk < 2; ++kk) xb[kk] = *(const bf16x8*)(xcb + t * 72 + 32 * kk + 8 * fq);
            const bool first = (c == 0 && t == 0);
#pragma unroll
            for (int eb = 0; eb < 4; ++eb) {
                f32x4 ar = (f32x4){0.f, 0.f, 0.f, 0.f}, ai = (f32x4){0.f, 0.f, 0.f, 0.f};
#pragma unroll
                for (int kk = 0; kk < 2; ++kk) {
                    const bf16x8 wr_ = *(const bf16x8*)(wT + (16 * eb + fr) * 72 + 32 * kk + 8 * fq);
                    const bf16x8 wi_ = *(const bf16x8*)(wT + (64 + 16 * eb + fr) * 72 + 32 * kk + 8 * fq);
                    ar = __builtin_amdgcn_mfma_f32_16x16x32_bf16(wr_, xb[kk], ar, 0, 0, 0);
                    ai = __builtin_amdgcn_mfma_f32_16x16x32_bf16(wi_, xb[kk], ai, 0, 0, 0);
                }
                const int e = 16 * eb + 4 * fq;
                const f32x4 br = *(const f32x4*)(cwL + 5 * 64 + e), bi = *(const f32x4*)(cwL + 6 * 64 + e), sp = *(const f32x4*)(cwL + 7 * 64 + e);
                const f32x4 xc4 = *(const f32x4*)(xcf + t * XP + e);
                f32x4 av, bv;
#pragma unroll
                for (int r = 0; r < 4; ++r) {
                    const float rr = sigmoidf_(ar[r] + br[r]), ii = sigmoidf_(ai[r] + bi[r]);
                    const float la = -sp[r] * rr, a = fexp2(1.4426950408889634f * la), x2 = 2.f * la;
                    const float em = -x2 * (1.f + 0.5f * x2 * (1.f + (1.f / 3.f) * x2 * (1.f + 0.25f * x2 * (1.f + 0.2f * x2 * (1.f + (1.f / 6.f) * x2)))));
                    const float mult = first ? 1.f : __builtin_amdgcn_sqrtf(em);
                    av[r] = a; bv[r] = mult * ii * xc4[r];
                }
                *(f32x4*)(af + t * XP + e) = av; *(f32x4*)(xcf + t * XP + e) = bv;
            }
        }
        LBAR();
        const int e = tid & 63, seg = tid >> 6;
        {
            float A = 1.f, B = 0.f;
#pragma unroll
            for (int i = 0; i < 16; ++i) { const int t = seg * 16 + i; const float a = af[t * XP + e]; B = a * B + xcf[t * XP + e]; A *= a; }
            segA[seg * 64 + e] = A; segB[seg * 64 + e] = B;
        }
        LBAR();
        if (!FINAL) {
            if (tid < 64) {
                float A = 1.f, B = 0.f;
#pragma unroll
                for (int s = 0; s < 8; ++s) { const float a = segA[s * 64 + tid]; B = a * B + segB[s * 64 + tid]; A *= a; }
                agg[(size_t)unit * 128 + tid] = A; agg[(size_t)unit * 128 + 64 + tid] = B;
            }
        } else {
            if (tid < 64) {
                float hh = h0u;
#pragma unroll
                for (int s = 0; s < 8; ++s) { hin[s * 64 + tid] = hh; hh = segA[s * 64 + tid] * hh + segB[s * 64 + tid]; }
            }
            LBAR();
            float hh = hin[seg * 64 + e];
#pragma unroll
            for (int i = 0; i < 16; ++i) {
                const int t = seg * 16 + i;
                hh = af[t * XP + e] * hh + xcf[t * XP + e];
                gbuf[t * 64 + e] = f2bf(hh * geluf_(bf2f(gbuf[t * 64 + e])));
            }
            if (c == 15 && seg == 7) {
                p.out[O_LHP + b * 512 + ch0 + e] = hh;
#pragma unroll
                for (int k = 0; k < 3; ++k) p.out[O_LCP + (size_t)(b * 3 + k) * 512 + ch0 + e] = bf2f(proj[(size_t)(b * TSEQ + 2045 + k) * DP + 2048 + ch0 + e]);
            }
            LBAR();
            { bf16_t* op = mix + (size_t)(row0 + tt) * D + 512 + ch0 + e0; *(u32x4*)op = *(const u32x4*)(gbuf + tt * 64 + e0); *(u32x4*)(op + 8) = *(const u32x4*)(gbuf + tt * 64 + e0 + 8); }
        }
        LBAR();
    }
    __syncthreads();
}

DEV void phase_scan(const Params& p) {
    unsigned char* ws = p.ws;
    const float* KVT = (const float*)(ws + W_KVT); bf16_t* STg = (bf16_t*)(ws + W_H);
    const float* agg = (const float*)(ws + W_AGG); float* hin0g = (float*)(ws + W_HIN0);
    const int gt = BIDX() * 512 + TIDX(), GT = gridDim.x * 512;
    for (int gid = gt; gid < 32 * 4096; gid += GT) {
        const int bh = gid >> 12, idx = gid & 4095, dv = idx >> 5, dk0 = (idx & 31) * 4, h = bh & 3;
        const float cd = exp2f(gamma_log2(h) * 128.f);
        const float* src = KVT + (size_t)bh * 16 * 16384 + dv * 128 + dk0;
        f32x4 kv[16];
#pragma unroll
        for (int m = 0; m < 16; ++m) kv[m] = *(const f32x4*)(src + (size_t)m * 16384);
        f32x4 S = (f32x4){0.f, 0.f, 0.f, 0.f};
        bf16_t* dst = STg + (size_t)bh * 16 * 16384 + dv * 128 + dk0;
#pragma unroll
        for (int m = 0; m < 16; ++m) {
            u32x2 o; o.x = cvt_pk_bf16(S.x, S.y); o.y = cvt_pk_bf16(S.z, S.w);
            *(u32x2*)(dst + (size_t)m * 16384) = o;
            S = S * cd + kv[m];
        }
        float* rp = p.out + O_RETP + (size_t)bh * 16384 + dv;
        rp[(dk0 + 0) * 128] = S.x; rp[(dk0 + 1) * 128] = S.y; rp[(dk0 + 2) * 128] = S.z; rp[(dk0 + 3) * 128] = S.w;
    }
    for (int gid = gt; gid < 64 * 64; gid += GT) {
        const int bjb = gid >> 6, e = gid & 63;
        float A[16], B[16];
#pragma unroll
        for (int c = 0; c < 16; ++c) { A[c] = agg[(size_t)(bjb * 16 + c) * 128 + e]; B[c] = agg[(size_t)(bjb * 16 + c) * 128 + 64 + e]; }
        float hh = 0.f;
#pragma unroll
        for (int c = 0; c < 16; ++c) { hin0g[(size_t)(bjb * 16 + c) * 64 + e] = hh; hh = A[c] * hh + B[c]; }
    }
}

DEV void sample_ret2(const Params& p, int unit) {
    unsigned char* ws = p.ws;
    const float* projS = (const float*)(ws + W_PROJS); const float* rope = (const float*)(ws + W_ROPE) + (size_t)TSEQ * 128; bf16_t* mix = (bf16_t*)(ws + W_MIX);
    const int h = unit & 3, b = unit >> 2, tid = TIDX();
    float* qs = (float*)shm_raw; float* ks = qs + 128; float* vs = ks + 128; float* part = vs + 128;
    float* red = part + 16 * 128;
    const float* pr = projS + (size_t)b * DP;
    const float gam = 1.f - exp2f(-5.f - (float)h);
    if (tid < 64) {
        const float c = rope[tid], s = rope[64 + tid];
        const float q1 = pr[h * 128 + tid], q2 = pr[h * 128 + 64 + tid], k1 = pr[512 + h * 128 + tid], k2 = pr[512 + h * 128 + 64 + tid];
        const float qa = q1 * c - q2 * s, qb = q1 * s + q2 * c, ka = (k1 * c - k2 * s) * 0.08838834764831845f, kb = (k1 * s + k2 * c) * 0.08838834764831845f;
        qs[tid] = qa; qs[64 + tid] = qb; ks[tid] = ka; ks[64 + tid] = kb;
        const float qkp = wave_sum(qa * ka + qb * kb);
        if (tid == 0) red[4] = qkp;
    } else if (tid < 192) vs[tid - 64] = pr[1024 + h * 128 + tid - 64];
    __syncthreads();
    {
        const int dv4 = (tid & 31) * 4, dkg = tid >> 5;
        const f32x4 v4 = *(const f32x4*)(vs + dv4);
        const float* S0 = p.st_ret + (size_t)unit * 16384; float* S1 = p.out + O_RETS + (size_t)unit * 16384;
        f32x4 po = (f32x4){0.f, 0.f, 0.f, 0.f};
#pragma unroll
        for (int i = 0; i < 8; ++i) {
            const int dk = dkg * 8 + i;
            const f32x4 s0 = *(const f32x4*)(S0 + dk * 128 + dv4);
            *(f32x4*)(S1 + dk * 128 + dv4) = s0 * gam + ks[dk] * v4;
            po = po + qs[dk] * s0;
        }
        *(f32x4*)(part + dkg * 128 + dv4) = po;
    }
    __syncthreads();
    float o = 0.f;
    if (tid < 128) {
        const float qk = red[4];
#pragma unroll
        for (int g = 0; g < 16; ++g) o += part[g * 128 + tid];
        o = qk * vs[tid] + gam * o;
        const float s1 = wave_sum(o);
        if ((tid & 63) == 0) red[tid >> 6] = s1;
    }
    __syncthreads();
    float mu = 0.f, dlt = 0.f;
    if (tid < 128) {
        mu = (red[0] + red[1]) * (1.f / 128.f); dlt = o - mu;
        const float s2 = wave_sum(dlt * dlt);
        if ((tid & 63) == 0) red[2 + (tid >> 6)] = s2;
    }
    __syncthreads();
    if (tid < 128) {
        const float rstd = __builtin_amdgcn_rsqf((red[2] + red[3]) * (1.f / 128.f) + EPS);
        const float g = pr[1536 + h * 128 + tid];
        mix[(size_t)(NTOK + b) * D + h * 128 + tid] = f2bf(dlt * rstd * siluf_(g));
    }
    __syncthreads();
}

DEV void sample_lru(const Params& p, int b) {
    unsigned char* ws = p.ws;
    const float* projS = (const float*)(ws + W_PROJS); bf16_t* mix = (bf16_t*)(ws + W_MIX); const float* spl = (const float*)(ws + W_SPL);
    float* xcS = (float*)shm_raw;
    const int ch = TIDX();
    const float* pr = projS + (size_t)b * DP;
    const float s0 = p.st_cl[(size_t)(b * 3 + 0) * 512 + ch], s1 = p.st_cl[(size_t)(b * 3 + 1) * 512 + ch], s2 = p.st_cl[(size_t)(b * 3 + 2) * 512 + ch], x = pr[2048 + ch];
    const float xc = p.cl_b[ch] + p.cl_w[ch] * s0 + p.cl_w[512 + ch] * s1 + p.cl_w[1024 + ch] * s2 + p.cl_w[1536 + ch] * x;
    xcS[ch] = xc;
    __syncthreads();
    const int jb = ch >> 6, e = ch & 63;
    float pr_ = 0.f, pi_ = 0.f;
    const float* wr = p.w_r + (size_t)jb * 4096 + e; const float* wi = p.w_i + (size_t)jb * 4096 + e;
#pragma unroll 8
    for (int d = 0; d < 64; ++d) { const float xv = xcS[64 * jb + d]; pr_ += xv * wr[d * 64]; pi_ += xv * wi[d * 64]; }
    const float rr = sigmoidf_(pr_ + p.b_r[ch]), ii = sigmoidf_(pi_ + p.b_i[ch]);
    const float la = -spl[ch] * rr, a = __expf(la), mult = sqrtf(-expm1f(2.f * la));
    const float hh = a * p.st_h[(size_t)b * 512 + ch] + mult * ii * xc;
    p.out[O_LHS + (size_t)b * 512 + ch] = hh;
    p.out[O_LCS + (size_t)(b * 3 + 0) * 512 + ch] = s1; p.out[O_LCS + (size_t)(b * 3 + 1) * 512 + ch] = s2; p.out[O_LCS + (size_t)(b * 3 + 2) * 512 + ch] = x;
    mix[(size_t)(NTOK + b) * D + 512 + ch] = f2bf(hh * geluf_(pr[2560 + ch]));
    __syncthreads();
}

DEV void phase_mixA(const Params& p) {
    constexpr int N1 = 512, N3 = 512, N4 = 128;
    {
        const float* mod = (const float*)(p.ws + W_MOD); bf16_t* shf = (bf16_t*)(p.ws + W_SHF);
        const int gt = BIDX() * 512 + TIDX(), GT = gridDim.x * 512;
        for (int i = gt; i < NMODROWS * D; i += GT) { const int row = i >> 10, k = i & 1023; shf[i] = f2bf(row < 136 ? mod[(size_t)row * 6144 + 3 * D + k] : 0.f); }
    }
    lru_phase<false>(p);
    for (int it = BIDX(); it < N1 + N3 + N4; it += gridDim.x) {
        if (it < N1) ret_passA(p, it);
        else if (it < N1 + N3) sample_ret2(p, it - N1);
        else sample_lru(p, it - N1 - N3);
    }
}
DEV void phase_mixC(const Params& p) {
    constexpr int N1 = 512;
    lru_phase<true>(p);
    for (int it = BIDX(); it < N1; it += gridDim.x) {
        { const int u = it; const int n = u & 15; const int nn = (((u >> 4) ^ (u >> 8)) & 1) ? 15 - n : n; ret_passC(p, (u & ~15) | nn); }
    }
}

DEV void phase_outproj(const Params& p) {
    unsigned char* ws = p.ws;
    const bf16_t* mix = (const bf16_t*)(ws + W_MIX); const bf16_t* BtOut = (const bf16_t*)(ws + W_BTOUT); bf16_t* xs = (bf16_t*)(ws + W_H);
    const float* mod = (const float*)(ws + W_MOD); float* rss1 = (float*)(ws + W_RSS1);
    constexpr int NBIG = 64 * 4;
    gemm_phase<false>(mix, BtOut, D, 64, 4, NBIG, nullptr, [&](const f32x4 (&acc)[2][2][4][2], int pm, int pn, int brow, int bcol, int wr, int wc, int fr, int fq) {
                const int b = brow >> 11;
                const float* mrow = mod + (size_t)b * 6144;
                f32x4 gt[2][2], sf[2][2];
#pragma unroll
                for (int bj = 0; bj < 2; ++bj)
#pragma unroll
                    for (int n = 0; n < 2; ++n) {
                        const int col = bcol + bj * HALF + wc * 32 + 8 * fq + 4 * n;
                        gt[bj][n] = *(const f32x4*)(mrow + 2 * D + col);
                        sf[bj][n] = *(const f32x4*)(p.g_ffn + col) * (1.f + *(const f32x4*)(mrow + 4 * D + col));
                    }
#pragma unroll
                for (int ai = 0; ai < 2; ++ai)
#pragma unroll
                    for (int m = 0; m < 4; ++m) {
                        const int row = brow + ai * HALF + wr * 64 + m * 16 + fr;
                        float ss = 0.f;
#pragma unroll
                        for (int bj = 0; bj < 2; ++bj) {
                            const int col = bcol + bj * HALF + wc * 32 + 8 * fq;
                            f32x4 y[2];
#pragma unroll
                            for (int n = 0; n < 2; ++n) {
                                y[n] = *(const f32x4*)(p.x_p + (size_t)row * D + col + 4 * n) + gt[bj][n] * acc[ai][bj][m][n];
                                ss += (y[n].x * y[n].x + y[n].y * y[n].y) + (y[n].z * y[n].z + y[n].w * y[n].w);
                                y[n] = y[n] * sf[bj][n];
                            }
                            u32x4 w; w.x = cvt_pk_bf16(y[0].x, y[0].y); w.y = cvt_pk_bf16(y[0].z, y[0].w); w.z = cvt_pk_bf16(y[1].x, y[1].y); w.w = cvt_pk_bf16(y[1].z, y[1].w);
                            *(u32x4*)(xs + (size_t)row * D + col) = w;
                        }
                        ss += __shfl_xor(ss, 16); ss += __shfl_xor(ss, 32);
                        if (fq == 0) atomicAdd(rss1 + row, ss);
                    }
            });
    const bf16_t* BtUp = (const bf16_t*)(ws + W_BTUP); const bf16_t* shf = (const bf16_t*)(ws + W_SHF); float* sW = (float*)(ws + W_SW);
    SKINNY_LOOP(j, NBIG, 64 + 176) {
        if (j < 64) {
            const int g = j >> 1, n = j & 1;
            const bf16_t* B0 = BtOut + (size_t)(32 * g + 16 * n) * D;
            skinny_tile<8, 1, 4>(mix + (size_t)NTOK * D, D, B0, B0, D, [&](int row, int s, float v0, float v1) {
                const float* mrow = mod + (size_t)(8 + row) * 6144;
                const int c0 = 32 * g + slotcol(n, s);
                const float y0 = p.x_s[(size_t)row * D + c0] + mrow[2 * D + c0] * v0;
                p.out[O_YS + (size_t)row * D + c0] = y0;
                xs[(size_t)(NTOK + row) * D + c0] = f2bf(y0 * p.g_ffn[c0] * (1.f + mrow[4 * D + c0]));
                return y0 * y0;
            }, [&](int row, float ss) { atomicAdd(rss1 + NTOK + row, ss); });
        } else {
            const int t = j - 64, pn = t >> 3, bj = (t >> 2) & 1, g4 = t & 3;
            const bf16_t* B0 = BtUp + (size_t)(256 * pn + 128 * bj + 32 * g4) * D;
            skinny_tile<9, 2, 4>(shf, D, B0, B0 + 16 * D, D, [&](int row, int s, float v0, float v1) {
                const int c0 = bj * DFF + 128 * pn + 32 * g4 + slotcol(0, s); sW[(size_t)row * (2 * DFF) + c0] = v0; sW[(size_t)row * (2 * DFF) + c0 + 4] = v1; return 0.f;
            });
        }
    }
}

DEV void phase_up(const Params& p) {
    unsigned char* ws = p.ws;
    const bf16_t* xs = (const bf16_t*)(ws + W_H); const bf16_t* BtUp = (const bf16_t*)(ws + W_BTUP); bf16_t* fin = (bf16_t*)(ws + W_PROJ);
    const float* sW = (const float*)(ws + W_SW); const float* rss1 = (const float*)(ws + W_RSS1);
    float* edgeU = (float*)(ws + W_EDGEU); float* edgeG = (float*)(ws + W_EDGEG); float* tailU = (float*)(ws + W_TAILU);
    constexpr int NBIG = 64 * 22, NSK = 176;
    gemm_phase<false>(xs, BtUp, D, 64, 22, NBIG, nullptr, [&](f32x4 (&acc)[2][2][4][2], int pm, int pn, int brow, int bcol, int wr, int wc, int fr, int fq) {
        float* halo = (float*)(shm_raw + 131072);
        const int b = brow >> 11;
        const int ff0 = 128 * pn + wc * 32 + 8 * fq;
        const int cl0 = wc * 32 + 8 * fq;
        {
            f32x4 swc[2], swg[2];
#pragma unroll
            for (int n = 0; n < 2; ++n) { swc[n] = *(const f32x4*)(sW + (size_t)b * (2 * DFF) + ff0 + 4 * n); swg[n] = *(const f32x4*)(sW + (size_t)b * (2 * DFF) + DFF + ff0 + 4 * n); }
#pragma unroll
            for (int ai = 0; ai < 2; ++ai)
#pragma unroll
                for (int m = 0; m < 4; ++m) {
                    const int rl = ai * HALF + wr * 64 + m * 16 + fr;
                    const float rstd = __builtin_amdgcn_rsqf(rss1[brow + rl] * (1.f / D) + EPS);
#pragma unroll
                    for (int n = 0; n < 2; ++n) { acc[ai][0][m][n] = acc[ai][0][m][n] * rstd + swc[n]; acc[ai][1][m][n] = acc[ai][1][m][n] * rstd + swg[n]; }
                }
        }
        if (fr >= 14) {
#pragma unroll
            for (int ai = 0; ai < 2; ++ai)
#pragma unroll
                for (int n = 0; n < 2; ++n) *(f32x4*)(halo + ((ai * 2 + wr) * 2 + fr - 14) * 128 + cl0 + 4 * n) = acc[ai][0][3][n];
        }
        __syncthreads();
        {
            f32x4 cw0[2], cw1[2], cw2[2], cb[2];
#pragma unroll
            for (int n = 0; n < 2; ++n) {
                cw0[n] = *(const f32x4*)(p.cf_w + ff0 + 4 * n); cw1[n] = *(const f32x4*)(p.cf_w + DFF + ff0 + 4 * n); cw2[n] = *(const f32x4*)(p.cf_w + 2 * DFF + ff0 + 4 * n);
                cb[n] = *(const f32x4*)(p.cf_b + ff0 + 4 * n);
            }
#pragma unroll
            for (int ai = 0; ai < 2; ++ai) {
                const int st = ai * 2 + wr;
                f32x4 um1[2];
#pragma unroll
                for (int n = 0; n < 2; ++n) {
                    um1[n] = (f32x4){0.f, 0.f, 0.f, 0.f};
                    if (st > 0 && fr >= 14) um1[n] = *(const f32x4*)(halo + ((st - 1) * 2 + fr - 14) * 128 + cl0 + 4 * n);
                }
#pragma unroll
                for (int m = 0; m < 4; ++m) {
                    const int rl = ai * HALF + wr * 64 + m * 16 + fr;
                    unsigned wv[4];
#pragma unroll
                    for (int n = 0; n < 2; ++n) {
                        const f32x4 u = acc[ai][0][m][n], g = acc[ai][1][m][n];
                        f32x4 p1, p2;
#pragma unroll
                        for (int c = 0; c < 4; ++c) { p1[c] = dpp_shr1(dpp_ror1(um1[n][c]), u[c]); p2[c] = dpp_shr2(dpp_ror2(um1[n][c]), u[c]); }
                        const f32x4 uc = cb[n] + cw0[n] * p2 + cw1[n] * p1 + cw2[n] * u;
                        wv[2 * n] = cvt_pk_bf16(geluf_(uc.x) * g.x, geluf_(uc.y) * g.y); wv[2 * n + 1] = cvt_pk_bf16(geluf_(uc.z) * g.z, geluf_(uc.w) * g.w);
                        um1[n] = u;
                    }
                    if (rl >= 2) {
                        u32x4 w; w.x = wv[0]; w.y = wv[1]; w.z = wv[2]; w.w = wv[3];
                        *(u32x4*)(fin + (size_t)(brow + rl) * DFF + ff0) = w;
                    } else {
#pragma unroll
                        for (int n = 0; n < 2; ++n) {
                            *(f32x4*)(edgeU + (size_t)(pm * 2 + rl) * DFF + ff0 + 4 * n) = acc[ai][0][m][n];
                            *(f32x4*)(edgeG + (size_t)(pm * 2 + rl) * DFF + ff0 + 4 * n) = acc[ai][1][m][n];
                        }
                    }
                    if (rl >= 254) {
#pragma unroll
                        for (int n = 0; n < 2; ++n) {
                            *(f32x4*)(tailU + (size_t)(pm * 2 + rl - 254) * DFF + ff0 + 4 * n) = acc[ai][0][m][n];
                            if ((pm & 7) == 7) *(f32x4*)(p.out + O_FCP + (size_t)(b * 2 + rl - 254) * DFF + ff0 + 4 * n) = acc[ai][0][m][n];
                        }
                    }
                }
            }
        }
    });
    SKINNY_LOOP(j, NBIG, NSK) {
            const int t = j, pn = t >> 3, g4 = (t >> 1) & 3, n = t & 1;
            const bf16_t* B0 = BtUp + (size_t)(256 * pn + 32 * g4 + 16 * n) * D;
            skinny_tile<8, 2, 4>(xs + (size_t)NTOK * D, D, B0, B0 + 128 * D, D, [&](int row, int s, float v0, float v1) {
                const int ff = 128 * pn + 32 * g4 + slotcol(n, s);
                const float rstd = __builtin_amdgcn_rsqf(rss1[NTOK + row] * (1.f / D) + EPS);
                const float u = v0 * rstd + sW[(size_t)(8 + row) * (2 * DFF) + ff], g = v1 * rstd + sW[(size_t)(8 + row) * (2 * DFF) + DFF + ff];
                const float s0 = p.st_cf[(size_t)(row * 2 + 0) * DFF + ff], s1 = p.st_cf[(size_t)(row * 2 + 1) * DFF + ff];
                const float uc = p.cf_b[ff] + p.cf_w[ff] * s0 + p.cf_w[DFF + ff] * s1 + p.cf_w[2 * DFF + ff] * u;
                fin[(size_t)(NTOK + row) * DFF + ff] = f2bf(geluf_(uc) * g);
                p.out[O_FCS + (size_t)(row * 2 + 0) * DFF + ff] = s1; p.out[O_FCS + (size_t)(row * 2 + 1) * DFF + ff] = u; return 0.f;
            });
    }
}

DEV void phase_down(const Params& p) {
    unsigned char* ws = p.ws;
    const bf16_t* fin = (const bf16_t*)(ws + W_PROJ); const bf16_t* BtDown = (const bf16_t*)(ws + W_BTDOWN);
    const float* mod = (const float*)(ws + W_MOD); float* rss2 = (float*)(ws + W_RSS2);
    const float* edgeU = (const float*)(ws + W_EDGEU); const float* edgeG = (const float*)(ws + W_EDGEG); const float* tailU = (const float*)(ws + W_TAILU);
    constexpr int NBIG = 64 * 4;
    for (int it = BIDX(); it < NBIG; it += gridDim.x) {
        int pm, pn; tile_order(it, 64, 4, pm, pn);
        bf16_t* fix = (bf16_t*)(ws + W_FIX) + (size_t)it * 2 * DFF;
            {
                const bool hp = (pm & 7) != 0;
                for (int i = TIDX(); i < DFF / 4; i += 512) {
                    const int ff = 4 * i;
                    const f32x4 z = (f32x4){0.f, 0.f, 0.f, 0.f};
                    const f32x4 um1 = hp ? *(const f32x4*)(tailU + (size_t)((pm - 1) * 2 + 1) * DFF + ff) : z, um2 = hp ? *(const f32x4*)(tailU + (size_t)((pm - 1) * 2 + 0) * DFF + ff) : z;
                    const f32x4 u0 = *(const f32x4*)(edgeU + (size_t)(pm * 2) * DFF + ff), u1 = *(const f32x4*)(edgeU + (size_t)(pm * 2 + 1) * DFF + ff);
                    const f32x4 g0 = *(const f32x4*)(edgeG + (size_t)(pm * 2) * DFF + ff), g1 = *(const f32x4*)(edgeG + (size_t)(pm * 2 + 1) * DFF + ff);
                    const f32x4 cb = *(const f32x4*)(p.cf_b + ff), w0 = *(const f32x4*)(p.cf_w + ff), w1 = *(const f32x4*)(p.cf_w + DFF + ff), w2 = *(const f32x4*)(p.cf_w + 2 * DFF + ff);
                    const f32x4 c0 = cb + w0 * um2 + w1 * um1 + w2 * u0, c1 = cb + w0 * um1 + w1 * u0 + w2 * u1;
                    u32x2 o0, o1;
                    o0.x = cvt_pk_bf16(geluf_(c0.x) * g0.x, geluf_(c0.y) * g0.y); o0.y = cvt_pk_bf16(geluf_(c0.z) * g0.z, geluf_(c0.w) * g0.w);
                    o1.x = cvt_pk_bf16(geluf_(c1.x) * g1.x, geluf_(c1.y) * g1.y); o1.y = cvt_pk_bf16(geluf_(c1.z) * g1.z, geluf_(c1.w) * g1.w);
                    *(u32x2*)(fix + ff) = o0; *(u32x2*)(fix + DFF + ff) = o1;
                }
            }
    }
    asm volatile("s_waitcnt vmcnt(0)" ::: "memory");
    __syncthreads();
    gemm_phase<true>(fin, BtDown, DFF, 64, 4, NBIG, (const bf16_t*)(ws + W_FIX), [&](f32x4 (&acc)[2][2][4][2], int pm, int pn, int brow, int bcol, int wr, int wc, int fr, int fq) {
        const int b = brow >> 11;
        const float* mrow = mod + (size_t)b * 6144;
        const bf16_t* xs = (const bf16_t*)(ws + W_H);
        const bool fuse = (gridDim.x == 256);
        unsigned* cnt = (unsigned*)(ws + W_BAR) + 3456 + 64 * pm;
        {
            f32x4 gt[2][2], isf[2][2];
#pragma unroll
            for (int bj = 0; bj < 2; ++bj)
#pragma unroll
                for (int n = 0; n < 2; ++n) {
                    const int col = bcol + bj * HALF + wc * 32 + 8 * fq + 4 * n;
                    gt[bj][n] = *(const f32x4*)(mrow + 5 * D + col);
                    const f32x4 sf = *(const f32x4*)(p.g_ffn + col) * (1.f + *(const f32x4*)(mrow + 4 * D + col));
                    isf[bj][n] = (f32x4){__builtin_amdgcn_rcpf(sf.x), __builtin_amdgcn_rcpf(sf.y), __builtin_amdgcn_rcpf(sf.z), __builtin_amdgcn_rcpf(sf.w)};
                }
#pragma unroll
            for (int ai = 0; ai < 2; ++ai)
#pragma unroll
                for (int m = 0; m < 4; ++m) {
                    const int row = brow + ai * HALF + wr * 64 + m * 16 + fr;
                    float ss = 0.f;
#pragma unroll
                    for (int bj = 0; bj < 2; ++bj) {
                        const int col = bcol + bj * HALF + wc * 32 + 8 * fq;
                        float xv[8]; unpack8(*(const u32x4*)(xs + (size_t)row * D + col), xv);
#pragma unroll
                        for (int n = 0; n < 2; ++n) {
                            const f32x4 x1 = (f32x4){xv[4 * n], xv[4 * n + 1], xv[4 * n + 2], xv[4 * n + 3]} * isf[bj][n];
                            const f32x4 y = x1 + gt[bj][n] * acc[ai][bj][m][n];
                            acc[ai][bj][m][n] = y;
                            ss += (y.x * y.x + y.y * y.y) + (y.z * y.z + y.w * y.w);
                        }
                    }
                    ss += __shfl_xor(ss, 16); ss += __shfl_xor(ss, 32);
                    if (fq == 0) atomicAdd(rss2 + row, ss);
                }
        }
        asm volatile("s_waitcnt vmcnt(0)" ::: "memory");
        __syncthreads();
        if (fuse && TIDX() == 0) {
            __hip_atomic_fetch_add(cnt, 1u, __ATOMIC_RELAXED, __HIP_MEMORY_SCOPE_AGENT);
            unsigned sp = 0;
            while (__hip_atomic_load(cnt, __ATOMIC_RELAXED, __HIP_MEMORY_SCOPE_AGENT) < 4u) { __builtin_amdgcn_s_sleep(2); if (++sp > (1u << 22)) break; }
        }
        __syncthreads();
        {
            f32x4 gf[2][2];
#pragma unroll
            for (int bj = 0; bj < 2; ++bj)
#pragma unroll
                for (int n = 0; n < 2; ++n) gf[bj][n] = *(const f32x4*)(p.g_final + bcol + bj * HALF + wc * 32 + 8 * fq + 4 * n);
            float tot[2][4];
#pragma unroll
            for (int ai = 0; ai < 2; ++ai)
#pragma unroll
                for (int m = 0; m < 4; ++m) tot[ai][m] = fuse ? __hip_atomic_load(rss2 + brow + ai * HALF + wr * 64 + m * 16 + fr, __ATOMIC_RELAXED, __HIP_MEMORY_SCOPE_AGENT) : 0.f;
#pragma unroll
            for (int ai = 0; ai < 2; ++ai)
#pragma unroll
                for (int m = 0; m < 4; ++m) {
                    const int row = brow + ai * HALF + wr * 64 + m * 16 + fr;
                    const float rstd = fuse ? __builtin_amdgcn_rsqf(tot[ai][m] * (1.f / D) + EPS) : 1.f;
#pragma unroll
                    for (int bj = 0; bj < 2; ++bj)
#pragma unroll
                        for (int n = 0; n < 2; ++n)
                            *(f32x4*)(p.out + O_YP + (size_t)row * D + bcol + bj * HALF + wc * 32 + 8 * fq + 4 * n) = fuse ? acc[ai][bj][m][n] * rstd * gf[bj][n] : acc[ai][bj][m][n];
                }
        }
    });
    for (int j = BIDX(); j < 32 * 11; j += gridDim.x) {
        const int g = j / 11, ksl = j - g * 11;
        const bf16_t* B0 = BtDown + (size_t)(32 * g) * DFF + ksl * 256;
        float* part = (float*)(ws + W_KVT) + (size_t)ksl * NSMP * D;
        skinny_tile<8, 2, 2>(fin + (size_t)NTOK * DFF + ksl * 256, DFF, B0, B0 + 16 * DFF, 256, [&](int row, int s, float v0, float v1) {
            const int c0 = 32 * g + slotcol(0, s);
            part[(size_t)row * D + c0] = v0; part[(size_t)row * D + c0 + 4] = v1; return 0.f;
        }, NoRowFn(), DFF);
    }
}

DEV void phase_final(const Params& p) {
    const float* rss2 = (const float*)(p.ws + W_RSS2);
    const int gt = BIDX() * 512 + TIDX(), GT = gridDim.x * 512;
    if (gridDim.x != 256)
    for (int i = gt; i < NTOK * 256; i += GT) {
        const int row = i >> 8, k = (i & 255) * 4;
        const float rstd = __builtin_amdgcn_rsqf(rss2[row] * (1.f / D) + EPS);
        f32x4* yp = (f32x4*)(p.out + (size_t)row * D + k);
        *yp = *yp * rstd * *(const f32x4*)(p.g_final + k);
    }
    const float* part = (const float*)(p.ws + W_KVT); const float* mod = (const float*)(p.ws + W_MOD);
    const int lane = TIDX() & 63, gw = BIDX() * 8 + (TIDX() >> 6), NGW = gridDim.x * 8;
    for (int row = gw; row < NSMP; row += NGW) {
        float* yp = p.out + O_YS + (size_t)row * D; const float* mrow = mod + (size_t)(8 + row) * 6144 + 5 * D;
        f32x4 y[4]; float ss = 0.f;
#pragma unroll
        for (int j = 0; j < 4; ++j) {
            const int k = 4 * lane + 256 * j;
            f32x4 a = (f32x4){0.f, 0.f, 0.f, 0.f};
#pragma unroll
            for (int sl = 0; sl < 11; ++sl) a = a + *(const f32x4*)(part + ((size_t)sl * NSMP + row) * D + k);
            y[j] = *(const f32x4*)(yp + k) + *(const f32x4*)(mrow + k) * a;
            ss += y[j].x * y[j].x + y[j].y * y[j].y + y[j].z * y[j].z + y[j].w * y[j].w;
        }
        const float rstd = __builtin_amdgcn_rsqf(wave_sum(ss) * (1.f / D) + EPS);
#pragma unroll
        for (int j = 0; j < 4; ++j) { const int k = 4 * lane + 256 * j; *(f32x4*)(yp + k) = y[j] * rstd * *(const f32x4*)(p.g_final + k); }
    }
}

#define XB_TMO      128
#define XB_XCNT(j)  (256  + 64 * (j))
#define XB_XSUB(j)  (1280 + 64 * (j))
#define XB_XGEN(j)  (2304 + 64 * (j))
#define XB_TOP      3328
#define XB_TOPGEN   3392
#define XCD_BAR_WORDS 3456
#define XB_SPIN_CAP (1u << 20)
DEV unsigned xb_ld(unsigned* p) { return __hip_atomic_load(p, __ATOMIC_RELAXED, __HIP_MEMORY_SCOPE_AGENT); }
DEV unsigned xb_add(unsigned* p, unsigned v) { return __hip_atomic_fetch_add(p, v, __ATOMIC_RELAXED, __HIP_MEMORY_SCOPE_AGENT); }
DEV unsigned xb_xcc_id() { return (unsigned)__builtin_amdgcn_s_getreg((3 << 11) | 20) & 0xFu; }
#define XB_SPIN(cond, bar) do { unsigned _sp = 0; while (cond) { __builtin_amdgcn_s_sleep(1); \
    if ((++_sp & 255u) == 0u) { if (xb_ld(&(bar)[XB_TMO])) break; if (_sp > XB_SPIN_CAP) { atomicAdd(&(bar)[XB_TMO], 1u); break; } } } } while (0)
struct XcdBarrier { unsigned* bar; unsigned x; volatile LAS unsigned* st; };
DEV XcdBarrier xcd_barrier_post(unsigned* bar, volatile LAS unsigned* st) {
    XcdBarrier b; b.bar = bar; b.x = xb_xcc_id(); b.st = st;
    if (threadIdx.x == 0) (void)xb_add(&bar[XB_XCNT(b.x)], 1u);
    return b;
}
DEV void xcd_barrier_complete(unsigned* bar, unsigned x, unsigned& nloc, unsigned& nx) {
    const unsigned G = gridDim.x * gridDim.y * gridDim.z;
    unsigned sum, cnt, mine, sp = 0u;
    for (;;) {
        sum = 0u; cnt = 0u; mine = 0u;
#pragma unroll
        for (unsigned j = 0; j < 16; ++j) { const unsigned c = xb_ld(&bar[XB_XCNT(j)]); sum += c; cnt += (c > 0u) ? 1u : 0u; mine = (j == x) ? c : mine; }
        if (sum == G) break;
        __builtin_amdgcn_s_sleep(1);
        if ((++sp & 255u) == 0u) { if (xb_ld(&bar[XB_TMO])) break; if (sp > XB_SPIN_CAP) { atomicAdd(&bar[XB_TMO], 1u); break; } }
    }
    nloc = mine > 0u ? mine : 1u; nx = cnt > 0u ? cnt : 1u;
}
DEV void xcd_barrier(const XcdBarrier& b) {
    asm volatile("s_waitcnt vmcnt(0)" ::: "memory");
    __syncthreads();
    if (threadIdx.x == 0) {
        unsigned* bar = b.bar;
        __builtin_amdgcn_s_waitcnt(0);
        unsigned nloc = b.st[0], nx = b.st[1];
        if (nloc == 0u) { xcd_barrier_complete(bar, b.x, nloc, nx); b.st[0] = nloc; b.st[1] = nx; }
        const unsigned old = xb_add(&bar[XB_XSUB(b.x)], 1u);
        const unsigned gen = old / nloc;
        if (old + 1u == (gen + 1u) * nloc) {
            __builtin_amdgcn_fence(__ATOMIC_RELEASE, "agent");
            asm volatile("s_waitcnt vmcnt(0)" ::: "memory");
            const unsigned og = xb_add(&bar[XB_TOP], 1u);
            const unsigned tg = og / nx;
            if (og + 1u == (tg + 1u) * nx) xb_add(&bar[XB_TOPGEN], 1u);
            else XB_SPIN(xb_ld(&bar[XB_TOPGEN]) == tg, bar);
            __builtin_amdgcn_fence(__ATOMIC_ACQUIRE, "agent");
            xb_add(&bar[XB_XGEN(b.x)], 1u);
            asm volatile("s_waitcnt vmcnt(0)" ::: "memory");
        } else {
            XB_SPIN(xb_ld(&bar[XB_XGEN(b.x)]) == gen, bar);
            __builtin_amdgcn_fence(__ATOMIC_ACQUIRE, "agent");
            asm volatile("s_waitcnt vmcnt(0)" ::: "memory");
        }
    }
    __syncthreads();
}

typedef const unsigned long long __attribute__((address_space(4)))* KWordPtr;
DEV Params kparams() {
    KWordPtr k = (KWordPtr)__builtin_amdgcn_kernarg_segment_ptr(); asm volatile("" : "+s"(k));
    Params q; unsigned long long* d = (unsigned long long*)&q;
#pragma unroll
    for (int i = 0; i < (int)(sizeof(Params) / 8); ++i) d[i] = k[i];
    return q;
}
__global__ void __launch_bounds__(512) fwd_kernel(Params p) {
    cg::grid_group grid = cg::this_grid();
    volatile LAS unsigned* xst = (volatile LAS unsigned*)((LAS unsigned char*)shm_raw + (LDS_BYTES - 16));
    if (threadIdx.x == 0) { xst[0] = 0u; xst[1] = 0u; }
    __syncthreads();
    const XcdBarrier xb = xcd_barrier_post((unsigned*)(p.ws + W_BAR), xst);
    const int lo = (int)p.ph_lo, hi = (int)p.ph_hi;
    if (hi < 0) grid.sync();
#ifdef ONLY_PHASE
#define RUNP(si, ph, call) if (ph == ONLY_PHASE) { const Params q = kparams(); call(q); }
#else
#define RUNP(si, ph, call) if (lo <= si && si < hi) { { const Params q = kparams(); call(q); } if (si + 1 < hi) { xcd_barrier(xb); } }
#endif
    RUNP(0, 0, phase_prep)
    RUNP(1, 1, phase_mod)
    RUNP(2, 2, phase_norm1)
    RUNP(3, 3, phase_inproj)
    RUNP(4, 4, phase_mixA)
    RUNP(5, 10, phase_scan)
    RUNP(6, 5, phase_mixC)
    RUNP(7, 6, phase_outproj)
    RUNP(8, 7, phase_up)
    RUNP(9, 8, phase_down)
    RUNP(10, 9, phase_final)
}

extern "C" void kernel_launch(void* const* d_in, const int* in_sizes, int n_in, void* d_out, int out_size, void* d_ws, size_t ws_size, hipStream_t stream) {
    static int grid_blocks = 0;
    if (grid_blocks == 0) {
        if (n_in != 27 || ws_size < W_END) { fprintf(stderr, "kernel_launch: unexpected n_in %d or ws_size %zu (< %zu)\n", n_in, ws_size, (size_t)W_END); grid_blocks = -1; return; }
        int dev = 0, cus = 0, per_cu = 0;
        hipGetDevice(&dev);
        hipDeviceGetAttribute(&cus, hipDeviceAttributeMultiprocessorCount, dev);
        if (hipFuncSetAttribute((const void*)fwd_kernel, hipFuncAttributeMaxDynamicSharedMemorySize, LDS_BYTES) != hipSuccess) { fprintf(stderr, "kernel_launch: hipFuncSetAttribute failed\n"); grid_blocks = -1; return; }
        if (hipOccupancyMaxActiveBlocksPerMultiprocessor(&per_cu, (const void*)fwd_kernel, 512, LDS_BYTES) != hipSuccess || per_cu < 1) { fprintf(stderr, "kernel_launch: occupancy query failed (%d)\n", per_cu); (void)hipGetLastError(); per_cu = 1; }
        grid_blocks = cus * 1;
    }
    if (grid_blocks < 0) return;
    Params p{};
    const float** pp = (const float**)&p;
    for (int i = 0; i < 27; ++i) pp[i] = (const float*)d_in[i];
    p.out = (float*)d_out; p.ws = (unsigned char*)d_ws;
    if (hipMemsetAsync((char*)d_ws + W_BAR, 0, (size_t)BAR_WORDS * 4, stream) != hipSuccess) { fprintf(stderr, "kernel_launch: memset failed\n"); return; }
#if MK_MULTI
    for (int ph = 0; ph < 11; ++ph) {
        p.ph_lo = ph; p.ph_hi = ph + 1;
        hipLaunchKernelGGL(fwd_kernel, dim3(grid_blocks), dim3(512), LDS_BYTES, stream, p);
    }
#else
    p.ph_lo = 0; p.ph_hi = 11;
    void* args[] = {&p};
    hipError_t e = hipLaunchCooperativeKernel((const void*)fwd_kernel, dim3(grid_blocks), dim3(512), args, LDS_BYTES, stream);
    if (e != hipSuccess) fprintf(stderr, "cooperative launch failed: %s (grid %d)\n", hipGetErrorString(e), grid_blocks);
#endif
}
```

```cpp
#include <hip/hip_runtime.h>
#include <hip/hip_cooperative_groups.h>
#include <cstdio>
#include <cstdint>
namespace cg = cooperative_groups;

#ifndef MK_MULTI
#define MK_MULTI 0
#endif

#define DEV __device__ __forceinline__
typedef unsigned short bf16_t;
typedef short bf16x8 __attribute__((ext_vector_type(8)));
typedef float f32x4 __attribute__((ext_vector_type(4)));
typedef unsigned u32x4 __attribute__((ext_vector_type(4)));
typedef unsigned u32x2 __attribute__((ext_vector_type(2)));

constexpr int D = 1024, TSEQ = 2048, NBATCH = 8, NTOK = 16384, NSMP = 128, NROWS = NTOK + NSMP;
constexpr int DP = 3072, DFF = 2816, DLRU = 512, NMODROWS = 144;
constexpr float EPS = 1e-6f;
constexpr int PAST_LEN = 16384;

constexpr size_t O_YP = 0, O_YS = O_YP + (size_t)NTOK * D, O_RETP = O_YS + (size_t)NSMP * D, O_LHP = O_RETP + 8 * 4 * 128 * 128,
                 O_LCP = O_LHP + 8 * 512, O_FCP = O_LCP + 8 * 3 * 512, O_RETS = O_FCP + 8 * 2 * DFF, O_LHS = O_RETS + (size_t)128 * 4 * 128 * 128,
                 O_LCS = O_LHS + 128 * 512, O_FCS = O_LCS + 128 * 3 * 512;

constexpr size_t al256(size_t x) { return (x + 255) & ~(size_t)255; }
constexpr size_t W_BTIN = 0;
constexpr size_t W_BTOUT = W_BTIN + (size_t)DP * D * 2;
constexpr size_t W_BTUP = W_BTOUT + (size_t)D * D * 2;
constexpr size_t W_BTDOWN = W_BTUP + (size_t)2 * DFF * D * 2;
constexpr size_t W_WRT = W_BTDOWN + (size_t)D * DFF * 2;
constexpr size_t W_H = W_WRT + 2 * 8 * 64 * 64 * 2;
constexpr size_t W_PROJ = W_H + (size_t)NROWS * D * 2;
constexpr size_t W_MIX = W_PROJ + (size_t)NTOK * DP * 2;
constexpr size_t W_KVT = W_MIX + (size_t)NROWS * D * 2;
constexpr size_t W_MOD = W_KVT + (size_t)512 * 65536;
constexpr size_t W_SW = W_MOD + (size_t)NMODROWS * 6144 * 4;
constexpr size_t W_PROJS = W_SW + (size_t)NMODROWS * 2 * DFF * 4;
constexpr size_t W_ROPE = W_PROJS + (size_t)NSMP * DP * 4;
constexpr size_t W_EDGEU = al256(W_ROPE + (size_t)(TSEQ + 1) * 128 * 4);
constexpr size_t W_EDGEG = W_EDGEU + (size_t)64 * 2 * DFF * 4;
constexpr size_t W_TAILU = W_EDGEG + (size_t)64 * 2 * DFF * 4;
constexpr size_t W_FIX = W_TAILU + (size_t)64 * 2 * DFF * 4;
constexpr size_t W_AGG = W_FIX + (size_t)256 * 2 * DFF * 2;
constexpr size_t W_RSS1 = W_AGG + (size_t)8 * 8 * 16 * 2 * 64 * 4;
constexpr size_t W_RSS2 = al256(W_RSS1 + (size_t)NROWS * 4);
constexpr size_t W_SPL = al256(W_RSS2 + (size_t)NROWS * 4);
constexpr size_t W_MODA = W_SPL + 512 * 4;
constexpr size_t W_SHF = W_MODA + (size_t)NMODROWS * D * 2;
constexpr size_t W_HIN0 = al256(W_SHF + (size_t)NMODROWS * D * 2);
constexpr size_t W_BAR = W_HIN0 + (size_t)1024 * 64 * 4;
constexpr int BAR_WORDS = 3456 + 64 * 64;
constexpr size_t W_END = W_BAR + (size_t)BAR_WORDS * 4;

constexpr int LDS_BYTES = 147456;

struct Params {
    const float *x_p, *x_s, *c_p, *c_s, *st_ret, *st_h, *st_cl, *st_cf, *w_ada, *b_ada, *g_mix, *w_in, *cl_w, *cl_b, *w_r, *b_r, *w_i, *b_i, *lam,
        *w_out, *g_ffn, *w_upc, *w_upg, *cf_w, *cf_b, *w_down, *g_final;
    float* out;
    unsigned char* ws;
    long long ph_lo, ph_hi;
};

extern __shared__ __attribute__((aligned(16))) unsigned char shm_raw[];

DEV int TIDX() { int t = threadIdx.x; asm volatile("" : "+v"(t)); return t; }
DEV int BIDX() { int b = blockIdx.x; asm volatile("" : "+s"(b)); return b; }
typedef float f32x2_ __attribute__((ext_vector_type(2)));
typedef __bf16 bf16x2_ __attribute__((ext_vector_type(2)));
DEV unsigned cvt_pk_bf16(float lo, float hi) { const f32x2_ v = {lo, hi}; const bf16x2_ r = __builtin_convertvector(v, bf16x2_); return __builtin_bit_cast(unsigned, r); }
DEV bf16_t f2bf(float x) { return (bf16_t)(cvt_pk_bf16(x, 0.f) & 0xffffu); }
DEV float bf2f(bf16_t v) { return __uint_as_float(((unsigned)v) << 16); }
DEV float bflo(unsigned w) { return __uint_as_float(w << 16); }
DEV float bfhi(unsigned w) { return __uint_as_float(w & 0xffff0000u); }
DEV float fexp2(float x) { return __builtin_amdgcn_exp2f(x); }
DEV float sigmoidf_(float x) { return __builtin_amdgcn_rcpf(1.f + fexp2(-1.4426950408889634f * x)); }
DEV float siluf_(float x) { return x * sigmoidf_(x); }
DEV float geluf_(float x) { const float y = 1.5957691216057308f * (x + 0.044715f * x * x * x); return x * sigmoidf_(y); }
DEV float wave_sum(float v) {
#pragma unroll
    for (int o = 1; o < 64; o <<= 1) v += __shfl_xor(v, o);
    return v;
}
DEV void unpack8(u32x4 w, float* f) { f[0] = bflo(w.x); f[1] = bfhi(w.x); f[2] = bflo(w.y); f[3] = bfhi(w.y); f[4] = bflo(w.z); f[5] = bfhi(w.z); f[6] = bflo(w.w); f[7] = bfhi(w.w); }
DEV u32x4 pack8(const float* f) { u32x4 w; w.x = cvt_pk_bf16(f[0], f[1]); w.y = cvt_pk_bf16(f[2], f[3]); w.z = cvt_pk_bf16(f[4], f[5]); w.w = cvt_pk_bf16(f[6], f[7]); return w; }
DEV int rhoinv(int w) { return 16 * ((w >> 2) & 1) + 4 * (w >> 3) + (w & 3); }
DEV int permpos(int c) { return (c & ~31) | rhoinv(c & 31); }
DEV int slotcol(int n, int s) { return 8 * (s >> 2) + 4 * n + (s & 3); }
DEV float gamma_log2(int h) { return __log2f(1.f - exp2f(-5.f - (float)h)); }

constexpr int BM = 256, BK = 64, HALF = 128, HT = HALF * BK;
DEV int lds_byte(int r, int c) { int st = (r >> 4) * 2 + (c >> 5), rr = r & 15, cc = c & 31, ob = rr * 64 + cc * 2; return st * 1024 + (ob ^ (((ob >> 9) & 1) << 5)); }
DEV void stage_rc(int b, int& R, int& C) { int st = b / 1024, sb = b % 1024, swz = sb ^ (((sb >> 9) & 1) << 5); R = (st >> 1) * 16 + swz / 64; C = (st & 1) * 32 + (swz % 64) / 2; }

#define LAS __attribute__((address_space(3)))
template <bool FIX, class Epi>
DEV void gemm_tile(const bf16_t* __restrict__ A, const bf16_t* __restrict__ Bt, const int K, const int brow, const int bcol, const bf16_t* fixA, Epi&& epi) {
    LAS unsigned char* lds = (LAS unsigned char*)shm_raw;
    const int tid = TIDX(), wid = __builtin_amdgcn_readfirstlane(tid >> 6), lane = tid & 63, wr = wid >> 2, wc = wid & 3, fr = lane & 15, fq = lane >> 4;
    const int nt = K / BK;
    constexpr int HTB = HALF * BK * 2;
    unsigned voff[2], voffF[2];
#pragma unroll
    for (int i = 0; i < 2; ++i) {
        int R, C; stage_rc(tid * 16 + i * 8192, R, C);
        voff[i] = (unsigned)(R * K + C) * 2u; voffF[i] = voff[i];
        if (FIX) { if (R < 2) voffF[i] = (unsigned)(((const char*)fixA - (const char*)(A + (size_t)brow * K)) + (long)(R * K + C) * 2); }
    }
    const size_t kstep = (size_t)(BK * 2), hstep = (size_t)HALF * K * 2;
    const unsigned ldsw = (unsigned)wid * 1024u;
    const int aoff = lds_byte(wr * 64 + fr, fq * 8), boff = lds_byte(wc * 32 + fr, fq * 8);
    const char* cA = (const char*)(A + (size_t)brow * K); const char* cB = (const char*)(Bt + (size_t)bcol * K);
#define SA(b, h) (((b) * 2 + (h)) * HTB)
#define SB(b, h) ((4 + (b) * 2 + (h)) * HTB)
#define STAGE(bufoff, gbase, vo) do { _Pragma("unroll") for (int _i = 0; _i < 2; ++_i) \
        __builtin_amdgcn_global_load_lds((const unsigned*)((const char*)(gbase) + (vo)[_i]), (LAS unsigned*)(lds + (bufoff) + ldsw + _i * 8192), 16, 0, 0); } while (0)
#define LDA(dst, b, h) do { _Pragma("unroll") for (int m = 0; m < 4; ++m) _Pragma("unroll") for (int k = 0; k < 2; ++k) dst[m][k] = *(const LAS bf16x8*)(lds + SA(b, h) + aoff + m * 2048 + k * 1024); } while (0)
#define LDB(dst, b, h) do { _Pragma("unroll") for (int n = 0; n < 2; ++n) _Pragma("unroll") for (int k = 0; k < 2; ++k) dst[n][k] = *(const LAS bf16x8*)(lds + SB(b, h) + boff + n * 2048 + k * 1024); } while (0)
#define MMA(ai, bj, At_, Bt_) do { __builtin_amdgcn_s_setprio(1); _Pragma("unroll") for (int m = 0; m < 4; ++m) _Pragma("unroll") for (int n = 0; n < 2; ++n) _Pragma("unroll") for (int k = 0; k < 2; ++k) \
        acc[ai][bj][m][n] = __builtin_amdgcn_mfma_f32_16x16x32_bf16(Bt_[n][k], At_[m][k], acc[ai][bj][m][n], 0, 0, 0); __builtin_amdgcn_s_setprio(0); } while (0)
#define WAIT_V(n) asm volatile("s_waitcnt vmcnt(" #n ")" ::: "memory")
#define WAIT_L(n) asm volatile("s_waitcnt lgkmcnt(" #n ")" ::: "memory")
#define BAR __builtin_amdgcn_s_barrier()
#define SCHED __builtin_amdgcn_sched_barrier(0)
    f32x4 acc[2][2][4][2];
#pragma unroll
    for (int a = 0; a < 2; ++a)
#pragma unroll
        for (int b = 0; b < 2; ++b)
#pragma unroll
            for (int m = 0; m < 4; ++m)
#pragma unroll
                for (int n = 0; n < 2; ++n) acc[a][b][m][n] = (f32x4){0.f, 0.f, 0.f, 0.f};
    bf16x8 At[4][2], B0[2][2], B1[2][2];
    STAGE(SB(0, 0), cB, voff); STAGE(SA(0, 0), cA, voffF); STAGE(SB(0, 1), cB + hstep, voff); STAGE(SA(0, 1), cA + hstep, voff);
    if (wr == 1) BAR;
    WAIT_V(4); BAR;
    STAGE(SB(1, 0), cB + kstep, voff); STAGE(SA(1, 0), cA + kstep, voffF); STAGE(SB(1, 1), cB + hstep + kstep, voff);
    WAIT_V(6); BAR;
    for (int t = 0; t < nt - 2; t += 2) {
        const char* a1 = cA + (size_t)(t + 1) * kstep; const char* a2 = a1 + kstep; const char* a3 = a2 + kstep;
        const char* b2 = cB + (size_t)(t + 2) * kstep; const char* b3 = b2 + kstep;
        LDB(B0, 0, 0); SCHED; LDA(At, 0, 0); STAGE(SA(1, 1), a1 + hstep, voff);
        WAIT_L(8); BAR; WAIT_L(0); MMA(0, 0, At, B0); BAR; SCHED;
        LDB(B1, 0, 1); STAGE(SB(0, 0), b2, voff);
        BAR; WAIT_L(0); MMA(0, 1, At, B1); BAR;
        LDA(At, 0, 1); STAGE(SA(0, 0), a2, voffF);
        BAR; WAIT_L(0); MMA(1, 0, At, B0); BAR; SCHED;
        STAGE(SB(0, 1), b2 + hstep, voff);
        WAIT_V(6); BAR; MMA(1, 1, At, B1); BAR;
        LDB(B0, 1, 0); SCHED; LDA(At, 1, 0); STAGE(SA(0, 1), a2 + hstep, voff);
        WAIT_L(8); BAR; WAIT_L(0); MMA(0, 0, At, B0); BAR; SCHED;
        LDB(B1, 1, 1); STAGE(SB(1, 0), b3, voff);
        BAR; WAIT_L(0); MMA(0, 1, At, B1); BAR;
        LDA(At, 1, 1); STAGE(SA(1, 0), a3, voffF);
        BAR; WAIT_L(0); MMA(1, 0, At, B0); BAR; SCHED;
        STAGE(SB(1, 1), b3 + hstep, voff);
        WAIT_V(6); BAR; MMA(1, 1, At, B1); BAR;
    }
    { LDB(B0, 0, 0); LDA(At, 0, 0); STAGE(SA(1, 1), cA + (size_t)(nt - 1) * kstep + hstep, voff);
      BAR; WAIT_L(0); MMA(0, 0, At, B0); BAR;
      LDB(B1, 0, 1); BAR; WAIT_L(0); MMA(0, 1, At, B1); BAR;
      LDA(At, 0, 1); WAIT_V(4); BAR; WAIT_L(0); MMA(1, 0, At, B0); MMA(1, 1, At, B1); BAR; }
    { LDB(B0, 1, 0); LDA(At, 1, 0); WAIT_V(2); BAR; WAIT_L(0); MMA(0, 0, At, B0); BAR;
      LDB(B1, 1, 1); WAIT_V(0); BAR; WAIT_L(0); MMA(0, 1, At, B1); BAR;
      LDA(At, 1, 1); BAR; WAIT_L(0); MMA(1, 0, At, B0); MMA(1, 1, At, B1); BAR; }
    if (wr == 0) BAR;
    asm volatile("" ::: "memory");
    epi(acc, brow, bcol, wr, wc, fr, fq);
#undef SA
#undef SB
#undef STAGE
#undef LDA
#undef LDB
#undef MMA
}

DEV void tile_order(int L, int nM, int nN, int& pm, int& pn) {
    const int nwg = nM * nN, NX = 8, WGM = 8;
    int wgid = L; { const int q = nwg / NX, r = nwg % NX, xcd = wgid % NX, off = wgid / NX; wgid = (xcd < r ? xcd * (q + 1) : r * (q + 1) + (xcd - r) * q) + off; }
    const int nig = WGM * nN, gid = wgid / nig, fm = gid * WGM, gsz = (nM - fm) < WGM ? (nM - fm) : WGM;
    pm = fm + ((wgid % nig) % gsz); pn = (wgid % nig) / gsz;
}

DEV float dpp_ror1(float x) { return __int_as_float(__builtin_amdgcn_update_dpp(0, __float_as_int(x), 0x121, 0xf, 0xf, false)); }
DEV float dpp_ror2(float x) { return __int_as_float(__builtin_amdgcn_update_dpp(0, __float_as_int(x), 0x122, 0xf, 0xf, false)); }
DEV float dpp_shr1(float old, float x) { return __int_as_float(__builtin_amdgcn_update_dpp(__float_as_int(old), __float_as_int(x), 0x111, 0xf, 0xf, false)); }
DEV float dpp_shr2(float old, float x) { return __int_as_float(__builtin_amdgcn_update_dpp(__float_as_int(old), __float_as_int(x), 0x112, 0xf, 0xf, false)); }
#define SKINNY_LOOP(j, NBIG_, NSK_) const int _nb = gridDim.x, _first = (NBIG_) % _nb, _bb = BIDX(); if (_bb >= _first) for (int j = _bb - _first; j < (NSK_); j += _nb - _first)
template <bool FIX, class Epi>
DEV void gemm_phase(const bf16_t* __restrict__ A, const bf16_t* __restrict__ Bt, const int K, const int nM, const int nN, const int nbig, const bf16_t* fixbase, Epi&& epi) {
    LAS unsigned char* lds = (LAS unsigned char*)shm_raw;
    const int tid = TIDX(), wid = __builtin_amdgcn_readfirstlane(tid >> 6), lane = tid & 63, wr = wid >> 2, wc = wid & 3, fr = lane & 15, fq = lane >> 4;
    const int nt = K / BK, G = gridDim.x;
    int it = BIDX();
    if (it >= nbig) return;
    constexpr int HTB = HALF * BK * 2;
    unsigned voff[2], voffF[2], voffFn[2];
    int sR[2], sC[2];
#pragma unroll
    for (int i = 0; i < 2; ++i) { stage_rc(tid * 16 + i * 8192, sR[i], sC[i]); voff[i] = (unsigned)(sR[i] * K + sC[i]) * 2u; voffF[i] = voff[i]; voffFn[i] = voff[i]; }
    const size_t kstep = (size_t)(BK * 2), hstep = (size_t)HALF * K * 2, tstep = 2 * hstep;
    const unsigned ldsw = (unsigned)wid * 1024u;
    const int aoff = lds_byte(wr * 64 + fr, fq * 8), boff = lds_byte(wc * 32 + fr, fq * 8);
    int pm, pn; tile_order(it, nM, nN, pm, pn);
    const char* cA = (const char*)A + (size_t)pm * tstep; const char* cB = (const char*)Bt + (size_t)pn * tstep;
    if (FIX) {
#pragma unroll
        for (int i = 0; i < 2; ++i) if (sR[i] < 2) voffF[i] = (unsigned)(((const char*)(fixbase + (size_t)it * 2 * K) - cA) + (long)(sR[i] * K + sC[i]) * 2);
    }
#define SA(b, h) (((b) * 2 + (h)) * HTB)
#define SB(b, h) ((4 + (b) * 2 + (h)) * HTB)
#define STAGE(bufoff, gbase, vo) do { _Pragma("unroll") for (int _i = 0; _i < 2; ++_i) \
        __builtin_amdgcn_global_load_lds((const unsigned*)((const char*)(gbase) + (vo)[_i]), (LAS unsigned*)(lds + (bufoff) + ldsw + _i * 8192), 16, 0, 0); } while (0)
#define LDA(dst, b, h) do { _Pragma("unroll") for (int m = 0; m < 4; ++m) _Pragma("unroll") for (int k = 0; k < 2; ++k) dst[m][k] = *(const LAS bf16x8*)(lds + SA(b, h) + aoff + m * 2048 + k * 1024); } while (0)
#define LDB(dst, b, h) do { _Pragma("unroll") for (int n = 0; n < 2; ++n) _Pragma("unroll") for (int k = 0; k < 2; ++k) dst[n][k] = *(const LAS bf16x8*)(lds + SB(b, h) + boff + n * 2048 + k * 1024); } while (0)
#define MMA(ai, bj, At_, Bt_) do { __builtin_amdgcn_s_setprio(1); _Pragma("unroll") for (int m = 0; m < 4; ++m) _Pragma("unroll") for (int n = 0; n < 2; ++n) _Pragma("unroll") for (int k = 0; k < 2; ++k) \
        acc[ai][bj][m][n] = __builtin_amdgcn_mfma_f32_16x16x32_bf16(Bt_[n][k], At_[m][k], acc[ai][bj][m][n], 0, 0, 0); __builtin_amdgcn_s_setprio(0); } while (0)
    f32x4 acc[2][2][4][2];
#define ZACC() do { _Pragma("unroll") for (int a_ = 0; a_ < 2; ++a_) _Pragma("unroll") for (int b_ = 0; b_ < 2; ++b_) _Pragma("unroll") for (int m_ = 0; m_ < 4; ++m_) _Pragma("unroll") for (int n_ = 0; n_ < 2; ++n_) acc[a_][b_][m_][n_] = (f32x4){0.f, 0.f, 0.f, 0.f}; } while (0)
    ZACC();
    bf16x8 At[4][2], B0[2][2], B1[2][2];
    STAGE(SB(0, 0), cB, voff); STAGE(SB(0, 1), cB + hstep, voff); STAGE(SA(0, 0), cA, voffF); STAGE(SA(0, 1), cA + hstep, voff);
    if (wr == 1) BAR;
    WAIT_V(2); BAR;
    STAGE(SB(1, 0), cB + kstep, voff); STAGE(SA(1, 0), cA + kstep, voffF); STAGE(SB(1, 1), cB + hstep + kstep, voff);
    WAIT_V(6); BAR;
    for (;;) {
        const int itn = it + G; const bool has_next = itn < nbig;
        int pmn = pm, pnn = pn; if (has_next) tile_order(itn, nM, nN, pmn, pnn);
        const char* nA = (const char*)A + (size_t)pmn * tstep; const char* nB = (const char*)Bt + (size_t)pnn * tstep;
        if (FIX) {
#pragma unroll
            for (int i = 0; i < 2; ++i) { voffFn[i] = voff[i]; if (sR[i] < 2) voffFn[i] = (unsigned)(((const char*)(fixbase + (size_t)(has_next ? itn : it) * 2 * K) - nA) + (long)(sR[i] * K + sC[i]) * 2); }
        }
        for (int t = 0; t < nt; t += 2) {
            const bool last = (t == nt - 2);
            const char* a1 = cA + (size_t)(t + 1) * kstep;
            const char* a2 = last ? nA : cA + (size_t)(t + 2) * kstep; const char* b2 = last ? nB : cB + (size_t)(t + 2) * kstep;
            const char* a3 = a2 + kstep; const char* b3 = b2 + kstep;
            unsigned vF2[2];
#pragma unroll
            for (int i = 0; i < 2; ++i) vF2[i] = FIX ? (last ? voffFn[i] : voffF[i]) : voff[i];
            LDB(B0, 0, 0); LDB(B1, 0, 1); SCHED; LDA(At, 0, 0); STAGE(SA(1, 1), a1 + hstep, voff);
            WAIT_V(8); WAIT_L(0); BAR; MMA(0, 0, At, B0); MMA(0, 1, At, B1); BAR; SCHED;
            LDA(At, 0, 1); STAGE(SB(0, 0), b2, voff); STAGE(SB(0, 1), b2 + hstep, voff); STAGE(SA(0, 0), a2, vF2);
            WAIT_V(8); WAIT_L(0); BAR; MMA(1, 0, At, B0); MMA(1, 1, At, B1); BAR; SCHED;
            LDB(B0, 1, 0); LDB(B1, 1, 1); SCHED; LDA(At, 1, 0); STAGE(SA(0, 1), a2 + hstep, voff);
            WAIT_V(8); WAIT_L(0); BAR; MMA(0, 0, At, B0); MMA(0, 1, At, B1); BAR; SCHED;
            LDA(At, 1, 1); STAGE(SB(1, 0), b3, voff); STAGE(SB(1, 1), b3 + hstep, voff); STAGE(SA(1, 0), a3, vF2);
            WAIT_V(8); WAIT_L(0); BAR; MMA(1, 0, At, B0); MMA(1, 1, At, B1); BAR; SCHED;
        }
        if (wr == 0) BAR;
        asm volatile("" ::: "memory");
        epi(acc, pm, pn, pm * BM, pn * BM, wr, wc, fr, fq);
        if (!has_next) { asm volatile("s_waitcnt vmcnt(0)" ::: "memory"); break; }
        ZACC();
        it = itn; pm = pmn; pn = pnn; cA = nA; cB = nB;
        if (FIX) { voffF[0] = voffFn[0]; voffF[1] = voffFn[1]; }
        if (wr == 1) BAR;
    }
    BAR;
#undef SA
#undef SB
#undef STAGE
#undef LDA
#undef LDB
#undef MMA
#undef ZACC
}

struct NoRowFn { DEV void operator()(int, float) const {} };
template <int RB, int NBLK, int U, class Epi, class RowFn = NoRowFn>
DEV void skinny_tile(const bf16_t* __restrict__ A, const int lda, const bf16_t* __restrict__ B0, const bf16_t* __restrict__ B1, const int K, Epi&& epi, RowFn&& rowfn = NoRowFn(), const int ldb_ = 0) {
    const int ldb = ldb_ ? ldb_ : K;
    float* red = (float*)shm_raw;
    const int tid = TIDX(), w = tid >> 6, lane = tid & 63, fr = lane & 15, fq = lane >> 4;
    constexpr int KG = (NBLK == 2) ? 4 : 8;
    const int kg = (NBLK == 2) ? (w & 3) : w, nb = (NBLK == 2) ? (w >> 2) : 0;
    const bf16_t* Bp = (nb ? B1 : B0) + (long)fr * ldb + fq * 8;
    const bf16_t* Ap = A + (long)fr * lda + fq * 8;
    const int kper = K / KG, kbeg = kg * kper, kend = kbeg + kper;
    f32x4 acc[RB];
#pragma unroll
    for (int rb = 0; rb < RB; ++rb) acc[rb] = (f32x4){0.f, 0.f, 0.f, 0.f};
    int k = kbeg;
    for (; k + 32 * U <= kend; k += 32 * U) {
        bf16x8 b[U], a[U][RB];
#pragma unroll
        for (int u = 0; u < U; ++u) {
            b[u] = *(const bf16x8*)(Bp + k + 32 * u);
#pragma unroll
            for (int rb = 0; rb < RB; ++rb) a[u][rb] = *(const bf16x8*)(Ap + (long)rb * 16 * lda + k + 32 * u);
        }
#pragma unroll
        for (int u = 0; u < U; ++u)
#pragma unroll
            for (int rb = 0; rb < RB; ++rb) acc[rb] = __builtin_amdgcn_mfma_f32_16x16x32_bf16(b[u], a[u][rb], acc[rb], 0, 0, 0);
    }
    for (; k < kend; k += 32) {
        const bf16x8 b = *(const bf16x8*)(Bp + k);
        bf16x8 a[RB];
#pragma unroll
        for (int rb = 0; rb < RB; ++rb) a[rb] = *(const bf16x8*)(Ap + (long)rb * 16 * lda + k);
#pragma unroll
        for (int rb = 0; rb < RB; ++rb) acc[rb] = __builtin_amdgcn_mfma_f32_16x16x32_bf16(b, a[rb], acc[rb], 0, 0, 0);
    }
    f32x4* r4 = (f32x4*)red;
#pragma unroll
    for (int rb = 0; rb < RB; ++rb) r4[(w * RB + rb) * 64 + lane] = acc[rb];
    __syncthreads();
    for (int e = tid; e < RB * 256; e += 512) {
        const int row = e >> 4, s = e & 15, rb = row >> 4, l2 = (row & 15) + 16 * (s >> 2), r = s & 3;
        float v0 = 0.f, v1 = 0.f;
        if (NBLK == 2) {
#pragma unroll
            for (int g = 0; g < 4; ++g) { v0 += red[((g * RB + rb) * 64 + l2) * 4 + r]; v1 += red[(((4 + g) * RB + rb) * 64 + l2) * 4 + r]; }
        } else {
#pragma unroll
            for (int g = 0; g < 8; ++g) v0 += red[((g * RB + rb) * 64 + l2) * 4 + r];
        }
        float ss = epi(row, s, v0, v1);
        ss += __shfl_xor(ss, 1); ss += __shfl_xor(ss, 2); ss += __shfl_xor(ss, 4); ss += __shfl_xor(ss, 8);
        if (s == 0) rowfn(row, ss);
    }
    __syncthreads();
}

template <class RowMap>
DEV void transpose_tile(const float* __restrict__ src, const int N, const int K, const int k0, const int c0, bf16_t* __restrict__ dst, RowMap&& rowmap) {
    float* lds = (float*)shm_raw;
    const int tid = TIDX();
#pragma unroll
    for (int i = 0; i < 2; ++i) {
        const int idx = tid * 4 + i * 2048, kk = idx >> 6, cc = idx & 63;
        const f32x4 v = *(const f32x4*)(src + (size_t)(k0 + kk) * N + c0 + cc);
        lds[kk * 65 + cc] = v.x; lds[kk * 65 + cc + 1] = v.y; lds[kk * 65 + cc + 2] = v.z; lds[kk * 65 + cc + 3] = v.w;
    }
    __syncthreads();
    {
        const int c = tid >> 3, ks = (tid & 7) * 8;
        float f[8];
#pragma unroll
        for (int e = 0; e < 8; ++e) f[e] = lds[(ks + e) * 65 + c];
        *(u32x4*)(dst + (size_t)rowmap(c0 + c) * K + k0 + ks) = pack8(f);
    }
    __syncthreads();
}

DEV void phase_prep(const Params& p) {
    unsigned char* ws = p.ws;
    bf16_t* BtIn = (bf16_t*)(ws + W_BTIN); bf16_t* BtOut = (bf16_t*)(ws + W_BTOUT); bf16_t* BtUp = (bf16_t*)(ws + W_BTUP);
    bf16_t* BtDown = (bf16_t*)(ws + W_BTDOWN); bf16_t* BtAda = (bf16_t*)(ws + W_KVT); bf16_t* WrT = (bf16_t*)(ws + W_WRT);
    constexpr int T_IN = 16 * 48, T_OUT = 16 * 16, T_UP = 16 * 44, T_DOWN = 44 * 16, T_ADA = 16 * 96, T_G = 16;
    constexpr int T_ALL = T_IN + T_OUT + 2 * T_UP + T_DOWN + T_ADA + T_G;
    for (int it = BIDX(); it < T_ALL; it += gridDim.x) {
        int r = it;
        if (r < T_ADA) { transpose_tile(p.w_ada, 6144, 1024, (r / 96) * 64, (r % 96) * 64, BtAda, [](int c) { return permpos(c); }); continue; } r -= T_ADA;
        if (r < T_IN) { transpose_tile(p.w_in, DP, 1024, (r / 48) * 64, (r % 48) * 64, BtIn, [](int c) { return permpos(c); }); continue; } r -= T_IN;
        if (r < T_OUT) { transpose_tile(p.w_out, D, 1024, (r / 16) * 64, (r % 16) * 64, BtOut, [](int c) { return permpos(c); }); continue; } r -= T_OUT;
        if (r < T_UP) { transpose_tile(p.w_upc, DFF, 1024, (r / 44) * 64, (r % 44) * 64, BtUp, [](int c) { return 256 * (c >> 7) + permpos(c & 127); }); continue; } r -= T_UP;
        if (r < T_UP) { transpose_tile(p.w_upg, DFF, 1024, (r / 44) * 64, (r % 44) * 64, BtUp, [](int c) { return 256 * (c >> 7) + 128 + permpos(c & 127); }); continue; } r -= T_UP;
        if (r < T_DOWN) { transpose_tile(p.w_down, D, DFF, (r / 16) * 64, (r % 16) * 64, BtDown, [](int c) { return permpos(c); }); continue; } r -= T_DOWN;
        { const int g = r >> 3, jb = r & 7; transpose_tile((g ? p.w_i : p.w_r) + jb * 4096, 64, 64, 0, 0, WrT + (g * 8 + jb) * 4096, [](int c) { return c; }); }
    }
    const int gt = BIDX() * 512 + TIDX(), GT = gridDim.x * 512;
    bf16_t* modA = (bf16_t*)(ws + W_MODA);
    for (int i = gt; i < NMODROWS * D; i += GT) {
        const int row = i >> 10, k = i & 1023;
        float v = 0.f;
        if (row < 8) v = siluf_(p.c_p[row * D + k]); else if (row < 136) v = siluf_(p.c_s[(row - 8) * D + k]);
        modA[i] = f2bf(v);
    }
    float* rope = (float*)(ws + W_ROPE);
    for (int i = gt; i < (TSEQ + 1) * 64; i += GT) {
        const int t = i >> 6, j = i & 63;
        const float pos = (t < TSEQ) ? (float)t : (float)PAST_LEN;
        const float invf = exp2f(-(float)(2 * j) * (13.287712379549449f / 128.f));
        const float ang = pos * invf;
        float s, c; sincosf(ang, &s, &c);
        rope[t * 128 + j] = c; rope[t * 128 + 64 + j] = s;
    }
    float* rss1 = (float*)(ws + W_RSS1); float* rss2 = (float*)(ws + W_RSS2); float* spl = (float*)(ws + W_SPL);
    for (int i = gt; i < NROWS; i += GT) { rss1[i] = 0.f; rss2[i] = 0.f; }
    for (int i = gt; i < 512; i += GT) spl[i] = 8.f * log1pf(__expf(-p.lam[i]));
}

DEV void phase_mod(const Params& p) {
    unsigned char* ws = p.ws;
    const bf16_t* modA = (const bf16_t*)(ws + W_MODA); const bf16_t* BtAda = (const bf16_t*)(ws + W_KVT); float* mod = (float*)(ws + W_MOD);
    for (int it = BIDX(); it < 256; it += gridDim.x) {
        if (it < 128) {
            const int g = it >> 1, n = it & 1;
            const bf16_t* B0 = BtAda + (size_t)(32 * g + 16 * n) * D;
            skinny_tile<9, 1, 4>(modA, D, B0, B0, D, [&](int row, int s, float v0, float v1) {
                if (row < 136) { const int c0 = 32 * g + slotcol(n, s); mod[(size_t)row * 6144 + c0] = v0 + p.b_ada[c0]; }
                return 0.f;
            });
        } else {
            const int g = 64 + (it - 128);
            const bf16_t* B0 = BtAda + (size_t)(32 * g) * D;
            skinny_tile<9, 2, 4>(modA, D, B0, B0 + 16 * D, D, [&](int row, int s, float v0, float v1) {
                if (row < 136) { const int c0 = 32 * g + slotcol(0, s), c1 = c0 + 4; mod[(size_t)row * 6144 + c0] = v0 + p.b_ada[c0]; mod[(size_t)row * 6144 + c1] = v1 + p.b_ada[c1]; }
                return 0.f;
            });
        }
    }
}

DEV void phase_norm1(const Params& p) {
    unsigned char* ws = p.ws;
    const float* mod = (const float*)(ws + W_MOD); bf16_t* H = (bf16_t*)(ws + W_H); bf16_t* shf = (bf16_t*)(ws + W_SHF);
    const int lane = TIDX() & 63, gw = BIDX() * 8 + (TIDX() >> 6), NGW = gridDim.x * 8;
    for (int row = gw; row < NROWS; row += NGW) {
        const float* xr = (row < NTOK) ? p.x_p + (size_t)row * D : p.x_s + (size_t)(row - NTOK) * D;
        const int b = (row < NTOK) ? (row >> 11) : 8 + (row - NTOK);
        const float* mrow = mod + (size_t)b * 6144;
        f32x4 v[4]; float ss = 0.f;
#pragma unroll
        for (int j = 0; j < 4; ++j) { v[j] = *(const f32x4*)(xr + 4 * lane + 256 * j); ss += v[j].x * v[j].x + v[j].y * v[j].y + v[j].z * v[j].z + v[j].w * v[j].w; }
        const float rstd = __builtin_amdgcn_rsqf(wave_sum(ss) * (1.f / D) + EPS);
#pragma unroll
        for (int j = 0; j < 4; ++j) {
            const int k = 4 * lane + 256 * j;
            const f32x4 g = *(const f32x4*)(p.g_mix + k), sh = *(const f32x4*)(mrow + k), sc = *(const f32x4*)(mrow + D + k);
            const f32x4 h = v[j] * rstd * g * (1.f + sc) + sh;
            u32x2 o; o.x = cvt_pk_bf16(h.x, h.y); o.y = cvt_pk_bf16(h.z, h.w);
            *(u32x2*)(H + (size_t)row * D + k) = o;
        }
    }
}

DEV void phase_inproj(const Params& p) {
    unsigned char* ws = p.ws;
    const bf16_t* H = (const bf16_t*)(ws + W_H); const bf16_t* BtIn = (const bf16_t*)(ws + W_BTIN); bf16_t* proj = (bf16_t*)(ws + W_PROJ);
    float* projS = (float*)(ws + W_PROJS);
    constexpr int NBIG = 64 * 12, NSK1 = 96;
    gemm_phase<false>(H, BtIn, D, 64, 12, NBIG, nullptr, [&](const f32x4 (&acc)[2][2][4][2], int pm, int pn, int brow, int bcol, int wr, int wc, int fr, int fq) {
#pragma unroll
        for (int ai = 0; ai < 2; ++ai)
#pragma unroll
            for (int m = 0; m < 4; ++m) {
                bf16_t* rp = proj + (size_t)(brow + ai * HALF + wr * 64 + m * 16 + fr) * DP + bcol + wc * 32 + 8 * fq;
#pragma unroll
                for (int bj = 0; bj < 2; ++bj) {
                    const f32x4 a = acc[ai][bj][m][0], b = acc[ai][bj][m][1];
                    u32x4 w; w.x = cvt_pk_bf16(a[0], a[1]); w.y = cvt_pk_bf16(a[2], a[3]); w.z = cvt_pk_bf16(b[0], b[1]); w.w = cvt_pk_bf16(b[2], b[3]);
                    *(u32x4*)(rp + bj * HALF) = w;
                }
            }
    });
    const bf16_t* modA = (const bf16_t*)(ws + W_MODA); const bf16_t* BtAda = (const bf16_t*)(ws + W_KVT); float* mod = (float*)(ws + W_MOD);
    SKINNY_LOOP(j, NBIG, 2 * NSK1) {
        const int g = j >> 1, n = j & 1;
        const bf16_t* B0 = BtIn + (size_t)(32 * g + 16 * n) * D;
        skinny_tile<8, 1, 4>(H + (size_t)NTOK * D, D, B0, B0, D, [&](int row, int s, float v0, float v1) {
            projS[row * DP + 32 * g + slotcol(n, s)] = v0; return 0.f;
        });
    }
}

constexpr int RP = 136;
DEV void rot8(const float* x1, const float* x2, const float* tr, int d0, float scale, float* o1, float* o2) {
    const f32x4 c0 = *(const f32x4*)(tr + d0), c1 = *(const f32x4*)(tr + d0 + 4), s0 = *(const f32x4*)(tr + 64 + d0), s1 = *(const f32x4*)(tr + 64 + d0 + 4);
    const float c[8] = {c0.x, c0.y, c0.z, c0.w, c1.x, c1.y, c1.z, c1.w}, s[8] = {s0.x, s0.y, s0.z, s0.w, s1.x, s1.y, s1.z, s1.w};
#pragma unroll
    for (int e = 0; e < 8; ++e) { o1[e] = (x1[e] * c[e] - x2[e] * s[e]) * scale; o2[e] = (x1[e] * s[e] + x2[e] * c[e]) * scale; }
}

DEV void rot8v(const u32x4 a, const u32x4 b, const f32x4 c0, const f32x4 c1, const f32x4 s0, const f32x4 s1, float scale, float* o1, float* o2) {
    float x1[8], x2[8]; unpack8(a, x1); unpack8(b, x2);
    const float c[8] = {c0.x, c0.y, c0.z, c0.w, c1.x, c1.y, c1.z, c1.w}, s[8] = {s0.x, s0.y, s0.z, s0.w, s1.x, s1.y, s1.z, s1.w};
#pragma unroll
    for (int e = 0; e < 8; ++e) { o1[e] = (x1[e] * c[e] - x2[e] * s[e]) * scale; o2[e] = (x1[e] * s[e] + x2[e] * c[e]) * scale; }
}
DEV void scatter_vT(const u32x4 w, int j, int d0, bf16_t* vT) {
    const unsigned ww[4] = {w.x, w.y, w.z, w.w};
#pragma unroll
    for (int e = 0; e < 4; ++e) { vT[(d0 + 2 * e) * RP + j] = (bf16_t)(ww[e] & 0xffffu); vT[(d0 + 2 * e + 1) * RP + j] = (bf16_t)(ww[e] >> 16); }
}
DEV void stage_vT(const bf16_t* proj, int row0, int h, bf16_t* vT) {
    for (int item = TIDX(); item < 2048; item += 512) {
        const int j = item >> 4, d0 = (item & 15) * 8;
        const u32x4 w = *(const u32x4*)(proj + (size_t)(row0 + j) * DP + 1024 + h * 128 + d0);
        const unsigned ww[4] = {w.x, w.y, w.z, w.w};
#pragma unroll
        for (int e = 0; e < 4; ++e) { vT[(d0 + 2 * e) * RP + j] = (bf16_t)(ww[e] & 0xffffu); vT[(d0 + 2 * e + 1) * RP + j] = (bf16_t)(ww[e] >> 16); }
    }
}

DEV void ret_passA(const Params& p, int unit) {
    unsigned char* ws = p.ws;
    const bf16_t* proj = (const bf16_t*)(ws + W_PROJ); const float* rope = (const float*)(ws + W_ROPE); float* KVT = (float*)(ws + W_KVT) + (size_t)unit * 16384;
    const int n = unit & 15, h = (unit >> 4) & 3, b = unit >> 6, row0 = b * TSEQ + n * 128;
    bf16_t* kT = (bf16_t*)shm_raw; bf16_t* vT = kT + 128 * RP;
    const float lg = gamma_log2(h);
    {
        const int tid = TIDX();
        u32x4 kA[2], kB[2], vv[4]; f32x4 rc[2][4];
#pragma unroll
        for (int i = 0; i < 2; ++i) {
            const int item = tid + 512 * i, j = item >> 3, d0 = (item & 7) * 8;
            const bf16_t* kr = proj + (size_t)(row0 + j) * DP + 512 + h * 128; const float* tr = rope + (size_t)(n * 128 + j) * 128;
            kA[i] = *(const u32x4*)(kr + d0); kB[i] = *(const u32x4*)(kr + 64 + d0);
            rc[i][0] = *(const f32x4*)(tr + d0); rc[i][1] = *(const f32x4*)(tr + d0 + 4); rc[i][2] = *(const f32x4*)(tr + 64 + d0); rc[i][3] = *(const f32x4*)(tr + 64 + d0 + 4);
        }
#pragma unroll
        for (int i = 0; i < 4; ++i) { const int item = tid + 512 * i, j = item >> 4, d0 = (item & 15) * 8; vv[i] = *(const u32x4*)(proj + (size_t)(row0 + j) * DP + 1024 + h * 128 + d0); }
#pragma unroll
        for (int i = 0; i < 2; ++i) {
            const int item = tid + 512 * i, j = item >> 3, d0 = (item & 7) * 8;
            float o1[8], o2[8];
            rot8v(kA[i], kB[i], rc[i][0], rc[i][1], rc[i][2], rc[i][3], 0.08838834764831845f * fexp2(lg * (float)(127 - j)), o1, o2);
#pragma unroll
            for (int e = 0; e < 8; ++e) { kT[(d0 + e) * RP + j] = f2bf(o1[e]); kT[(64 + d0 + e) * RP + j] = f2bf(o2[e]); }
        }
#pragma unroll
        for (int i = 0; i < 4; ++i) { const int item = tid + 512 * i; scatter_vT(vv[i], item >> 4, (item & 15) * 8, vT); }
    }
    __syncthreads();
    const int w = TIDX() >> 6, lane = TIDX() & 63, fr = lane & 15, fq = lane >> 4;
    f32x4 acc[8];
#pragma unroll
    for (int vb = 0; vb < 8; ++vb) acc[vb] = (f32x4){0.f, 0.f, 0.f, 0.f};
#pragma unroll
    for (int ks = 0; ks < 4; ++ks) {
        const bf16x8 a = *(const bf16x8*)(kT + (16 * w + fr) * RP + 32 * ks + 8 * fq);
#pragma unroll
        for (int vb = 0; vb < 8; ++vb) {
            const bf16x8 bb = *(const bf16x8*)(vT + (16 * vb + fr) * RP + 32 * ks + 8 * fq);
            acc[vb] = __builtin_amdgcn_mfma_f32_16x16x32_bf16(a, bb, acc[vb], 0, 0, 0);
        }
    }
#pragma unroll
    for (int vb = 0; vb < 8; ++vb) *(f32x4*)(KVT + (16 * vb + fr) * 128 + 16 * w + 4 * fq) = acc[vb];
    __syncthreads();
}

DEV void ret_passC(const Params& p, int unit) {
    unsigned char* ws = p.ws;
    const bf16_t* proj = (const bf16_t*)(ws + W_PROJ); const float* rope = (const float*)(ws + W_ROPE); bf16_t* mix = (bf16_t*)(ws + W_MIX);
    const int n = unit & 15, h = (unit >> 4) & 3, b = unit >> 6, row0 = b * TSEQ + n * 128;
    bf16_t* ks_ = (bf16_t*)shm_raw; bf16_t* vT = ks_ + 128 * RP; bf16_t* ST = vT + 128 * RP; bf16_t* P = ST + 128 * RP;
    const float lg = gamma_log2(h);
    const int tid = TIDX(), w = tid >> 6, lane = tid & 63, fr = lane & 15, fq = lane >> 4;
    const int i_loc = 16 * w + fr;
    bf16x8 qf[4];
    {
        u32x4 kA[2], kB[2], vv[4], st[4], qA[2], qB[2]; f32x4 rc[2][4], qc[2][4];
#pragma unroll
        for (int i = 0; i < 2; ++i) {
            const int item = tid + 512 * i, j = item >> 3, d0 = (item & 7) * 8;
            const bf16_t* kr = proj + (size_t)(row0 + j) * DP + 512 + h * 128; const float* tr = rope + (size_t)(n * 128 + j) * 128;
            kA[i] = *(const u32x4*)(kr + d0); kB[i] = *(const u32x4*)(kr + 64 + d0);
            rc[i][0] = *(const f32x4*)(tr + d0); rc[i][1] = *(const f32x4*)(tr + d0 + 4); rc[i][2] = *(const f32x4*)(tr + 64 + d0); rc[i][3] = *(const f32x4*)(tr + 64 + d0 + 4);
        }
#pragma unroll
        for (int i = 0; i < 4; ++i) { const int item = tid + 512 * i, j = item >> 4, d0 = (item & 15) * 8; vv[i] = *(const u32x4*)(proj + (size_t)(row0 + j) * DP + 1024 + h * 128 + d0); }
        {
            const int dv = tid >> 2, sg = tid & 3;
            const bf16_t* src = (const bf16_t*)(ws + W_H) + (size_t)unit * 16384 + dv * 128 + sg * 32;
#pragma unroll
            for (int i = 0; i < 4; ++i) st[i] = *(const u32x4*)(src + 8 * i);
        }
        {
            const bf16_t* qr = proj + (size_t)(row0 + i_loc) * DP + h * 128; const float* tr = rope + (size_t)(n * 128 + i_loc) * 128;
#pragma unroll
            for (int kk = 0; kk < 2; ++kk) {
                const int d0 = 32 * kk + 8 * fq;
                qA[kk] = *(const u32x4*)(qr + d0); qB[kk] = *(const u32x4*)(qr + 64 + d0);
                qc[kk][0] = *(const f32x4*)(tr + d0); qc[kk][1] = *(const f32x4*)(tr + d0 + 4); qc[kk][2] = *(const f32x4*)(tr + 64 + d0); qc[kk][3] = *(const f32x4*)(tr + 64 + d0 + 4);
            }
        }
#pragma unroll
        for (int i = 0; i < 2; ++i) {
            const int item = tid + 512 * i, j = item >> 3, d0 = (item & 7) * 8;
            float o1[8], o2[8];
            rot8v(kA[i], kB[i], rc[i][0], rc[i][1], rc[i][2], rc[i][3], 0.08838834764831845f, o1, o2);
            *(u32x4*)(ks_ + j * RP + d0) = pack8(o1); *(u32x4*)(ks_ + j * RP + 64 + d0) = pack8(o2);
        }
#pragma unroll
        for (int i = 0; i < 4; ++i) { const int item = tid + 512 * i; scatter_vT(vv[i], item >> 4, (item & 15) * 8, vT); }
        {
            const int dv = tid >> 2, sg = tid & 3;
#pragma unroll
            for (int i = 0; i < 4; ++i) *(u32x4*)(ST + dv * RP + sg * 32 + 8 * i) = st[i];
        }
#pragma unroll
        for (int kk = 0; kk < 2; ++kk) {
            float o1[8], o2[8];
            rot8v(qA[kk], qB[kk], qc[kk][0], qc[kk][1], qc[kk][2], qc[kk][3], 1.f, o1, o2);
            const u32x4 a = pack8(o1), c = pack8(o2);
            qf[kk] = __builtin_bit_cast(bf16x8, a); qf[kk + 2] = __builtin_bit_cast(bf16x8, c);
        }
    }
    __syncthreads();
#pragma unroll
    for (int jb = 0; jb < 8; ++jb) {
        u32x2 o; o.x = 0u; o.y = 0u;
        if (jb <= w) {
            f32x4 sc = (f32x4){0.f, 0.f, 0.f, 0.f};
#pragma unroll
            for (int kk = 0; kk < 4; ++kk) {
                const bf16x8 a = *(const bf16x8*)(ks_ + (16 * jb + fr) * RP + 32 * kk + 8 * fq);
                sc = __builtin_amdgcn_mfma_f32_16x16x32_bf16(a, qf[kk], sc, 0, 0, 0);
            }
            float pv[4];
#pragma unroll
            for (int r = 0; r < 4; ++r) { const int dj = i_loc - (16 * jb + 4 * fq + r); pv[r] = dj >= 0 ? sc[r] * fexp2(lg * (float)dj) : 0.f; }
            o.x = cvt_pk_bf16(pv[0], pv[1]); o.y = cvt_pk_bf16(pv[2], pv[3]);
        }
        *(u32x2*)(P + i_loc * RP + 16 * jb + 4 * fq) = o;
    }
    __syncthreads();
    f32x4 a1[8], a2[8];
#pragma unroll
    for (int vb = 0; vb < 8; ++vb) { a1[vb] = (f32x4){0.f, 0.f, 0.f, 0.f}; a2[vb] = (f32x4){0.f, 0.f, 0.f, 0.f}; }
    for (int kk = 0; kk <= (w >> 1); ++kk) {
        const bf16x8 pb = *(const bf16x8*)(P + i_loc * RP + 32 * kk + 8 * fq);
#pragma unroll
        for (int vb = 0; vb < 8; ++vb) {
            const bf16x8 a = *(const bf16x8*)(vT + (16 * vb + fr) * RP + 32 * kk + 8 * fq);
            a1[vb] = __builtin_amdgcn_mfma_f32_16x16x32_bf16(a, pb, a1[vb], 0, 0, 0);
        }
    }
#pragma unroll
    for (int kk = 0; kk < 4; ++kk) {
#pragma unroll
        for (int vb = 0; vb < 8; ++vb) {
            const bf16x8 a = *(const bf16x8*)(ST + (16 * vb + fr) * RP + 32 * kk + 8 * fq);
            a2[vb] = __builtin_amdgcn_mfma_f32_16x16x32_bf16(a, qf[kk], a2[vb], 0, 0, 0);
        }
    }
    const float qd = fexp2(lg * (float)(i_loc + 1));
    float sum = 0.f;
#pragma unroll
    for (int vb = 0; vb < 8; ++vb) { a1[vb] = a1[vb] + qd * a2[vb]; sum += (a1[vb].x + a1[vb].y) + (a1[vb].z + a1[vb].w); }
    sum += __shfl_xor(sum, 16); sum += __shfl_xor(sum, 32);
    const float mu = sum * (1.f / 128.f);
    float var = 0.f;
#pragma unroll
    for (int vb = 0; vb < 8; ++vb) { const f32x4 d = a1[vb] - mu; var += (d.x * d.x + d.y * d.y) + (d.z * d.z + d.w * d.w); }
    var += __shfl_xor(var, 16); var += __shfl_xor(var, 32);
    const float rstd = __builtin_amdgcn_rsqf(var * (1.f / 128.f) + EPS);
    const bf16_t* gr = proj + (size_t)(row0 + i_loc) * DP + 1536 + h * 128 + 4 * fq;
    bf16_t* orow = mix + (size_t)(row0 + i_loc) * D + h * 128 + 4 * fq;
    u32x2 gg[8];
#pragma unroll
    for (int vb = 0; vb < 8; ++vb) gg[vb] = *(const u32x2*)(gr + 16 * vb);
#pragma unroll
    for (int vb = 0; vb < 8; ++vb) {
        const u32x2 g = gg[vb];
        const f32x4 d = (a1[vb] - mu) * rstd;
        u32x2 o; o.x = cvt_pk_bf16(d.x * siluf_(bflo(g.x)), d.y * siluf_(bfhi(g.x))); o.y = cvt_pk_bf16(d.z * siluf_(bflo(g.y)), d.w * siluf_(bfhi(g.y)));
        *(u32x2*)(orow + 16 * vb) = o;
    }
    __syncthreads();
}

#define LBAR() do { asm volatile("s_waitcnt lgkmcnt(0)" ::: "memory"); __builtin_amdgcn_s_barrier(); asm volatile("" ::: "memory"); } while (0)
template <bool FINAL>
DEV void lru_phase(const Params& p) {
    unsigned char* ws = p.ws;
    const bf16_t* proj = (const bf16_t*)(ws + W_PROJ); bf16_t* mix = (bf16_t*)(ws + W_MIX); const bf16_t* WrT = (const bf16_t*)(ws + W_WRT);
    const float* spl = (const float*)(ws + W_SPL); float* agg = (float*)(ws + W_AGG); const float* hin0g = (const float*)(ws + W_HIN0);
    float* xcf = (float*)shm_raw;
    constexpr int XP = 68;
    float* af = xcf + 128 * XP;
    bf16_t* xcb = (bf16_t*)(af + 128 * XP);
    float* segA = (float*)(xcb + 128 * 72);
    float* segB = segA + 512;
    float* hin = segB + 512;
    bf16_t* wT = (bf16_t*)(hin + 512);
    float* cwL = (float*)(wT + 2 * 64 * 72);
    bf16_t* gbuf = (bf16_t*)(cwL + 8 * 64);
    const int tid = TIDX(), w = tid >> 6, lane = tid & 63, fr = lane & 15, fq = lane >> 4;
    const int tt = tid >> 2, e0 = (tid & 3) * 16;
    int key = -1;
    u32x4 xr[4][2]; u32x4 gr[2]; float h0 = 0.f;
    auto prefetch = [&](int unit) {
        const int c = unit & 15, jb = (unit >> 4) & 7, b = unit >> 7, ch0 = 64 * jb;
#pragma unroll
        for (int k = 0; k < 4; ++k) {
            const int tabs = c * 128 + tt - 3 + k;
            xr[k][0] = (u32x4){0u, 0u, 0u, 0u}; xr[k][1] = xr[k][0];
            if (tabs >= 0) { const bf16_t* xp = proj + (size_t)(b * TSEQ + tabs) * DP + 2048 + ch0 + e0; xr[k][0] = *(const u32x4*)xp; xr[k][1] = *(const u32x4*)(xp + 8); }
        }
        if (FINAL) {
            const bf16_t* gp = proj + (size_t)(b * TSEQ + c * 128 + tt) * DP + 2560 + ch0 + e0; gr[0] = *(const u32x4*)gp; gr[1] = *(const u32x4*)(gp + 8);
            if (tid < 64) h0 = hin0g[(size_t)unit * 64 + tid];
        }
    };
    int it = BIDX();
    if (it < 1024) prefetch(it);
    for (; it < 1024; it += gridDim.x) {
        const int unit = it, c = unit & 15, jb = (unit >> 4) & 7, b = unit >> 7, row0 = b * TSEQ + c * 128, ch0 = 64 * jb;
        if ((unit & 127) != key) {
            key = unit & 127;
            { const int g = tid >> 8, e = (tid >> 2) & 63, sg = tid & 3; const bf16_t* src = WrT + (size_t)((g * 8 + jb) * 64 + e) * 64 + sg * 16;
              *(u32x4*)(wT + (g * 64 + e) * 72 + sg * 16) = *(const u32x4*)src; *(u32x4*)(wT + (g * 64 + e) * 72 + sg * 16 + 8) = *(const u32x4*)(src + 8); }
            { const int q = tid >> 6, e = tid & 63; float v;
              if (q < 4) v = p.cl_w[q * DLRU + ch0 + e]; else if (q == 4) v = p.cl_b[ch0 + e]; else if (q == 5) v = p.b_r[ch0 + e]; else if (q == 6) v = p.b_i[ch0 + e]; else v = spl[ch0 + e];
              cwL[q * 64 + e] = v; }
            LBAR();
        }
        {
            float accv[16];
#pragma unroll
            for (int i = 0; i < 4; ++i) { const f32x4 cb = *(const f32x4*)(cwL + 4 * 64 + e0 + 4 * i); accv[4 * i] = cb.x; accv[4 * i + 1] = cb.y; accv[4 * i + 2] = cb.z; accv[4 * i + 3] = cb.w; }
#pragma unroll
            for (int k = 0; k < 4; ++k) {
                float xv[16]; unpack8(xr[k][0], xv); unpack8(xr[k][1], xv + 8);
#pragma unroll
                for (int i = 0; i < 4; ++i) { const f32x4 cw = *(const f32x4*)(cwL + k * 64 + e0 + 4 * i);
                    accv[4 * i] += cw.x * xv[4 * i]; accv[4 * i + 1] += cw.y * xv[4 * i + 1]; accv[4 * i + 2] += cw.z * xv[4 * i + 2]; accv[4 * i + 3] += cw.w * xv[4 * i + 3]; }
            }
#pragma unroll
            for (int i = 0; i < 4; ++i) *(f32x4*)(xcf + tt * XP + e0 + 4 * i) = (f32x4){accv[4 * i], accv[4 * i + 1], accv[4 * i + 2], accv[4 * i + 3]};
            *(u32x4*)(xcb + tt * 72 + e0) = pack8(accv); *(u32x4*)(xcb + tt * 72 + e0 + 8) = pack8(accv + 8);
            if (FINAL) { *(u32x4*)(gbuf + tt * 64 + e0) = gr[0]; *(u32x4*)(gbuf + tt * 64 + e0 + 8) = gr[1]; }
        }
        const float h0u = h0;
        if (it + (int)gridDim.x < 1024) prefetch(it + gridDim.x);
        LBAR();
        {
            const int t = 16 * w + fr;
            bf16x8 xb[2];
#pragma unroll
            for (int kk = 0; kk < 2; ++kk) xb[kk] = *(const bf16x8*)(xcb + t * 72 + 32 * kk + 8 * fq);
            const bool first = (c == 0 && t == 0);
#pragma unroll
            for (int eb = 0; eb < 4; ++eb) {
                f32x4 ar = (f32x4){0.f, 0.f, 0.f, 0.f}, ai = (f32x4){0.f, 0.f, 0.f, 0.f};
#pragma unroll
                for (int kk = 0; kk < 2; ++kk) {
                    const bf16x8 wr_ = *(const bf16x8*)(wT + (16 * eb + fr) * 72 + 32 * kk + 8 * fq);
                    const bf16x8 wi_ = *(const bf16x8*)(wT + (64 + 16 * eb + fr) * 72 + 32 * kk + 8 * fq);
                    ar = __builtin_amdgcn_mfma_f32_16x16x32_bf16(wr_, xb[kk], ar, 0, 0, 0);
                    ai = __builtin_amdgcn_mfma_f32_16x16x32_bf16(wi_, xb[kk], ai, 0, 0, 0);
                }
                const int e = 16 * eb + 4 * fq;
                const f32x4 br = *(const f32x4*)(cwL + 5 * 64 + e), bi = *(const f32x4*)(cwL + 6 * 64 + e), sp = *(const f32x4*)(cwL + 7 * 64 + e);
                const f32x4 xc4 = *(const f32x4*)(xcf + t * XP + e);
                f32x4 av, bv;
#pragma unroll
                for (int r = 0; r < 4; ++r) {
                    const float rr = sigmoidf_(ar[r] + br[r]), ii = sigmoidf_(ai[r] + bi[r]);
                    const float la = -sp[r] * rr, a = fexp2(1.4426950408889634f * la), x2 = 2.f * la;
                    const float em = -x2 * (1.f + 0.5f * x2 * (1.f + (1.f / 3.f) * x2 * (1.f + 0.25f * x2 * (1.f + 0.2f * x2 * (1.f + (1.f / 6.f) * x2)))));
                    const float mult = first ? 1.f : __builtin_amdgcn_sqrtf(em);
                    av[r] = a; bv[r] = mult * ii * xc4[r];
                }
                *(f32x4*)(af + t * XP + e) = av; *(f32x4*)(xcf + t * XP + e) = bv;
            }
        }
        LBAR();
        const int e = tid & 63, seg = tid >> 6;
        {
            float A = 1.f, B = 0.f;
#pragma unroll
            for (int i = 0; i < 16; ++i) { const int t = seg * 16 + i; const float a = af[t * XP + e]; B = a * B + xcf[t * XP + e]; A *= a; }
            segA[seg * 64 + e] = A; segB[seg * 64 + e] = B;
        }
        LBAR();
        if (!FINAL) {
            if (tid < 64) {
                float A = 1.f, B = 0.f;
#pragma unroll
                for (int s = 0; s < 8; ++s) { const float a = segA[s * 64 + tid]; B = a * B + segB[s * 64 + tid]; A *= a; }
                agg[(size_t)unit * 128 + tid] = A; agg[(size_t)unit * 128 + 64 + tid] = B;
            }
        } else {
            if (tid < 64) {
                float hh = h0u;
#pragma unroll
                for (int s = 0; s < 8; ++s) { hin[s * 64 + tid] = hh; hh = segA[s * 64 + tid] * hh + segB[s * 64 + tid]; }
            }
            LBAR();
            float hh = hin[seg * 64 + e];
#pragma unroll
            for (int i = 0; i < 16; ++i) {
                const int t = seg * 16 + i;
                hh = af[t * XP + e] * hh + xcf[t * XP + e];
                gbuf[t * 64 + e] = f2bf(hh * geluf_(bf2f(gbuf[t * 64 + e])));
            }
            if (c == 15 && seg == 7) {
                p.out[O_LHP + b * 512 + ch0 + e] = hh;
#pragma unroll
                for (int k = 0; k < 3; ++k) p.out[O_LCP + (size_t)(b * 3 + k) * 512 + ch0 + e] = bf2f(proj[(size_t)(b * TSEQ + 2045 + k) * DP + 2048 + ch0 + e]);
            }
            LBAR();
            { bf16_t* op = mix + (size_t)(row0 + tt) * D + 512 + ch0 + e0; *(u32x4*)op = *(const u32x4*)(gbuf + tt * 64 + e0); *(u32x4*)(op + 8) = *(const u32x4*)(gbuf + tt * 64 + e0 + 8); }
        }
        LBAR();
    }
    __syncthreads();
}

DEV void phase_scan(const Params& p) {
    unsigned char* ws = p.ws;
    const float* KVT = (const float*)(ws + W_KVT); bf16_t* STg = (bf16_t*)(ws + W_H);
    const float* agg = (const float*)(ws + W_AGG); float* hin0g = (float*)(ws + W_HIN0);
    const int gt = BIDX() * 512 + TIDX(), GT = gridDim.x * 512;
    for (int gid = gt; gid < 32 * 4096; gid += GT) {
        const int bh = gid >> 12, idx = gid & 4095, dv = idx >> 5, dk0 = (idx & 31) * 4, h = bh & 3;
        const float cd = exp2f(gamma_log2(h) * 128.f);
        const float* src = KVT + (size_t)bh * 16 * 16384 + dv * 128 + dk0;
        f32x4 kv[16];
#pragma unroll
        for (int m = 0; m < 16; ++m) kv[m] = *(const f32x4*)(src + (size_t)m * 16384);
        f32x4 S = (f32x4){0.f, 0.f, 0.f, 0.f};
        bf16_t* dst = STg + (size_t)bh * 16 * 16384 + dv * 128 + dk0;
#pragma unroll
        for (int m = 0; m < 16; ++m) {
            u32x2 o; o.x = cvt_pk_bf16(S.x, S.y); o.y = cvt_pk_bf16(S.z, S.w);
            *(u32x2*)(dst + (size_t)m * 16384) = o;
            S = S * cd + kv[m];
        }
        float* rp = p.out + O_RETP + (size_t)bh * 16384 + dv;
        rp[(dk0 + 0) * 128] = S.x; rp[(dk0 + 1) * 128] = S.y; rp[(dk0 + 2) * 128] = S.z; rp[(dk0 + 3) * 128] = S.w;
    }
    for (int gid = gt; gid < 64 * 64; gid += GT) {
        const int bjb = gid >> 6, e = gid & 63;
        float A[16], B[16];
#pragma unroll
        for (int c = 0; c < 16; ++c) { A[c] = agg[(size_t)(bjb * 16 + c) * 128 + e]; B[c] = agg[(size_t)(bjb * 16 + c) * 128 + 64 + e]; }
        float hh = 0.f;
#pragma unroll
        for (int c = 0; c < 16; ++c) { hin0g[(size_t)(bjb * 16 + c) * 64 + e] = hh; hh = A[c] * hh + B[c]; }
    }
}

DEV void sample_ret2(const Params& p, int unit) {
    unsigned char* ws = p.ws;
    const float* projS = (const float*)(ws + W_PROJS); const float* rope = (const float*)(ws + W_ROPE) + (size_t)TSEQ * 128; bf16_t* mix = (bf16_t*)(ws + W_MIX);
    const int h = unit & 3, b = unit >> 2, tid = TIDX();
    float* qs = (float*)shm_raw; float* ks = qs + 128; float* vs = ks + 128; float* part = vs + 128;
    float* red = part + 16 * 128;
    const float* pr = projS + (size_t)b * DP;
    const float gam = 1.f - exp2f(-5.f - (float)h);
    if (tid < 64) {
        const float c = rope[tid], s = rope[64 + tid];
        const float q1 = pr[h * 128 + tid], q2 = pr[h * 128 + 64 + tid], k1 = pr[512 + h * 128 + tid], k2 = pr[512 + h * 128 + 64 + tid];
        const float qa = q1 * c - q2 * s, qb = q1 * s + q2 * c, ka = (k1 * c - k2 * s) * 0.08838834764831845f, kb = (k1 * s + k2 * c) * 0.08838834764831845f;
        qs[tid] = qa; qs[64 + tid] = qb; ks[tid] = ka; ks[64 + tid] = kb;
        const float qkp = wave_sum(qa * ka + qb * kb);
        if (tid == 0) red[4] = qkp;
    } else if (tid < 192) vs[tid - 64] = pr[1024 + h * 128 + tid - 64];
    __syncthreads();
    {
        const int dv4 = (tid & 31) * 4, dkg = tid >> 5;
        const f32x4 v4 = *(const f32x4*)(vs + dv4);
        const float* S0 = p.st_ret + (size_t)unit * 16384; float* S1 = p.out + O_RETS + (size_t)unit * 16384;
        f32x4 po = (f32x4){0.f, 0.f, 0.f, 0.f};
        f32x4 s0[8];
#pragma unroll
        for (int i = 0; i < 8; ++i) s0[i] = *(const f32x4*)(S0 + (dkg * 8 + i) * 128 + dv4);
#pragma unroll
        for (int i = 0; i < 8; ++i) {
            const int dk = dkg * 8 + i;
            *(f32x4*)(S1 + dk * 128 + dv4) = s0[i] * gam + ks[dk] * v4;
            po = po + qs[dk] * s0[i];
        }
        *(f32x4*)(part + dkg * 128 + dv4) = po;
    }
    __syncthreads();
    float o = 0.f;
    if (tid < 128) {
        const float qk = red[4];
#pragma unroll
        for (int g = 0; g < 16; ++g) o += part[g * 128 + tid];
        o = qk * vs[tid] + gam * o;
        const float s1 = wave_sum(o);
        if ((tid & 63) == 0) red[tid >> 6] = s1;
    }
    __syncthreads();
    float mu = 0.f, dlt = 0.f;
    if (tid < 128) {
        mu = (red[0] + red[1]) * (1.f / 128.f); dlt = o - mu;
        const float s2 = wave_sum(dlt * dlt);
        if ((tid & 63) == 0) red[2 + (tid >> 6)] = s2;
    }
    __syncthreads();
    if (tid < 128) {
        const float rstd = __builtin_amdgcn_rsqf((red[2] + red[3]) * (1.f / 128.f) + EPS);
        const float g = pr[1536 + h * 128 + tid];
        mix[(size_t)(NTOK + b) * D + h * 128 + tid] = f2bf(dlt * rstd * siluf_(g));
    }
    __syncthreads();
}

DEV void sample_lru(const Params& p, int b) {
    unsigned char* ws = p.ws;
    const float* projS = (const float*)(ws + W_PROJS); bf16_t* mix = (bf16_t*)(ws + W_MIX); const float* spl = (const float*)(ws + W_SPL);
    float* xcS = (float*)shm_raw;
    const int ch = TIDX();
    const float* pr = projS + (size_t)b * DP;
    const float s0 = p.st_cl[(size_t)(b * 3 + 0) * 512 + ch], s1 = p.st_cl[(size_t)(b * 3 + 1) * 512 + ch], s2 = p.st_cl[(size_t)(b * 3 + 2) * 512 + ch], x = pr[2048 + ch];
    const float xc = p.cl_b[ch] + p.cl_w[ch] * s0 + p.cl_w[512 + ch] * s1 + p.cl_w[1024 + ch] * s2 + p.cl_w[1536 + ch] * x;
    xcS[ch] = xc;
    __syncthreads();
    const int jb = ch >> 6, e = ch & 63;
    float pr_ = 0.f, pi_ = 0.f;
    const float* wr = p.w_r + (size_t)jb * 4096 + e; const float* wi = p.w_i + (size_t)jb * 4096 + e;
#pragma unroll 8
    for (int d = 0; d < 64; ++d) { const float xv = xcS[64 * jb + d]; pr_ += xv * wr[d * 64]; pi_ += xv * wi[d * 64]; }
    const float rr = sigmoidf_(pr_ + p.b_r[ch]), ii = sigmoidf_(pi_ + p.b_i[ch]);
    const float la = -spl[ch] * rr, a = __expf(la), mult = sqrtf(-expm1f(2.f * la));
    const float hh = a * p.st_h[(size_t)b * 512 + ch] + mult * ii * xc;
    p.out[O_LHS + (size_t)b * 512 + ch] = hh;
    p.out[O_LCS + (size_t)(b * 3 + 0) * 512 + ch] = s1; p.out[O_LCS + (size_t)(b * 3 + 1) * 512 + ch] = s2; p.out[O_LCS + (size_t)(b * 3 + 2) * 512 + ch] = x;
    mix[(size_t)(NTOK + b) * D + 512 + ch] = f2bf(hh * geluf_(pr[2560 + ch]));
    __syncthreads();
}

DEV void phase_mixA(const Params& p) {
    constexpr int N1 = 512, N3 = 512, N4 = 128;
    {
        const float* mod = (const float*)(p.ws + W_MOD); bf16_t* shf = (bf16_t*)(p.ws + W_SHF);
        const int gt = BIDX() * 512 + TIDX(), GT = gridDim.x * 512;
        for (int i = gt; i < NMODROWS * D; i += GT) { const int row = i >> 10, k = i & 1023; shf[i] = f2bf(row < 136 ? mod[(size_t)row * 6144 + 3 * D + k] : 0.f); }
    }
    lru_phase<false>(p);
    for (int it = BIDX(); it < N1 + N3 + N4; it += gridDim.x) {
        if (it < N1) ret_passA(p, it);
        else if (it < N1 + N3) sample_ret2(p, it - N1);
        else sample_lru(p, it - N1 - N3);
    }
}
DEV void phase_mixC(const Params& p) {
    constexpr int N1 = 512;
    lru_phase<true>(p);
    for (int it = BIDX(); it < N1; it += gridDim.x) {
        { const int u = it; const int n = u & 15; const int nn = (((u >> 4) ^ (u >> 8)) & 1) ? 15 - n : n; ret_passC(p, (u & ~15) | nn); }
    }
}

DEV void phase_outproj(const Params& p) {
    unsigned char* ws = p.ws;
    const bf16_t* mix = (const bf16_t*)(ws + W_MIX); const bf16_t* BtOut = (const bf16_t*)(ws + W_BTOUT); bf16_t* xs = (bf16_t*)(ws + W_H);
    const float* mod = (const float*)(ws + W_MOD); float* rss1 = (float*)(ws + W_RSS1);
    constexpr int NBIG = 64 * 4;
    gemm_phase<false>(mix, BtOut, D, 64, 4, NBIG, nullptr, [&](const f32x4 (&acc)[2][2][4][2], int pm, int pn, int brow, int bcol, int wr, int wc, int fr, int fq) {
                const int b = brow >> 11;
                const float* mrow = mod + (size_t)b * 6144;
                f32x4 gt[2][2], sf[2][2];
#pragma unroll
                for (int bj = 0; bj < 2; ++bj)
#pragma unroll
                    for (int n = 0; n < 2; ++n) {
                        const int col = bcol + bj * HALF + wc * 32 + 8 * fq + 4 * n;
                        gt[bj][n] = *(const f32x4*)(mrow + 2 * D + col);
                        sf[bj][n] = *(const f32x4*)(p.g_ffn + col) * (1.f + *(const f32x4*)(mrow + 4 * D + col));
                    }
#pragma unroll
                for (int ai = 0; ai < 2; ++ai)
#pragma unroll
                    for (int m = 0; m < 4; ++m) {
                        const int row = brow + ai * HALF + wr * 64 + m * 16 + fr;
                        float ss = 0.f;
#pragma unroll
                        for (int bj = 0; bj < 2; ++bj) {
                            const int col = bcol + bj * HALF + wc * 32 + 8 * fq;
                            f32x4 y[2];
#pragma unroll
                            for (int n = 0; n < 2; ++n) {
                                y[n] = *(const f32x4*)(p.x_p + (size_t)row * D + col + 4 * n) + gt[bj][n] * acc[ai][bj][m][n];
                                ss += (y[n].x * y[n].x + y[n].y * y[n].y) + (y[n].z * y[n].z + y[n].w * y[n].w);
                                y[n] = y[n] * sf[bj][n];
                            }
                            u32x4 w; w.x = cvt_pk_bf16(y[0].x, y[0].y); w.y = cvt_pk_bf16(y[0].z, y[0].w); w.z = cvt_pk_bf16(y[1].x, y[1].y); w.w = cvt_pk_bf16(y[1].z, y[1].w);
                            *(u32x4*)(xs + (size_t)row * D + col) = w;
                        }
                        ss += __shfl_xor(ss, 16); ss += __shfl_xor(ss, 32);
                        if (fq == 0) atomicAdd(rss1 + row, ss);
                    }
            });
    const bf16_t* BtUp = (const bf16_t*)(ws + W_BTUP); const bf16_t* shf = (const bf16_t*)(ws + W_SHF); float* sW = (float*)(ws + W_SW);
    SKINNY_LOOP(j, NBIG, 64 + 176) {
        if (j < 64) {
            const int g = j >> 1, n = j & 1;
            const bf16_t* B0 = BtOut + (size_t)(32 * g + 16 * n) * D;
            skinny_tile<8, 1, 4>(mix + (size_t)NTOK * D, D, B0, B0, D, [&](int row, int s, float v0, float v1) {
                const float* mrow = mod + (size_t)(8 + row) * 6144;
                const int c0 = 32 * g + slotcol(n, s);
                const float y0 = p.x_s[(size_t)row * D + c0] + mrow[2 * D + c0] * v0;
                p.out[O_YS + (size_t)row * D + c0] = y0;
                xs[(size_t)(NTOK + row) * D + c0] = f2bf(y0 * p.g_ffn[c0] * (1.f + mrow[4 * D + c0]));
                return y0 * y0;
            }, [&](int row, float ss) { atomicAdd(rss1 + NTOK + row, ss); });
        } else {
            const int t = j - 64, pn = t >> 3, bj = (t >> 2) & 1, g4 = t & 3;
            const bf16_t* B0 = BtUp + (size_t)(256 * pn + 128 * bj + 32 * g4) * D;
            skinny_tile<9, 2, 4>(shf, D, B0, B0 + 16 * D, D, [&](int row, int s, float v0, float v1) {
                const int c0 = bj * DFF + 128 * pn + 32 * g4 + slotcol(0, s); sW[(size_t)row * (2 * DFF) + c0] = v0; sW[(size_t)row * (2 * DFF) + c0 + 4] = v1; return 0.f;
            });
        }
    }
}

DEV void phase_up(const Params& p) {
    unsigned char* ws = p.ws;
    const bf16_t* xs = (const bf16_t*)(ws + W_H); const bf16_t* BtUp = (const bf16_t*)(ws + W_BTUP); bf16_t* fin = (bf16_t*)(ws + W_PROJ);
    const float* sW = (const float*)(ws + W_SW); const float* rss1 = (const float*)(ws + W_RSS1);
    float* edgeU = (float*)(ws + W_EDGEU); float* edgeG = (float*)(ws + W_EDGEG); float* tailU = (float*)(ws + W_TAILU);
    constexpr int NBIG = 64 * 22, NSK = 176;
    gemm_phase<false>(xs, BtUp, D, 64, 22, NBIG, nullptr, [&](f32x4 (&acc)[2][2][4][2], int pm, int pn, int brow, int bcol, int wr, int wc, int fr, int fq) {
        float* halo = (float*)(shm_raw + 131072);
        const int b = brow >> 11;
        const int ff0 = 128 * pn + wc * 32 + 8 * fq;
        const int cl0 = wc * 32 + 8 * fq;
        {
            f32x4 swc[2], swg[2];
#pragma unroll
            for (int n = 0; n < 2; ++n) { swc[n] = *(const f32x4*)(sW + (size_t)b * (2 * DFF) + ff0 + 4 * n); swg[n] = *(const f32x4*)(sW + (size_t)b * (2 * DFF) + DFF + ff0 + 4 * n); }
#pragma unroll
            for (int ai = 0; ai < 2; ++ai)
#pragma unroll
                for (int m = 0; m < 4; ++m) {
                    const int rl = ai * HALF + wr * 64 + m * 16 + fr;
                    const float rstd = __builtin_amdgcn_rsqf(rss1[brow + rl] * (1.f / D) + EPS);
#pragma unroll
                    for (int n = 0; n < 2; ++n) { acc[ai][0][m][n] = acc[ai][0][m][n] * rstd + swc[n]; acc[ai][1][m][n] = acc[ai][1][m][n] * rstd + swg[n]; }
                }
        }
        if (fr >= 14) {
#pragma unroll
            for (int ai = 0; ai < 2; ++ai)
#pragma unroll
                for (int n = 0; n < 2; ++n) *(f32x4*)(halo + ((ai * 2 + wr) * 2 + fr - 14) * 128 + cl0 + 4 * n) = acc[ai][0][3][n];
        }
        __syncthreads();
        {
            f32x4 cw0[2], cw1[2], cw2[2], cb[2];
#pragma unroll
            for (int n = 0; n < 2; ++n) {
                cw0[n] = *(const f32x4*)(p.cf_w + ff0 + 4 * n); cw1[n] = *(const f32x4*)(p.cf_w + DFF + ff0 + 4 * n); cw2[n] = *(const f32x4*)(p.cf_w + 2 * DFF + ff0 + 4 * n);
                cb[n] = *(const f32x4*)(p.cf_b + ff0 + 4 * n);
            }
#pragma unroll
            for (int ai = 0; ai < 2; ++ai) {
                const int st = ai * 2 + wr;
                f32x4 um1[2];
#pragma unroll
                for (int n = 0; n < 2; ++n) {
                    um1[n] = (f32x4){0.f, 0.f, 0.f, 0.f};
                    if (st > 0 && fr >= 14) um1[n] = *(const f32x4*)(halo + ((st - 1) * 2 + fr - 14) * 128 + cl0 + 4 * n);
                }
#pragma unroll
                for (int m = 0; m < 4; ++m) {
                    const int rl = ai * HALF + wr * 64 + m * 16 + fr;
                    unsigned wv[4];
#pragma unroll
                    for (int n = 0; n < 2; ++n) {
                        const f32x4 u = acc[ai][0][m][n], g = acc[ai][1][m][n];
                        f32x4 p1, p2;
#pragma unroll
                        for (int c = 0; c < 4; ++c) { p1[c] = dpp_shr1(dpp_ror1(um1[n][c]), u[c]); p2[c] = dpp_shr2(dpp_ror2(um1[n][c]), u[c]); }
                        const f32x4 uc = cb[n] + cw0[n] * p2 + cw1[n] * p1 + cw2[n] * u;
                        wv[2 * n] = cvt_pk_bf16(geluf_(uc.x) * g.x, geluf_(uc.y) * g.y); wv[2 * n + 1] = cvt_pk_bf16(geluf_(uc.z) * g.z, geluf_(uc.w) * g.w);
                        um1[n] = u;
                    }
                    if (rl >= 2) {
                        u32x4 w; w.x = wv[0]; w.y = wv[1]; w.z = wv[2]; w.w = wv[3];
                        *(u32x4*)(fin + (size_t)(brow + rl) * DFF + ff0) = w;
                    } else {
#pragma unroll
                        for (int n = 0; n < 2; ++n) {
                            *(f32x4*)(edgeU + (size_t)(pm * 2 + rl) * DFF + ff0 + 4 * n) = acc[ai][0][m][n];
                            *(f32x4*)(edgeG + (size_t)(pm * 2 + rl) * DFF + ff0 + 4 * n) = acc[ai][1][m][n];
                        }
                    }
                    if (rl >= 254) {
#pragma unroll
                        for (int n = 0; n < 2; ++n) {
                            *(f32x4*)(tailU + (size_t)(pm * 2 + rl - 254) * DFF + ff0 + 4 * n) = acc[ai][0][m][n];
                            if ((pm & 7) == 7) *(f32x4*)(p.out + O_FCP + (size_t)(b * 2 + rl - 254) * DFF + ff0 + 4 * n) = acc[ai][0][m][n];
                        }
                    }
                }
            }
        }
    });
    SKINNY_LOOP(j, NBIG, NSK) {
            const int t = j, pn = t >> 3, g4 = (t >> 1) & 3, n = t & 1;
            const bf16_t* B0 = BtUp + (size_t)(256 * pn + 32 * g4 + 16 * n) * D;
            skinny_tile<8, 2, 4>(xs + (size_t)NTOK * D, D, B0, B0 + 128 * D, D, [&](int row, int s, float v0, float v1) {
                const int ff = 128 * pn + 32 * g4 + slotcol(n, s);
                const float rstd = __builtin_amdgcn_rsqf(rss1[NTOK + row] * (1.f / D) + EPS);
                const float u = v0 * rstd + sW[(size_t)(8 + row) * (2 * DFF) + ff], g = v1 * rstd + sW[(size_t)(8 + row) * (2 * DFF) + DFF + ff];
                const float s0 = p.st_cf[(size_t)(row * 2 + 0) * DFF + ff], s1 = p.st_cf[(size_t)(row * 2 + 1) * DFF + ff];
                const float uc = p.cf_b[ff] + p.cf_w[ff] * s0 + p.cf_w[DFF + ff] * s1 + p.cf_w[2 * DFF + ff] * u;
                fin[(size_t)(NTOK + row) * DFF + ff] = f2bf(geluf_(uc) * g);
                p.out[O_FCS + (size_t)(row * 2 + 0) * DFF + ff] = s1; p.out[O_FCS + (size_t)(row * 2 + 1) * DFF + ff] = u; return 0.f;
            });
    }
}

DEV void phase_down(const Params& p) {
    unsigned char* ws = p.ws;
    const bf16_t* fin = (const bf16_t*)(ws + W_PROJ); const bf16_t* BtDown = (const bf16_t*)(ws + W_BTDOWN);
    const float* mod = (const float*)(ws + W_MOD); float* rss2 = (float*)(ws + W_RSS2);
    const float* edgeU = (const float*)(ws + W_EDGEU); const float* edgeG = (const float*)(ws + W_EDGEG); const float* tailU = (const float*)(ws + W_TAILU);
    constexpr int NBIG = 64 * 4;
    for (int it = BIDX(); it < NBIG; it += gridDim.x) {
        int pm, pn; tile_order(it, 64, 4, pm, pn);
        bf16_t* fix = (bf16_t*)(ws + W_FIX) + (size_t)it * 2 * DFF;
            {
                const bool hp = (pm & 7) != 0;
                for (int i = TIDX(); i < DFF / 4; i += 512) {
                    const int ff = 4 * i;
                    const f32x4 z = (f32x4){0.f, 0.f, 0.f, 0.f};
                    const f32x4 um1 = hp ? *(const f32x4*)(tailU + (size_t)((pm - 1) * 2 + 1) * DFF + ff) : z, um2 = hp ? *(const f32x4*)(tailU + (size_t)((pm - 1) * 2 + 0) * DFF + ff) : z;
                    const f32x4 u0 = *(const f32x4*)(edgeU + (size_t)(pm * 2) * DFF + ff), u1 = *(const f32x4*)(edgeU + (size_t)(pm * 2 + 1) * DFF + ff);
                    const f32x4 g0 = *(const f32x4*)(edgeG + (size_t)(pm * 2) * DFF + ff), g1 = *(const f32x4*)(edgeG + (size_t)(pm * 2 + 1) * DFF + ff);
                    const f32x4 cb = *(const f32x4*)(p.cf_b + ff), w0 = *(const f32x4*)(p.cf_w + ff), w1 = *(const f32x4*)(p.cf_w + DFF + ff), w2 = *(const f32x4*)(p.cf_w + 2 * DFF + ff);
                    const f32x4 c0 = cb + w0 * um2 + w1 * um1 + w2 * u0, c1 = cb + w0 * um1 + w1 * u0 + w2 * u1;
                    u32x2 o0, o1;
                    o0.x = cvt_pk_bf16(geluf_(c0.x) * g0.x, geluf_(c0.y) * g0.y); o0.y = cvt_pk_bf16(geluf_(c0.z) * g0.z, geluf_(c0.w) * g0.w);
                    o1.x = cvt_pk_bf16(geluf_(c1.x) * g1.x, geluf_(c1.y) * g1.y); o1.y = cvt_pk_bf16(geluf_(c1.z) * g1.z, geluf_(c1.w) * g1.w);
                    *(u32x2*)(fix + ff) = o0; *(u32x2*)(fix + DFF + ff) = o1;
                }
            }
    }
    asm volatile("s_waitcnt vmcnt(0)" ::: "memory");
    __syncthreads();
    gemm_phase<true>(fin, BtDown, DFF, 64, 4, NBIG, (const bf16_t*)(ws + W_FIX), [&](f32x4 (&acc)[2][2][4][2], int pm, int pn, int brow, int bcol, int wr, int wc, int fr, int fq) {
        const int b = brow >> 11;
        const float* mrow = mod + (size_t)b * 6144;
        const bf16_t* xs = (const bf16_t*)(ws + W_H);
        const bool fuse = (gridDim.x == 256);
        unsigned* cnt = (unsigned*)(ws + W_BAR) + 3456 + 64 * pm;
        {
            f32x4 gt[2][2], isf[2][2];
#pragma unroll
            for (int bj = 0; bj < 2; ++bj)
#pragma unroll
                for (int n = 0; n < 2; ++n) {
                    const int col = bcol + bj * HALF + wc * 32 + 8 * fq + 4 * n;
                    gt[bj][n] = *(const f32x4*)(mrow + 5 * D + col);
                    const f32x4 sf = *(const f32x4*)(p.g_ffn + col) * (1.f + *(const f32x4*)(mrow + 4 * D + col));
                    isf[bj][n] = (f32x4){__builtin_amdgcn_rcpf(sf.x), __builtin_amdgcn_rcpf(sf.y), __builtin_amdgcn_rcpf(sf.z), __builtin_amdgcn_rcpf(sf.w)};
                }
#pragma unroll
            for (int ai = 0; ai < 2; ++ai)
#pragma unroll
                for (int m = 0; m < 4; ++m) {
                    const int row = brow + ai * HALF + wr * 64 + m * 16 + fr;
                    float ss = 0.f;
#pragma unroll
                    for (int bj = 0; bj < 2; ++bj) {
                        const int col = bcol + bj * HALF + wc * 32 + 8 * fq;
                        float xv[8]; unpack8(*(const u32x4*)(xs + (size_t)row * D + col), xv);
#pragma unroll
                        for (int n = 0; n < 2; ++n) {
                            const f32x4 x1 = (f32x4){xv[4 * n], xv[4 * n + 1], xv[4 * n + 2], xv[4 * n + 3]} * isf[bj][n];
                            const f32x4 y = x1 + gt[bj][n] * acc[ai][bj][m][n];
                            acc[ai][bj][m][n] = y;
                            ss += (y.x * y.x + y.y * y.y) + (y.z * y.z + y.w * y.w);
                        }
                    }
                    ss += __shfl_xor(ss, 16); ss += __shfl_xor(ss, 32);
                    if (fq == 0) atomicAdd(rss2 + row, ss);
                }
        }
        asm volatile("s_waitcnt vmcnt(0)" ::: "memory");
        __syncthreads();
        if (fuse && TIDX() == 0) {
            __hip_atomic_fetch_add(cnt, 1u, __ATOMIC_RELAXED, __HIP_MEMORY_SCOPE_AGENT);
            unsigned sp = 0;
            while (__hip_atomic_load(cnt, __ATOMIC_RELAXED, __HIP_MEMORY_SCOPE_AGENT) < 4u) { __builtin_amdgcn_s_sleep(2); if (++sp > (1u << 22)) break; }
        }
        __syncthreads();
        {
            f32x4 gf[2][2];
#pragma unroll
            for (int bj = 0; bj < 2; ++bj)
#pragma unroll
                for (int n = 0; n < 2; ++n) gf[bj][n] = *(const f32x4*)(p.g_final + bcol + bj * HALF + wc * 32 + 8 * fq + 4 * n);
            float tot[2][4];
#pragma unroll
            for (int ai = 0; ai < 2; ++ai)
#pragma unroll
                for (int m = 0; m < 4; ++m) tot[ai][m] = fuse ? __hip_atomic_load(rss2 + brow + ai * HALF + wr * 64 + m * 16 + fr, __ATOMIC_RELAXED, __HIP_MEMORY_SCOPE_AGENT) : 0.f;
#pragma unroll
            for (int ai = 0; ai < 2; ++ai)
#pragma unroll
                for (int m = 0; m < 4; ++m) {
                    const int row = brow + ai * HALF + wr * 64 + m * 16 + fr;
                    const float rstd = fuse ? __builtin_amdgcn_rsqf(tot[ai][m] * (1.f / D) + EPS) : 1.f;
#pragma unroll
                    for (int bj = 0; bj < 2; ++bj)
#pragma unroll
                        for (int n = 0; n < 2; ++n)
                            *(f32x4*)(p.out + O_YP + (size_t)row * D + bcol + bj * HALF + wc * 32 + 8 * fq + 4 * n) = fuse ? acc[ai][bj][m][n] * rstd * gf[bj][n] : acc[ai][bj][m][n];
                }
        }
    });
    for (int j = BIDX(); j < 32 * 11; j += gridDim.x) {
        const int g = j / 11, ksl = j - g * 11;
        const bf16_t* B0 = BtDown + (size_t)(32 * g) * DFF + ksl * 256;
        float* part = (float*)(ws + W_KVT) + (size_t)ksl * NSMP * D;
        skinny_tile<8, 2, 2>(fin + (size_t)NTOK * DFF + ksl * 256, DFF, B0, B0 + 16 * DFF, 256, [&](int row, int s, float v0, float v1) {
            const int c0 = 32 * g + slotcol(0, s);
            part[(size_t)row * D + c0] = v0; part[(size_t)row * D + c0 + 4] = v1; return 0.f;
        }, NoRowFn(), DFF);
    }
}

DEV void phase_final(const Params& p) {
    const float* rss2 = (const float*)(p.ws + W_RSS2);
    const int gt = BIDX() * 512 + TIDX(), GT = gridDim.x * 512;
    if (gridDim.x != 256)
    for (int i = gt; i < NTOK * 256; i += GT) {
        const int row = i >> 8, k = (i & 255) * 4;
        const float rstd = __builtin_amdgcn_rsqf(rss2[row] * (1.f / D) + EPS);
        f32x4* yp = (f32x4*)(p.out + (size_t)row * D + k);
        *yp = *yp * rstd * *(const f32x4*)(p.g_final + k);
    }
    const float* part = (const float*)(p.ws + W_KVT); const float* mod = (const float*)(p.ws + W_MOD);
    const int lane = TIDX() & 63, gw = BIDX() * 8 + (TIDX() >> 6), NGW = gridDim.x * 8;
    for (int row = gw; row < NSMP; row += NGW) {
        float* yp = p.out + O_YS + (size_t)row * D; const float* mrow = mod + (size_t)(8 + row) * 6144 + 5 * D;
        f32x4 y[4]; float ss = 0.f;
#pragma unroll
        for (int j = 0; j < 4; ++j) {
            const int k = 4 * lane + 256 * j;
            f32x4 a = (f32x4){0.f, 0.f, 0.f, 0.f};
#pragma unroll
            for (int sl = 0; sl < 11; ++sl) a = a + *(const f32x4*)(part + ((size_t)sl * NSMP + row) * D + k);
            y[j] = *(const f32x4*)(yp + k) + *(const f32x4*)(mrow + k) * a;
            ss += y[j].x * y[j].x + y[j].y * y[j].y + y[j].z * y[j].z + y[j].w * y[j].w;
        }
        const float rstd = __builtin_amdgcn_rsqf(wave_sum(ss) * (1.f / D) + EPS);
#pragma unroll
        for (int j = 0; j < 4; ++j) { const int k = 4 * lane + 256 * j; *(f32x4*)(yp + k) = y[j] * rstd * *(const f32x4*)(p.g_final + k); }
    }
}

#define XB_TMO      128
#define XB_XCNT(j)  (256  + 64 * (j))
#define XB_XSUB(j)  (1280 + 64 * (j))
#define XB_XGEN(j)  (2304 + 64 * (j))
#define XB_TOP      3328
#define XB_TOPGEN   3392
#define XCD_BAR_WORDS 3456
#define XB_SPIN_CAP (1u << 20)
DEV unsigned xb_ld(unsigned* p) { return __hip_atomic_load(p, __ATOMIC_RELAXED, __HIP_MEMORY_SCOPE_AGENT); }
DEV unsigned xb_add(unsigned* p, unsigned v) { return __hip_atomic_fetch_add(p, v, __ATOMIC_RELAXED, __HIP_MEMORY_SCOPE_AGENT); }
DEV unsigned xb_xcc_id() { return (unsigned)__builtin_amdgcn_s_getreg((3 << 11) | 20) & 0xFu; }
#define XB_SPIN(cond, bar) do { unsigned _sp = 0; while (cond) { __builtin_amdgcn_s_sleep(1); \
    if ((++_sp & 255u) == 0u) { if (xb_ld(&(bar)[XB_TMO])) break; if (_sp > XB_SPIN_CAP) { atomicAdd(&(bar)[XB_TMO], 1u); break; } } } } while (0)
struct XcdBarrier { unsigned* bar; unsigned x; volatile LAS unsigned* st; };
DEV XcdBarrier xcd_barrier_post(unsigned* bar, volatile LAS unsigned* st) {
    XcdBarrier b; b.bar = bar; b.x = xb_xcc_id(); b.st = st;
    if (threadIdx.x == 0) (void)xb_add(&bar[XB_XCNT(b.x)], 1u);
    return b;
}
DEV void xcd_barrier_complete(unsigned* bar, unsigned x, unsigned& nloc, unsigned& nx) {
    const unsigned G = gridDim.x * gridDim.y * gridDim.z;
    unsigned sum, cnt, mine, sp = 0u;
    for (;;) {
        sum = 0u; cnt = 0u; mine = 0u;
#pragma unroll
        for (unsigned j = 0; j < 16; ++j) { const unsigned c = xb_ld(&bar[XB_XCNT(j)]); sum += c; cnt += (c > 0u) ? 1u : 0u; mine = (j == x) ? c : mine; }
        if (sum == G) break;
        __builtin_amdgcn_s_sleep(1);
        if ((++sp & 255u) == 0u) { if (xb_ld(&bar[XB_TMO])) break; if (sp > XB_SPIN_CAP) { atomicAdd(&bar[XB_TMO], 1u); break; } }
    }
    nloc = mine > 0u ? mine : 1u; nx = cnt > 0u ? cnt : 1u;
}
DEV void xcd_barrier(const XcdBarrier& b) {
    asm volatile("s_waitcnt vmcnt(0)" ::: "memory");
    __syncthreads();
    if (threadIdx.x == 0) {
        unsigned* bar = b.bar;
        __builtin_amdgcn_s_waitcnt(0);
        unsigned nloc = b.st[0], nx = b.st[1];
        if (nloc == 0u) { xcd_barrier_complete(bar, b.x, nloc, nx); b.st[0] = nloc; b.st[1] = nx; }
        const unsigned old = xb_add(&bar[XB_XSUB(b.x)], 1u);
        const unsigned gen = old / nloc;
        if (old + 1u == (gen + 1u) * nloc) {
            __builtin_amdgcn_fence(__ATOMIC_RELEASE, "agent");
            asm volatile("s_waitcnt vmcnt(0)" ::: "memory");
            const unsigned og = xb_add(&bar[XB_TOP], 1u);
            const unsigned tg = og / nx;
            if (og + 1u == (tg + 1u) * nx) xb_add(&bar[XB_TOPGEN], 1u);
            else XB_SPIN(xb_ld(&bar[XB_TOPGEN]) == tg, bar);
            __builtin_amdgcn_fence(__ATOMIC_ACQUIRE, "agent");
            xb_add(&bar[XB_XGEN(b.x)], 1u);
            asm volatile("s_waitcnt vmcnt(0)" ::: "memory");
        } else {
            XB_SPIN(xb_ld(&bar[XB_XGEN(b.x)]) == gen, bar);
            __builtin_amdgcn_fence(__ATOMIC_ACQUIRE, "agent");
            asm volatile("s_waitcnt vmcnt(0)" ::: "memory");
        }
    }
    __syncthreads();
}

typedef const unsigned long long __attribute__((address_space(4)))* KWordPtr;
DEV Params kparams() {
    KWordPtr k = (KWordPtr)__builtin_amdgcn_kernarg_segment_ptr(); asm volatile("" : "+s"(k));
    Params q; unsigned long long* d = (unsigned long long*)&q;
#pragma unroll
    for (int i = 0; i < (int)(sizeof(Params) / 8); ++i) d[i] = k[i];
    return q;
}
__global__ void __launch_bounds__(512) fwd_kernel(Params p) {
    cg::grid_group grid = cg::this_grid();
    volatile LAS unsigned* xst = (volatile LAS unsigned*)((LAS unsigned char*)shm_raw + (LDS_BYTES - 16));
    if (threadIdx.x == 0) { xst[0] = 0u; xst[1] = 0u; }
    __syncthreads();
    const XcdBarrier xb = xcd_barrier_post((unsigned*)(p.ws + W_BAR), xst);
    const int lo = (int)p.ph_lo, hi = (int)p.ph_hi;
    if (hi < 0) grid.sync();
#ifdef ONLY_PHASE
#define RUNP(si, ph, call) if (ph == ONLY_PHASE) { const Params q = kparams(); call(q); }
#else
#define RUNP(si, ph, call) if (lo <= si && si < hi) { { const Params q = kparams(); call(q); } if (si + 1 < hi) { xcd_barrier(xb); } }
#endif
    RUNP(0, 0, phase_prep)
    RUNP(1, 1, phase_mod)
    RUNP(2, 2, phase_norm1)
    RUNP(3, 3, phase_inproj)
    RUNP(4, 4, phase_mixA)
    RUNP(5, 10, phase_scan)
    RUNP(6, 5, phase_mixC)
    RUNP(7, 6, phase_outproj)
    RUNP(8, 7, phase_up)
    RUNP(9, 8, phase_down)
    RUNP(10, 9, phase_final)
}

extern "C" void kernel_launch(void* const* d_in, const int* in_sizes, int n_in, void* d_out, int out_size, void* d_ws, size_t ws_size, hipStream_t stream) {
    static int grid_blocks = 0;
    if (grid_blocks == 0) {
        if (n_in != 27 || ws_size < W_END) { fprintf(stderr, "kernel_launch: unexpected n_in %d or ws_size %zu (< %zu)\n", n_in, ws_size, (size_t)W_END); grid_blocks = -1; return; }
        int dev = 0, cus = 0, per_cu = 0;
        hipGetDevice(&dev);
        hipDeviceGetAttribute(&cus, hipDeviceAttributeMultiprocessorCount, dev);
        if (hipFuncSetAttribute((const void*)fwd_kernel, hipFuncAttributeMaxDynamicSharedMemorySize, LDS_BYTES) != hipSuccess) { fprintf(stderr, "kernel_launch: hipFuncSetAttribute failed\n"); grid_blocks = -1; return; }
        if (hipOccupancyMaxActiveBlocksPerMultiprocessor(&per_cu, (const void*)fwd_kernel, 512, LDS_BYTES) != hipSuccess || per_cu < 1) { fprintf(stderr, "kernel_launch: occupancy query failed (%d)\n", per_cu); (void)hipGetLastError(); per_cu = 1; }
        grid_blocks = cus * 1;
    }
    if (grid_blocks < 0) return;
    Params p{};
    const float** pp = (const float**)&p;
    for (int i = 0; i < 27; ++i) pp[i] = (const float*)d_in[i];
    p.out = (float*)d_out; p.ws = (unsigned char*)d_ws;
    if (hipMemsetAsync((char*)d_ws + W_BAR, 0, (size_t)BAR_WORDS * 4, stream) != hipSuccess) { fprintf(stderr, "kernel_launch: memset failed\n"); return; }
#if MK_MULTI
    for (int ph = 0; ph < 11; ++ph) {
        p.ph_lo = ph; p.ph_hi = ph + 1;
        hipLaunchKernelGGL(fwd_kernel, dim3(grid_blocks), dim3(512), LDS_BYTES, stream, p);
    }
#else
    p.ph_lo = 0; p.ph_hi = 11;
    void* args[] = {&p};
    hipError_t e = hipLaunchCooperativeKernel((const void*)fwd_kernel, dim3(grid_blocks), dim3(512), args, LDS_BYTES, stream);
    if (e != hipSuccess) fprintf(stderr, "cooperative launch failed: %s (grid %d)\n", hipGetErrorString(e), grid_blocks);
#endif
}
```

```cpp
#include <hip/hip_runtime.h>
#include <hip/hip_cooperative_groups.h>
#include <cstdio>
#include <cstdint>
namespace cg = cooperative_groups;

#ifndef MK_MULTI
#define MK_MULTI 0
#endif

#define DEV __device__ __forceinline__
typedef unsigned short bf16_t;
typedef short bf16x8 __attribute__((ext_vector_type(8)));
typedef float f32x4 __attribute__((ext_vector_type(4)));
typedef unsigned u32x4 __attribute__((ext_vector_type(4)));
typedef unsigned u32x2 __attribute__((ext_vector_type(2)));

constexpr int D = 1024, TSEQ = 2048, NBATCH = 8, NTOK = 16384, NSMP = 128, NROWS = NTOK + NSMP;
constexpr int DP = 3072, DFF = 2816, DLRU = 512, NMODROWS = 144;
constexpr float EPS = 1e-6f;
constexpr int PAST_LEN = 16384;

constexpr size_t O_YP = 0, O_YS = O_YP + (size_t)NTOK * D, O_RETP = O_YS + (size_t)NSMP * D, O_LHP = O_RETP + 8 * 4 * 128 * 128,
                 O_LCP = O_LHP + 8 * 512, O_FCP = O_LCP + 8 * 3 * 512, O_RETS = O_FCP + 8 * 2 * DFF, O_LHS = O_RETS + (size_t)128 * 4 * 128 * 128,
                 O_LCS = O_LHS + 128 * 512, O_FCS = O_LCS + 128 * 3 * 512;

constexpr size_t al256(size_t x) { return (x + 255) & ~(size_t)255; }
constexpr size_t W_BTIN = 0;
constexpr size_t W_BTOUT = W_BTIN + (size_t)DP * D * 2;
constexpr size_t W_BTUP = W_BTOUT + (size_t)D * D * 2;
constexpr size_t W_BTDOWN = W_BTUP + (size_t)2 * DFF * D * 2;
constexpr size_t W_WRT = W_BTDOWN + (size_t)D * DFF * 2;
constexpr size_t W_H = W_WRT + 2 * 8 * 64 * 64 * 2;
constexpr size_t W_PROJ = W_H + (size_t)NROWS * D * 2;
constexpr size_t W_MIX = W_PROJ + (size_t)NTOK * DP * 2;
constexpr size_t W_KVT = W_MIX + (size_t)NROWS * D * 2;
constexpr size_t W_MOD = W_KVT + (size_t)512 * 65536;
constexpr size_t W_SW = W_MOD + (size_t)NMODROWS * 6144 * 4;
constexpr size_t W_PROJS = W_SW + (size_t)NMODROWS * 2 * DFF * 4;
constexpr size_t W_ROPE = W_PROJS + (size_t)NSMP * DP * 4;
constexpr size_t W_EDGEU = al256(W_ROPE + (size_t)(TSEQ + 1) * 128 * 4);
constexpr size_t W_EDGEG = W_EDGEU + (size_t)64 * 2 * DFF * 4;
constexpr size_t W_TAILU = W_EDGEG + (size_t)64 * 2 * DFF * 4;
constexpr size_t W_FIX = W_TAILU + (size_t)64 * 2 * DFF * 4;
constexpr size_t W_AGG = W_FIX + (size_t)256 * 2 * DFF * 2;
constexpr size_t W_RSS1 = W_AGG + (size_t)8 * 8 * 16 * 2 * 64 * 4;
constexpr size_t W_RSS2 = al256(W_RSS1 + (size_t)NROWS * 4);
constexpr size_t W_SPL = al256(W_RSS2 + (size_t)NROWS * 4);
constexpr size_t W_MODA = W_SPL + 512 * 4;
constexpr size_t W_SHF = W_MODA + (size_t)NMODROWS * D * 2;
constexpr size_t W_HIN0 = al256(W_SHF + (size_t)NMODROWS * D * 2);
constexpr size_t W_BAR = W_HIN0 + (size_t)1024 * 64 * 4;
constexpr int BAR_WORDS = 3456 + 64 * 64;
constexpr size_t W_END = W_BAR + (size_t)BAR_WORDS * 4;

constexpr int LDS_BYTES = 147456;

struct Params {
    const float *x_p, *x_s, *c_p, *c_s, *st_ret, *st_h, *st_cl, *st_cf, *w_ada, *b_ada, *g_mix, *w_in, *cl_w, *cl_b, *w_r, *b_r, *w_i, *b_i, *lam,
        *w_out, *g_ffn, *w_upc, *w_upg, *cf_w, *cf_b, *w_down, *g_final;
    float* out;
    unsigned char* ws;
    long long ph_lo, ph_hi;
};

extern __shared__ __attribute__((aligned(16))) unsigned char shm_raw[];

DEV int TIDX() { int t = threadIdx.x; asm volatile("" : "+v"(t)); return t; }
DEV int BIDX() { int b = blockIdx.x; asm volatile("" : "+s"(b)); return b; }
typedef float f32x2_ __attribute__((ext_vector_type(2)));
typedef __bf16 bf16x2_ __attribute__((ext_vector_type(2)));
DEV unsigned cvt_pk_bf16(float lo, float hi) { const f32x2_ v = {lo, hi}; const bf16x2_ r = __builtin_convertvector(v, bf16x2_); return __builtin_bit_cast(unsigned, r); }
DEV bf16_t f2bf(float x) { return (bf16_t)(cvt_pk_bf16(x, 0.f) & 0xffffu); }
DEV float bf2f(bf16_t v) { return __uint_as_float(((unsigned)v) << 16); }
DEV float bflo(unsigned w) { return __uint_as_float(w << 16); }
DEV float bfhi(unsigned w) { return __uint_as_float(w & 0xffff0000u); }
DEV float fexp2(float x) { return __builtin_amdgcn_exp2f(x); }
DEV float sigmoidf_(float x) { return __builtin_amdgcn_rcpf(1.f + fexp2(-1.4426950408889634f * x)); }
DEV float siluf_(float x) { return x * sigmoidf_(x); }
DEV float geluf_(float x) { const float y = 1.5957691216057308f * (x + 0.044715f * x * x * x); return x * sigmoidf_(y); }
DEV float wave_sum(float v) {
#pragma unroll
    for (int o = 1; o < 64; o <<= 1) v += __shfl_xor(v, o);
    return v;
}
DEV void unpack8(u32x4 w, float* f) { f[0] = bflo(w.x); f[1] = bfhi(w.x); f[2] = bflo(w.y); f[3] = bfhi(w.y); f[4] = bflo(w.z); f[5] = bfhi(w.z); f[6] = bflo(w.w); f[7] = bfhi(w.w); }
DEV u32x4 pack8(const float* f) { u32x4 w; w.x = cvt_pk_bf16(f[0], f[1]); w.y = cvt_pk_bf16(f[2], f[3]); w.z = cvt_pk_bf16(f[4], f[5]); w.w = cvt_pk_bf16(f[6], f[7]); return w; }
DEV int rhoinv(int w) { return 16 * ((w >> 2) & 1) + 4 * (w >> 3) + (w & 3); }
DEV int permpos(int c) { return (c & ~31) | rhoinv(c & 31); }
DEV int slotcol(int n, int s) { return 8 * (s >> 2) + 4 * n + (s & 3); }
DEV float gamma_log2(int h) { return __log2f(1.f - exp2f(-5.f - (float)h)); }

constexpr int BM = 256, BK = 64, HALF = 128, HT = HALF * BK;
DEV int lds_byte(int r, int c) { int st = (r >> 4) * 2 + (c >> 5), rr = r & 15, cc = c & 31, ob = rr * 64 + cc * 2; return st * 1024 + (ob ^ (((ob >> 9) & 1) << 5)); }
DEV void stage_rc(int b, int& R, int& C) { int st = b / 1024, sb = b % 1024, swz = sb ^ (((sb >> 9) & 1) << 5); R = (st >> 1) * 16 + swz / 64; C = (st & 1) * 32 + (swz % 64) / 2; }

#define LAS __attribute__((address_space(3)))
template <bool FIX, class Epi>
DEV void gemm_tile(const bf16_t* __restrict__ A, const bf16_t* __restrict__ Bt, const int K, const int brow, const int bcol, const bf16_t* fixA, Epi&& epi) {
    LAS unsigned char* lds = (LAS unsigned char*)shm_raw;
    const int tid = TIDX(), wid = __builtin_amdgcn_readfirstlane(tid >> 6), lane = tid & 63, wr = wid >> 2, wc = wid & 3, fr = lane & 15, fq = lane >> 4;
    const int nt = K / BK;
    constexpr int HTB = HALF * BK * 2;
    unsigned voff[2], voffF[2];
#pragma unroll
    for (int i = 0; i < 2; ++i) {
        int R, C; stage_rc(tid * 16 + i * 8192, R, C);
        voff[i] = (unsigned)(R * K + C) * 2u; voffF[i] = voff[i];
        if (FIX) { if (R < 2) voffF[i] = (unsigned)(((const char*)fixA - (const char*)(A + (size_t)brow * K)) + (long)(R * K + C) * 2); }
    }
    const size_t kstep = (size_t)(BK * 2), hstep = (size_t)HALF * K * 2;
    const unsigned ldsw = (unsigned)wid * 1024u;
    const int aoff = lds_byte(wr * 64 + fr, fq * 8), boff = lds_byte(wc * 32 + fr, fq * 8);
    const char* cA = (const char*)(A + (size_t)brow * K); const char* cB = (const char*)(Bt + (size_t)bcol * K);
#define SA(b, h) (((b) * 2 + (h)) * HTB)
#define SB(b, h) ((4 + (b) * 2 + (h)) * HTB)
#define STAGE(bufoff, gbase, vo) do { _Pragma("unroll") for (int _i = 0; _i < 2; ++_i) \
        __builtin_amdgcn_global_load_lds((const unsigned*)((const char*)(gbase) + (vo)[_i]), (LAS unsigned*)(lds + (bufoff) + ldsw + _i * 8192), 16, 0, 0); } while (0)
#define LDA(dst, b, h) do { _Pragma("unroll") for (int m = 0; m < 4; ++m) _Pragma("unroll") for (int k = 0; k < 2; ++k) dst[m][k] = *(const LAS bf16x8*)(lds + SA(b, h) + aoff + m * 2048 + k * 1024); } while (0)
#define LDB(dst, b, h) do { _Pragma("unroll") for (int n = 0; n < 2; ++n) _Pragma("unroll") for (int k = 0; k < 2; ++k) dst[n][k] = *(const LAS bf16x8*)(lds + SB(b, h) + boff + n * 2048 + k * 1024); } while (0)
#define MMA(ai, bj, At_, Bt_) do { __builtin_amdgcn_s_setprio(1); _Pragma("unroll") for (int m = 0; m < 4; ++m) _Pragma("unroll") for (int n = 0; n < 2; ++n) _Pragma("unroll") for (int k = 0; k < 2; ++k) \
        acc[ai][bj][m][n] = __builtin_amdgcn_mfma_f32_16x16x32_bf16(Bt_[n][k], At_[m][k], acc[ai][bj][m][n], 0, 0, 0); __builtin_amdgcn_s_setprio(0); } while (0)
#define WAIT_V(n) asm volatile("s_waitcnt vmcnt(" #n ")" ::: "memory")
#define WAIT_L(n) asm volatile("s_waitcnt lgkmcnt(" #n ")" ::: "memory")
#define BAR __builtin_amdgcn_s_barrier()
#define SCHED __builtin_amdgcn_sched_barrier(0)
    f32x4 acc[2][2][4][2];
#pragma unroll
    for (int a = 0; a < 2; ++a)
#pragma unroll
        for (int b = 0; b < 2; ++b)
#pragma unroll
            for (int m = 0; m < 4; ++m)
#pragma unroll
                for (int n = 0; n < 2; ++n) acc[a][b][m][n] = (f32x4){0.f, 0.f, 0.f, 0.f};
    bf16x8 At[4][2], B0[2][2], B1[2][2];
    STAGE(SB(0, 0), cB, voff); STAGE(SA(0, 0), cA, voffF); STAGE(SB(0, 1), cB + hstep, voff); STAGE(SA(0, 1), cA + hstep, voff);
    if (wr == 1) BAR;
    WAIT_V(4); BAR;
    STAGE(SB(1, 0), cB + kstep, voff); STAGE(SA(1, 0), cA + kstep, voffF); STAGE(SB(1, 1), cB + hstep + kstep, voff);
    WAIT_V(6); BAR;
    for (int t = 0; t < nt - 2; t += 2) {
        const char* a1 = cA + (size_t)(t + 1) * kstep; const char* a2 = a1 + kstep; const char* a3 = a2 + kstep;
        const char* b2 = cB + (size_t)(t + 2) * kstep; const char* b3 = b2 + kstep;
        LDB(B0, 0, 0); SCHED; LDA(At, 0, 0); STAGE(SA(1, 1), a1 + hstep, voff);
        WAIT_L(8); BAR; WAIT_L(0); MMA(0, 0, At, B0); BAR; SCHED;
        LDB(B1, 0, 1); STAGE(SB(0, 0), b2, voff);
        BAR; WAIT_L(0); MMA(0, 1, At, B1); BAR;
        LDA(At, 0, 1); STAGE(SA(0, 0), a2, voffF);
        BAR; WAIT_L(0); MMA(1, 0, At, B0); BAR; SCHED;
        STAGE(SB(0, 1), b2 + hstep, voff);
        WAIT_V(6); BAR; MMA(1, 1, At, B1); BAR;
        LDB(B0, 1, 0); SCHED; LDA(At, 1, 0); STAGE(SA(0, 1), a2 + hstep, voff);
        WAIT_L(8); BAR; WAIT_L(0); MMA(0, 0, At, B0); BAR; SCHED;
        LDB(B1, 1, 1); STAGE(SB(1, 0), b3, voff);
        BAR; WAIT_L(0); MMA(0, 1, At, B1); BAR;
        LDA(At, 1, 1); STAGE(SA(1, 0), a3, voffF);
        BAR; WAIT_L(0); MMA(1, 0, At, B0); BAR; SCHED;
        STAGE(SB(1, 1), b3 + hstep, voff);
        WAIT_V(6); BAR; MMA(1, 1, At, B1); BAR;
    }
    { LDB(B0, 0, 0); LDA(At, 0, 0); STAGE(SA(1, 1), cA + (size_t)(nt - 1) * kstep + hstep, voff);
      BAR; WAIT_L(0); MMA(0, 0, At, B0); BAR;
      LDB(B1, 0, 1); BAR; WAIT_L(0); MMA(0, 1, At, B1); BAR;
      LDA(At, 0, 1); WAIT_V(4); BAR; WAIT_L(0); MMA(1, 0, At, B0); MMA(1, 1, At, B1); BAR; }
    { LDB(B0, 1, 0); LDA(At, 1, 0); WAIT_V(2); BAR; WAIT_L(0); MMA(0, 0, At, B0); BAR;
      LDB(B1, 1, 1); WAIT_V(0); BAR; WAIT_L(0); MMA(0, 1, At, B1); BAR;
      LDA(At, 1, 1); BAR; WAIT_L(0); MMA(1, 0, At, B0); MMA(1, 1, At, B1); BAR; }
    if (wr == 0) BAR;
    asm volatile("" ::: "memory");
    epi(acc, brow, bcol, wr, wc, fr, fq);
#undef SA
#undef SB
#undef STAGE
#undef LDA
#undef LDB
#undef MMA
}

DEV void tile_order(int L, int nM, int nN, int& pm, int& pn) {
    const int nwg = nM * nN, NX = 8, WGM = 8;
    int wgid = L; { const int q = nwg / NX, r = nwg % NX, xcd = wgid % NX, off = wgid / NX; wgid = (xcd < r ? xcd * (q + 1) : r * (q + 1) + (xcd - r) * q) + off; }
    const int nig = WGM * nN, gid = wgid / nig, fm = gid * WGM, gsz = (nM - fm) < WGM ? (nM - fm) : WGM;
    pm = fm + ((wgid % nig) % gsz); pn = (wgid % nig) / gsz;
}

DEV float dpp_ror1(float x) { return __int_as_float(__builtin_amdgcn_update_dpp(0, __float_as_int(x), 0x121, 0xf, 0xf, false)); }
DEV float dpp_ror2(float x) { return __int_as_float(__builtin_amdgcn_update_dpp(0, __float_as_int(x), 0x122, 0xf, 0xf, false)); }
DEV float dpp_shr1(float old, float x) { return __int_as_float(__builtin_amdgcn_update_dpp(__float_as_int(old), __float_as_int(x), 0x111, 0xf, 0xf, false)); }
DEV float dpp_shr2(float old, float x) { return __int_as_float(__builtin_amdgcn_update_dpp(__float_as_int(old), __float_as_int(x), 0x112, 0xf, 0xf, false)); }
#define SKINNY_LOOP(j, NBIG_, NSK_) const int _nb = gridDim.x, _first = (NBIG_) % _nb, _bb = BIDX(); if (_bb >= _first) for (int j = _bb - _first; j < (NSK_); j += _nb - _first)
template <bool FIX, class Epi>
DEV void gemm_phase(const bf16_t* __restrict__ A, const bf16_t* __restrict__ Bt, const int K, const int nM, const int nN, const int nbig, const bf16_t* fixbase, Epi&& epi) {
    LAS unsigned char* lds = (LAS unsigned char*)shm_raw;
    const int tid = TIDX(), wid = __builtin_amdgcn_readfirstlane(tid >> 6), lane = tid & 63, wr = wid >> 2, wc = wid & 3, fr = lane & 15, fq = lane >> 4;
    const int nt = K / BK, G = gridDim.x;
    int it = BIDX();
    if (it >= nbig) return;
    constexpr int HTB = HALF * BK * 2;
    unsigned voff[2], voffF[2], voffFn[2];
    int sR[2], sC[2];
#pragma unroll
    for (int i = 0; i < 2; ++i) { stage_rc(tid * 16 + i * 8192, sR[i], sC[i]); voff[i] = (unsigned)(sR[i] * K + sC[i]) * 2u; voffF[i] = voff[i]; voffFn[i] = voff[i]; }
    const size_t kstep = (size_t)(BK * 2), hstep = (size_t)HALF * K * 2, tstep = 2 * hstep;
    const unsigned ldsw = (unsigned)wid * 1024u;
    const int aoff = lds_byte(wr * 64 + fr, fq * 8), boff = lds_byte(wc * 32 + fr, fq * 8);
    int pm, pn; tile_order(it, nM, nN, pm, pn);
    const char* cA = (const char*)A + (size_t)pm * tstep; const char* cB = (const char*)Bt + (size_t)pn * tstep;
    if (FIX) {
#pragma unroll
        for (int i = 0; i < 2; ++i) if (sR[i] < 2) voffF[i] = (unsigned)(((const char*)(fixbase + (size_t)it * 2 * K) - cA) + (long)(sR[i] * K + sC[i]) * 2);
    }
#define SA(b, h) (((b) * 2 + (h)) * HTB)
#define SB(b, h) ((4 + (b) * 2 + (h)) * HTB)
#define STAGE(bufoff, gbase, vo) do { _Pragma("unroll") for (int _i = 0; _i < 2; ++_i) \
        __builtin_amdgcn_global_load_lds((const unsigned*)((const char*)(gbase) + (vo)[_i]), (LAS unsigned*)(lds + (bufoff) + ldsw + _i * 8192), 16, 0, 0); } while (0)
#define LDA(dst, b, h) do { _Pragma("unroll") for (int m = 0; m < 4; ++m) _Pragma("unroll") for (int k = 0; k < 2; ++k) dst[m][k] = *(const LAS bf16x8*)(lds + SA(b, h) + aoff + m * 2048 + k * 1024); } while (0)
#define LDB(dst, b, h) do { _Pragma("unroll") for (int n = 0; n < 2; ++n) _Pragma("unroll") for (int k = 0; k < 2; ++k) dst[n][k] = *(const LAS bf16x8*)(lds + SB(b, h) + boff + n * 2048 + k * 1024); } while (0)
#define MMA(ai, bj, At_, Bt_) do { __builtin_amdgcn_s_setprio(1); _Pragma("unroll") for (int m = 0; m < 4; ++m) _Pragma("unroll") for (int n = 0; n < 2; ++n) _Pragma("unroll") for (int k = 0; k < 2; ++k) \
        acc[ai][bj][m][n] = __builtin_amdgcn_mfma_f32_16x16x32_bf16(Bt_[n][k], At_[m][k], acc[ai][bj][m][n], 0, 0, 0); __builtin_amdgcn_s_setprio(0); } while (0)
    f32x4 acc[2][2][4][2];
#define ZACC() do { _Pragma("unroll") for (int a_ = 0; a_ < 2; ++a_) _Pragma("unroll") for (int b_ = 0; b_ < 2; ++b_) _Pragma("unroll") for (int m_ = 0; m_ < 4; ++m_) _Pragma("unroll") for (int n_ = 0; n_ < 2; ++n_) acc[a_][b_][m_][n_] = (f32x4){0.f, 0.f, 0.f, 0.f}; } while (0)
    ZACC();
    bf16x8 At[4][2], B0[2][2], B1[2][2];
    STAGE(SB(0, 0), cB, voff); STAGE(SB(0, 1), cB + hstep, voff); STAGE(SA(0, 0), cA, voffF); STAGE(SA(0, 1), cA + hstep, voff);
    if (wr == 1) BAR;
    WAIT_V(2); BAR;
    STAGE(SB(1, 0), cB + kstep, voff); STAGE(SA(1, 0), cA + kstep, voffF); STAGE(SB(1, 1), cB + hstep + kstep, voff);
    WAIT_V(6); BAR;
    for (;;) {
        const int itn = it + G; const bool has_next = itn < nbig;
        int pmn = pm, pnn = pn; if (has_next) tile_order(itn, nM, nN, pmn, pnn);
        const char* nA = (const char*)A + (size_t)pmn * tstep; const char* nB = (const char*)Bt + (size_t)pnn * tstep;
        if (FIX) {
#pragma unroll
            for (int i = 0; i < 2; ++i) { voffFn[i] = voff[i]; if (sR[i] < 2) voffFn[i] = (unsigned)(((const char*)(fixbase + (size_t)(has_next ? itn : it) * 2 * K) - nA) + (long)(sR[i] * K + sC[i]) * 2); }
        }
        for (int t = 0; t < nt; t += 2) {
            const bool last = (t == nt - 2);
            const char* a1 = cA + (size_t)(t + 1) * kstep;
            const char* a2 = last ? nA : cA + (size_t)(t + 2) * kstep; const char* b2 = last ? nB : cB + (size_t)(t + 2) * kstep;
            const char* a3 = a2 + kstep; const char* b3 = b2 + kstep;
            unsigned vF2[2];
#pragma unroll
            for (int i = 0; i < 2; ++i) vF2[i] = FIX ? (last ? voffFn[i] : voffF[i]) : voff[i];
            LDB(B0, 0, 0); LDB(B1, 0, 1); SCHED; LDA(At, 0, 0); STAGE(SA(1, 1), a1 + hstep, voff);
            WAIT_V(8); WAIT_L(0); BAR; MMA(0, 0, At, B0); MMA(0, 1, At, B1); BAR; SCHED;
            LDA(At, 0, 1); STAGE(SB(0, 0), b2, voff); STAGE(SB(0, 1), b2 + hstep, voff); STAGE(SA(0, 0), a2, vF2);
            WAIT_V(8); WAIT_L(0); BAR; MMA(1, 0, At, B0); MMA(1, 1, At, B1); BAR; SCHED;
            LDB(B0, 1, 0); LDB(B1, 1, 1); SCHED; LDA(At, 1, 0); STAGE(SA(0, 1), a2 + hstep, voff);
            WAIT_V(8); WAIT_L(0); BAR; MMA(0, 0, At, B0); MMA(0, 1, At, B1); BAR; SCHED;
            LDA(At, 1, 1); STAGE(SB(1, 0), b3, voff); STAGE(SB(1, 1), b3 + hstep, voff); STAGE(SA(1, 0), a3, vF2);
            WAIT_V(8); WAIT_L(0); BAR; MMA(1, 0, At, B0); MMA(1, 1, At, B1); BAR; SCHED;
        }
        if (wr == 0) BAR;
        asm volatile("" ::: "memory");
        epi(acc, pm, pn, pm * BM, pn * BM, wr, wc, fr, fq);
        if (!has_next) { asm volatile("s_waitcnt vmcnt(0)" ::: "memory"); break; }
        ZACC();
        it = itn; pm = pmn; pn = pnn; cA = nA; cB = nB;
        if (FIX) { voffF[0] = voffFn[0]; voffF[1] = voffFn[1]; }
        if (wr == 1) BAR;
    }
    BAR;
#undef SA
#undef SB
#undef STAGE
#undef LDA
#undef LDB
#undef MMA
#undef ZACC
}

struct NoRowFn { DEV void operator()(int, float) const {} };
template <int RB, int NBLK, int U, class Epi, class RowFn = NoRowFn>
DEV void skinny_tile(const bf16_t* __restrict__ A, const int lda, const bf16_t* __restrict__ B0, const bf16_t* __restrict__ B1, const int K, Epi&& epi, RowFn&& rowfn = NoRowFn(), const int ldb_ = 0) {
    const int ldb = ldb_ ? ldb_ : K;
    float* red = (float*)shm_raw;
    const int tid = TIDX(), w = tid >> 6, lane = tid & 63, fr = lane & 15, fq = lane >> 4;
    constexpr int KG = (NBLK == 2) ? 4 : 8;
    const int kg = (NBLK == 2) ? (w & 3) : w, nb = (NBLK == 2) ? (w >> 2) : 0;
    const bf16_t* Bp = (nb ? B1 : B0) + (long)fr * ldb + fq * 8;
    const bf16_t* Ap = A + (long)fr * lda + fq * 8;
    const int kper = K / KG, kbeg = kg * kper, kend = kbeg + kper;
    f32x4 acc[RB];
#pragma unroll
    for (int rb = 0; rb < RB; ++rb) acc[rb] = (f32x4){0.f, 0.f, 0.f, 0.f};
    int k = kbeg;
    for (; k + 32 * U <= kend; k += 32 * U) {
        bf16x8 b[U], a[U][RB];
#pragma unroll
        for (int u = 0; u < U; ++u) {
            b[u] = *(const bf16x8*)(Bp + k + 32 * u);
#pragma unroll
            for (int rb = 0; rb < RB; ++rb) a[u][rb] = *(const bf16x8*)(Ap + (long)rb * 16 * lda + k + 32 * u);
        }
#pragma unroll
        for (int u = 0; u < U; ++u)
#pragma unroll
            for (int rb = 0; rb < RB; ++rb) acc[rb] = __builtin_amdgcn_mfma_f32_16x16x32_bf16(b[u], a[u][rb], acc[rb], 0, 0, 0);
    }
    for (; k < kend; k += 32) {
        const bf16x8 b = *(const bf16x8*)(Bp + k);
        bf16x8 a[RB];
#pragma unroll
        for (int rb = 0; rb < RB; ++rb) a[rb] = *(const bf16x8*)(Ap + (long)rb * 16 * lda + k);
#pragma unroll
        for (int rb = 0; rb < RB; ++rb) acc[rb] = __builtin_amdgcn_mfma_f32_16x16x32_bf16(b, a[rb], acc[rb], 0, 0, 0);
    }
    f32x4* r4 = (f32x4*)red;
#pragma unroll
    for (int rb = 0; rb < RB; ++rb) r4[(w * RB + rb) * 64 + lane] = acc[rb];
    __syncthreads();
    for (int e = tid; e < RB * 256; e += 512) {
        const int row = e >> 4, s = e & 15, rb = row >> 4, l2 = (row & 15) + 16 * (s >> 2), r = s & 3;
        float v0 = 0.f, v1 = 0.f;
        if (NBLK == 2) {
#pragma unroll
            for (int g = 0; g < 4; ++g) { v0 += red[((g * RB + rb) * 64 + l2) * 4 + r]; v1 += red[(((4 + g) * RB + rb) * 64 + l2) * 4 + r]; }
        } else {
#pragma unroll
            for (int g = 0; g < 8; ++g) v0 += red[((g * RB + rb) * 64 + l2) * 4 + r];
        }
        float ss = epi(row, s, v0, v1);
        ss += __shfl_xor(ss, 1); ss += __shfl_xor(ss, 2); ss += __shfl_xor(ss, 4); ss += __shfl_xor(ss, 8);
        if (s == 0) rowfn(row, ss);
    }
    __syncthreads();
}

template <class RowMap>
DEV void transpose_tile(const float* __restrict__ src, const int N, const int K, const int k0, const int c0, bf16_t* __restrict__ dst, RowMap&& rowmap) {
    float* lds = (float*)shm_raw;
    const int tid = TIDX();
#pragma unroll
    for (int i = 0; i < 2; ++i) {
        const int idx = tid * 4 + i * 2048, kk = idx >> 6, cc = idx & 63;
        const f32x4 v = *(const f32x4*)(src + (size_t)(k0 + kk) * N + c0 + cc);
        lds[kk * 65 + cc] = v.x; lds[kk * 65 + cc + 1] = v.y; lds[kk * 65 + cc + 2] = v.z; lds[kk * 65 + cc + 3] = v.w;
    }
    __syncthreads();
    {
        const int c = tid >> 3, ks = (tid & 7) * 8;
        float f[8];
#pragma unroll
        for (int e = 0; e < 8; ++e) f[e] = lds[(ks + e) * 65 + c];
        *(u32x4*)(dst + (size_t)rowmap(c0 + c) * K + k0 + ks) = pack8(f);
    }
    __syncthreads();
}

DEV void phase_prep(const Params& p) {
    unsigned char* ws = p.ws;
    bf16_t* BtIn = (bf16_t*)(ws + W_BTIN); bf16_t* BtOut = (bf16_t*)(ws + W_BTOUT); bf16_t* BtUp = (bf16_t*)(ws + W_BTUP);
    bf16_t* BtDown = (bf16_t*)(ws + W_BTDOWN); bf16_t* BtAda = (bf16_t*)(ws + W_KVT); bf16_t* WrT = (bf16_t*)(ws + W_WRT);
    constexpr int T_IN = 16 * 48, T_OUT = 16 * 16, T_UP = 16 * 44, T_DOWN = 44 * 16, T_ADA = 16 * 96, T_G = 16;
    constexpr int T_ALL = T_IN + T_OUT + 2 * T_UP + T_DOWN + T_ADA + T_G;
    for (int it = BIDX(); it < T_ALL; it += gridDim.x) {
        int r = it;
        if (r < T_ADA) { transpose_tile(p.w_ada, 6144, 1024, (r / 96) * 64, (r % 96) * 64, BtAda, [](int c) { return permpos(c); }); continue; } r -= T_ADA;
        if (r < T_IN) { transpose_tile(p.w_in, DP, 1024, (r / 48) * 64, (r % 48) * 64, BtIn, [](int c) { return permpos(c); }); continue; } r -= T_IN;
        if (r < T_OUT) { transpose_tile(p.w_out, D, 1024, (r / 16) * 64, (r % 16) * 64, BtOut, [](int c) { return permpos(c); }); continue; } r -= T_OUT;
        if (r < T_UP) { transpose_tile(p.w_upc, DFF, 1024, (r / 44) * 64, (r % 44) * 64, BtUp, [](int c) { return 256 * (c >> 7) + permpos(c & 127); }); continue; } r -= T_UP;
        if (r < T_UP) { transpose_tile(p.w_upg, DFF, 1024, (r / 44) * 64, (r % 44) * 64, BtUp, [](int c) { return 256 * (c >> 7) + 128 + permpos(c & 127); }); continue; } r -= T_UP;
        if (r < T_DOWN) { transpose_tile(p.w_down, D, DFF, (r / 16) * 64, (r % 16) * 64, BtDown, [](int c) { return permpos(c); }); continue; } r -= T_DOWN;
        { const int g = r >> 3, jb = r & 7; transpose_tile((g ? p.w_i : p.w_r) + jb * 4096, 64, 64, 0, 0, WrT + (g * 8 + jb) * 4096, [](int c) { return c; }); }
    }
    const int gt = BIDX() * 512 + TIDX(), GT = gridDim.x * 512;
    bf16_t* modA = (bf16_t*)(ws + W_MODA);
    for (int i = gt; i < NMODROWS * D; i += GT) {
        const int row = i >> 10, k = i & 1023;
        float v = 0.f;
        if (row < 8) v = siluf_(p.c_p[row * D + k]); else if (row < 136) v = siluf_(p.c_s[(row - 8) * D + k]);
        modA[i] = f2bf(v);
    }
    float* rope = (float*)(ws + W_ROPE);
    for (int i = gt; i < (TSEQ + 1) * 64; i += GT) {
        const int t = i >> 6, j = i & 63;
        const float pos = (t < TSEQ) ? (float)t : (float)PAST_LEN;
        const float invf = exp2f(-(float)(2 * j) * (13.287712379549449f / 128.f));
        const float ang = pos * invf;
        float s, c; sincosf(ang, &s, &c);
        rope[t * 128 + j] = c; rope[t * 128 + 64 + j] = s;
    }
    float* rss1 = (float*)(ws + W_RSS1); float* rss2 = (float*)(ws + W_RSS2); float* spl = (float*)(ws + W_SPL);
    for (int i = gt; i < NROWS; i += GT) { rss1[i] = 0.f; rss2[i] = 0.f; }
    for (int i = gt; i < 512; i += GT) spl[i] = 8.f * log1pf(__expf(-p.lam[i]));
}

DEV void phase_mod(const Params& p) {
    unsigned char* ws = p.ws;
    const bf16_t* modA = (const bf16_t*)(ws + W_MODA); const bf16_t* BtAda = (const bf16_t*)(ws + W_KVT); float* mod = (float*)(ws + W_MOD);
    for (int it = BIDX(); it < 256; it += gridDim.x) {
        if (it < 128) {
            const int g = it >> 1, n = it & 1;
            const bf16_t* B0 = BtAda + (size_t)(32 * g + 16 * n) * D;
            skinny_tile<9, 1, 4>(modA, D, B0, B0, D, [&](int row, int s, float v0, float v1) {
                if (row < 136) { const int c0 = 32 * g + slotcol(n, s); mod[(size_t)row * 6144 + c0] = v0 + p.b_ada[c0]; }
                return 0.f;
            });
        } else {
            const int g = 64 + (it - 128);
            const bf16_t* B0 = BtAda + (size_t)(32 * g) * D;
            skinny_tile<9, 2, 4>(modA, D, B0, B0 + 16 * D, D, [&](int row, int s, float v0, float v1) {
                if (row < 136) { const int c0 = 32 * g + slotcol(0, s), c1 = c0 + 4; mod[(size_t)row * 6144 + c0] = v0 + p.b_ada[c0]; mod[(size_t)row * 6144 + c1] = v1 + p.b_ada[c1]; }
                return 0.f;
            });
        }
    }
}

DEV void phase_norm1(const Params& p) {
    unsigned char* ws = p.ws;
    const float* mod = (const float*)(ws + W_MOD); bf16_t* H = (bf16_t*)(ws + W_H); bf16_t* shf = (bf16_t*)(ws + W_SHF);
    const int lane = TIDX() & 63, gw = BIDX() * 8 + (TIDX() >> 6), NGW = gridDim.x * 8;
    for (int row = gw; row < NROWS; row += NGW) {
        const float* xr = (row < NTOK) ? p.x_p + (size_t)row * D : p.x_s + (size_t)(row - NTOK) * D;
        const int b = (row < NTOK) ? (row >> 11) : 8 + (row - NTOK);
        const float* mrow = mod + (size_t)b * 6144;
        f32x4 v[4]; float ss = 0.f;
#pragma unroll
        for (int j = 0; j < 4; ++j) { v[j] = *(const f32x4*)(xr + 4 * lane + 256 * j); ss += v[j].x * v[j].x + v[j].y * v[j].y + v[j].z * v[j].z + v[j].w * v[j].w; }
        const float rstd = __builtin_amdgcn_rsqf(wave_sum(ss) * (1.f / D) + EPS);
#pragma unroll
        for (int j = 0; j < 4; ++j) {
            const int k = 4 * lane + 256 * j;
            const f32x4 g = *(const f32x4*)(p.g_mix + k), sh = *(const f32x4*)(mrow + k), sc = *(const f32x4*)(mrow + D + k);
            const f32x4 h = v[j] * rstd * g * (1.f + sc) + sh;
            u32x2 o; o.x = cvt_pk_bf16(h.x, h.y); o.y = cvt_pk_bf16(h.z, h.w);
            *(u32x2*)(H + (size_t)row * D + k) = o;
        }
    }
}

DEV void phase_inproj(const Params& p) {
    unsigned char* ws = p.ws;
    const bf16_t* H = (const bf16_t*)(ws + W_H); const bf16_t* BtIn = (const bf16_t*)(ws + W_BTIN); bf16_t* proj = (bf16_t*)(ws + W_PROJ);
    float* projS = (float*)(ws + W_PROJS);
    constexpr int NBIG = 64 * 12, NSK1 = 96;
    gemm_phase<false>(H, BtIn, D, 64, 12, NBIG, nullptr, [&](const f32x4 (&acc)[2][2][4][2], int pm, int pn, int brow, int bcol, int wr, int wc, int fr, int fq) {
#pragma unroll
        for (int ai = 0; ai < 2; ++ai)
#pragma unroll
            for (int m = 0; m < 4; ++m) {
                bf16_t* rp = proj + (size_t)(brow + ai * HALF + wr * 64 + m * 16 + fr) * DP + bcol + wc * 32 + 8 * fq;
#pragma unroll
                for (int bj = 0; bj < 2; ++bj) {
                    const f32x4 a = acc[ai][bj][m][0], b = acc[ai][bj][m][1];
                    u32x4 w; w.x = cvt_pk_bf16(a[0], a[1]); w.y = cvt_pk_bf16(a[2], a[3]); w.z = cvt_pk_bf16(b[0], b[1]); w.w = cvt_pk_bf16(b[2], b[3]);
                    *(u32x4*)(rp + bj * HALF) = w;
                }
            }
    });
    const bf16_t* modA = (const bf16_t*)(ws + W_MODA); const bf16_t* BtAda = (const bf16_t*)(ws + W_KVT); float* mod = (float*)(ws + W_MOD);
    SKINNY_LOOP(j, NBIG, 2 * NSK1) {
        const int g = j >> 1, n = j & 1;
        const bf16_t* B0 = BtIn + (size_t)(32 * g + 16 * n) * D;
        skinny_tile<8, 1, 4>(H + (size_t)NTOK * D, D, B0, B0, D, [&](int row, int s, float v0, float v1) {
            projS[row * DP + 32 * g + slotcol(n, s)] = v0; return 0.f;
        });
    }
}

constexpr int RP = 136;
DEV void rot8(const float* x1, const float* x2, const float* tr, int d0, float scale, float* o1, float* o2) {
    const f32x4 c0 = *(const f32x4*)(tr + d0), c1 = *(const f32x4*)(tr + d0 + 4), s0 = *(const f32x4*)(tr + 64 + d0), s1 = *(const f32x4*)(tr + 64 + d0 + 4);
    const float c[8] = {c0.x, c0.y, c0.z, c0.w, c1.x, c1.y, c1.z, c1.w}, s[8] = {s0.x, s0.y, s0.z, s0.w, s1.x, s1.y, s1.z, s1.w};
#pragma unroll
    for (int e = 0; e < 8; ++e) { o1[e] = (x1[e] * c[e] - x2[e] * s[e]) * scale; o2[e] = (x1[e] * s[e] + x2[e] * c[e]) * scale; }
}

DEV void rot8v(const u32x4 a, const u32x4 b, const f32x4 c0, const f32x4 c1, const f32x4 s0, const f32x4 s1, float scale, float* o1, float* o2) {
    float x1[8], x2[8]; unpack8(a, x1); unpack8(b, x2);
    const float c[8] = {c0.x, c0.y, c0.z, c0.w, c1.x, c1.y, c1.z, c1.w}, s[8] = {s0.x, s0.y, s0.z, s0.w, s1.x, s1.y, s1.z, s1.w};
#pragma unroll
    for (int e = 0; e < 8; ++e) { o1[e] = (x1[e] * c[e] - x2[e] * s[e]) * scale; o2[e] = (x1[e] * s[e] + x2[e] * c[e]) * scale; }
}
DEV void scatter_vT(const u32x4 w, int j, int d0, bf16_t* vT) {
    const unsigned ww[4] = {w.x, w.y, w.z, w.w};
#pragma unroll
    for (int e = 0; e < 4; ++e) { vT[(d0 + 2 * e) * RP + j] = (bf16_t)(ww[e] & 0xffffu); vT[(d0 + 2 * e + 1) * RP + j] = (bf16_t)(ww[e] >> 16); }
}
DEV void stage_vT(const bf16_t* proj, int row0, int h, bf16_t* vT) {
    for (int item = TIDX(); item < 2048; item += 512) {
        const int j = item >> 4, d0 = (item & 15) * 8;
        const u32x4 w = *(const u32x4*)(proj + (size_t)(row0 + j) * DP + 1024 + h * 128 + d0);
        const unsigned ww[4] = {w.x, w.y, w.z, w.w};
#pragma unroll
        for (int e = 0; e < 4; ++e) { vT[(d0 + 2 * e) * RP + j] = (bf16_t)(ww[e] & 0xffffu); vT[(d0 + 2 * e + 1) * RP + j] = (bf16_t)(ww[e] >> 16); }
    }
}

DEV void ret_passA(const Params& p, int unit) {
    unsigned char* ws = p.ws;
    const bf16_t* proj = (const bf16_t*)(ws + W_PROJ); const float* rope = (const float*)(ws + W_ROPE); float* KVT = (float*)(ws + W_KVT) + (size_t)unit * 16384;
    const int n = unit & 15, h = (unit >> 4) & 3, b = unit >> 6, row0 = b * TSEQ + n * 128;
    bf16_t* kT = (bf16_t*)shm_raw; bf16_t* vT = kT + 128 * RP;
    const float lg = gamma_log2(h);
    {
        const int tid = TIDX();
        u32x4 kA[2], kB[2], vv[4]; f32x4 rc[2][4];
#pragma unroll
        for (int i = 0; i < 2; ++i) {
            const int item = tid + 512 * i, j = item >> 3, d0 = (item & 7) * 8;
            const bf16_t* kr = proj + (size_t)(row0 + j) * DP + 512 + h * 128; const float* tr = rope + (size_t)(n * 128 + j) * 128;
            kA[i] = *(const u32x4*)(kr + d0); kB[i] = *(const u32x4*)(kr + 64 + d0);
            rc[i][0] = *(const f32x4*)(tr + d0); rc[i][1] = *(const f32x4*)(tr + d0 + 4); rc[i][2] = *(const f32x4*)(tr + 64 + d0); rc[i][3] = *(const f32x4*)(tr + 64 + d0 + 4);
        }
#pragma unroll
        for (int i = 0; i < 4; ++i) { const int item = tid + 512 * i, j = item >> 4, d0 = (item & 15) * 8; vv[i] = *(const u32x4*)(proj + (size_t)(row0 + j) * DP + 1024 + h * 128 + d0); }
#pragma unroll
        for (int i = 0; i < 2; ++i) {
            const int item = tid + 512 * i, j = item >> 3, d0 = (item & 7) * 8;
            float o1[8], o2[8];
            rot8v(kA[i], kB[i], rc[i][0], rc[i][1], rc[i][2], rc[i][3], 0.08838834764831845f * fexp2(lg * (float)(127 - j)), o1, o2);
#pragma unroll
            for (int e = 0; e < 8; ++e) { kT[(d0 + e) * RP + j] = f2bf(o1[e]); kT[(64 + d0 + e) * RP + j] = f2bf(o2[e]); }
        }
#pragma unroll
        for (int i = 0; i < 4; ++i) { const int item = tid + 512 * i; scatter_vT(vv[i], item >> 4, (item & 15) * 8, vT); }
    }
    __syncthreads();
    const int w = TIDX() >> 6, lane = TIDX() & 63, fr = lane & 15, fq = lane >> 4;
    f32x4 acc[8];
#pragma unroll
    for (int vb = 0; vb < 8; ++vb) acc[vb] = (f32x4){0.f, 0.f, 0.f, 0.f};
#pragma unroll
    for (int ks = 0; ks < 4; ++ks) {
        const bf16x8 a = *(const bf16x8*)(kT + (16 * w + fr) * RP + 32 * ks + 8 * fq);
#pragma unroll
        for (int vb = 0; vb < 8; ++vb) {
            const bf16x8 bb = *(const bf16x8*)(vT + (16 * vb + fr) * RP + 32 * ks + 8 * fq);
            acc[vb] = __builtin_amdgcn_mfma_f32_16x16x32_bf16(a, bb, acc[vb], 0, 0, 0);
        }
    }
#pragma unroll
    for (int vb = 0; vb < 8; ++vb) *(f32x4*)(KVT + (16 * vb + fr) * 128 + 16 * w + 4 * fq) = acc[vb];
    __syncthreads();
}

DEV void ret_passC(const Params& p, int unit) {
    unsigned char* ws = p.ws;
    const bf16_t* proj = (const bf16_t*)(ws + W_PROJ); const float* rope = (const float*)(ws + W_ROPE); bf16_t* mix = (bf16_t*)(ws + W_MIX);
    const int n = unit & 15, h = (unit >> 4) & 3, b = unit >> 6, row0 = b * TSEQ + n * 128;
    bf16_t* ks_ = (bf16_t*)shm_raw; bf16_t* vT = ks_ + 128 * RP; bf16_t* ST = vT + 128 * RP; bf16_t* P = ST + 128 * RP;
    const float lg = gamma_log2(h);
    const int tid = TIDX(), w = tid >> 6, lane = tid & 63, fr = lane & 15, fq = lane >> 4;
    const int i_loc = 16 * w + fr;
    bf16x8 qf[4];
    {
        u32x4 kA[2], kB[2], vv[4], st[4], qA[2], qB[2]; f32x4 rc[2][4], qc[2][4];
#pragma unroll
        for (int i = 0; i < 2; ++i) {
            const int item = tid + 512 * i, j = item >> 3, d0 = (item & 7) * 8;
            const bf16_t* kr = proj + (size_t)(row0 + j) * DP + 512 + h * 128; const float* tr = rope + (size_t)(n * 128 + j) * 128;
            kA[i] = *(const u32x4*)(kr + d0); kB[i] = *(const u32x4*)(kr + 64 + d0);
            rc[i][0] = *(const f32x4*)(tr + d0); rc[i][1] = *(const f32x4*)(tr + d0 + 4); rc[i][2] = *(const f32x4*)(tr + 64 + d0); rc[i][3] = *(const f32x4*)(tr + 64 + d0 + 4);
        }
#pragma unroll
        for (int i = 0; i < 4; ++i) { const int item = tid + 512 * i, j = item >> 4, d0 = (item & 15) * 8; vv[i] = *(const u32x4*)(proj + (size_t)(row0 + j) * DP + 1024 + h * 128 + d0); }
        {
            const int dv = tid >> 2, sg = tid & 3;
            const bf16_t* src = (const bf16_t*)(ws + W_H) + (size_t)unit * 16384 + dv * 128 + sg * 32;
#pragma unroll
            for (int i = 0; i < 4; ++i) st[i] = *(const u32x4*)(src + 8 * i);
        }
        {
            const bf16_t* qr = proj + (size_t)(row0 + i_loc) * DP + h * 128; const float* tr = rope + (size_t)(n * 128 + i_loc) * 128;
#pragma unroll
            for (int kk = 0; kk < 2; ++kk) {
                const int d0 = 32 * kk + 8 * fq;
                qA[kk] = *(const u32x4*)(qr + d0); qB[kk] = *(const u32x4*)(qr + 64 + d0);
                qc[kk][0] = *(const f32x4*)(tr + d0); qc[kk][1] = *(const f32x4*)(tr + d0 + 4); qc[kk][2] = *(const f32x4*)(tr + 64 + d0); qc[kk][3] = *(const f32x4*)(tr + 64 + d0 + 4);
            }
        }
#pragma unroll
        for (int i = 0; i < 2; ++i) {
            const int item = tid + 512 * i, j = item >> 3, d0 = (item & 7) * 8;
            float o1[8], o2[8];
            rot8v(kA[i], kB[i], rc[i][0], rc[i][1], rc[i][2], rc[i][3], 0.08838834764831845f, o1, o2);
            *(u32x4*)(ks_ + j * RP + d0) = pack8(o1); *(u32x4*)(ks_ + j * RP + 64 + d0) = pack8(o2);
        }
#pragma unroll
        for (int i = 0; i < 4; ++i) { const int item = tid + 512 * i; scatter_vT(vv[i], item >> 4, (item & 15) * 8, vT); }
        {
            const int dv = tid >> 2, sg = tid & 3;
#pragma unroll
            for (int i = 0; i < 4; ++i) *(u32x4*)(ST + dv * RP + sg * 32 + 8 * i) = st[i];
        }
#pragma unroll
        for (int kk = 0; kk < 2; ++kk) {
            float o1[8], o2[8];
            rot8v(qA[kk], qB[kk], qc[kk][0], qc[kk][1], qc[kk][2], qc[kk][3], 1.f, o1, o2);
            const u32x4 a = pack8(o1), c = pack8(o2);
            qf[kk] = __builtin_bit_cast(bf16x8, a); qf[kk + 2] = __builtin_bit_cast(bf16x8, c);
        }
    }
    __syncthreads();
#pragma unroll
    for (int jb = 0; jb < 8; ++jb) {
        u32x2 o; o.x = 0u; o.y = 0u;
        if (jb <= w) {
            f32x4 sc = (f32x4){0.f, 0.f, 0.f, 0.f};
#pragma unroll
            for (int kk = 0; kk < 4; ++kk) {
                const bf16x8 a = *(const bf16x8*)(ks_ + (16 * jb + fr) * RP + 32 * kk + 8 * fq);
                sc = __builtin_amdgcn_mfma_f32_16x16x32_bf16(a, qf[kk], sc, 0, 0, 0);
            }
            float pv[4];
#pragma unroll
            for (int r = 0; r < 4; ++r) { const int dj = i_loc - (16 * jb + 4 * fq + r); pv[r] = dj >= 0 ? sc[r] * fexp2(lg * (float)dj) : 0.f; }
            o.x = cvt_pk_bf16(pv[0], pv[1]); o.y = cvt_pk_bf16(pv[2], pv[3]);
        }
        *(u32x2*)(P + i_loc * RP + 16 * jb + 4 * fq) = o;
    }
    __syncthreads();
    f32x4 a1[8], a2[8];
#pragma unroll
    for (int vb = 0; vb < 8; ++vb) { a1[vb] = (f32x4){0.f, 0.f, 0.f, 0.f}; a2[vb] = (f32x4){0.f, 0.f, 0.f, 0.f}; }
    for (int kk = 0; kk <= (w >> 1); ++kk) {
        const bf16x8 pb = *(const bf16x8*)(P + i_loc * RP + 32 * kk + 8 * fq);
#pragma unroll
        for (int vb = 0; vb < 8; ++vb) {
            const bf16x8 a = *(const bf16x8*)(vT + (16 * vb + fr) * RP + 32 * kk + 8 * fq);
            a1[vb] = __builtin_amdgcn_mfma_f32_16x16x32_bf16(a, pb, a1[vb], 0, 0, 0);
        }
    }
#pragma unroll
    for (int kk = 0; kk < 4; ++kk) {
#pragma unroll
        for (int vb = 0; vb < 8; ++vb) {
            const bf16x8 a = *(const bf16x8*)(ST + (16 * vb + fr) * RP + 32 * kk + 8 * fq);
            a2[vb] = __builtin_amdgcn_mfma_f32_16x16x32_bf16(a, qf[kk], a2[vb], 0, 0, 0);
        }
    }
    const float qd = fexp2(lg * (float)(i_loc + 1));
    float sum = 0.f;
#pragma unroll
    for (int vb = 0; vb < 8; ++vb) { a1[vb] = a1[vb] + qd * a2[vb]; sum += (a1[vb].x + a1[vb].y) + (a1[vb].z + a1[vb].w); }
    sum += __shfl_xor(sum, 16); sum += __shfl_xor(sum, 32);
    const float mu = sum * (1.f / 128.f);
    float var = 0.f;
#pragma unroll
    for (int vb = 0; vb < 8; ++vb) { const f32x4 d = a1[vb] - mu; var += (d.x * d.x + d.y * d.y) + (d.z * d.z + d.w * d.w); }
    var += __shfl_xor(var, 16); var += __shfl_xor(var, 32);
    const float rstd = __builtin_amdgcn_rsqf(var * (1.f / 128.f) + EPS);
    const bf16_t* gr = proj + (size_t)(row0 + i_loc) * DP + 1536 + h * 128 + 4 * fq;
    bf16_t* orow = mix + (size_t)(row0 + i_loc) * D + h * 128 + 4 * fq;
    u32x2 gg[8];
#pragma unroll
    for (int vb = 0; vb < 8; ++vb) gg[vb] = *(const u32x2*)(gr + 16 * vb);
#pragma unroll
    for (int vb = 0; vb < 8; ++vb) {
        const u32x2 g = gg[vb];
        const f32x4 d = (a1[vb] - mu) * rstd;
        u32x2 o; o.x = cvt_pk_bf16(d.x * siluf_(bflo(g.x)), d.y * siluf_(bfhi(g.x))); o.y = cvt_pk_bf16(d.z * siluf_(bflo(g.y)), d.w * siluf_(bfhi(g.y)));
        *(u32x2*)(orow + 16 * vb) = o;
    }
    __syncthreads();
}

#define LBAR() do { asm volatile("s_waitcnt lgkmcnt(0)" ::: "memory"); __builtin_amdgcn_s_barrier(); asm volatile("" ::: "memory"); } while (0)
template <bool FINAL>
DEV void lru_phase(const Params& p) {
    unsigned char* ws = p.ws;
    const bf16_t* proj = (const bf16_t*)(ws + W_PROJ); bf16_t* mix = (bf16_t*)(ws + W_MIX); const bf16_t* WrT = (const bf16_t*)(ws + W_WRT);
    const float* spl = (const float*)(ws + W_SPL); float* agg = (float*)(ws + W_AGG); const float* hin0g = (const float*)(ws + W_HIN0);
    float* xcf = (float*)shm_raw;
    constexpr int XP = 68;
    float* af = xcf + 128 * XP;
    bf16_t* xcb = (bf16_t*)(af + 128 * XP);
    float* segA = (float*)(xcb + 128 * 72);
    float* segB = segA + 512;
    float* hin = segB + 512;
    bf16_t* wT = (bf16_t*)(hin + 512);
    float* cwL = (float*)(wT + 2 * 64 * 72);
    bf16_t* gbuf = (bf16_t*)(cwL + 8 * 64);
    const int tid = TIDX(), w = tid >> 6, lane = tid & 63, fr = lane & 15, fq = lane >> 4;
    const int tt = tid >> 2, e0 = (tid & 3) * 16;
    int key = -1;
    u32x4 xr[4][2]; u32x4 gr[2]; float h0 = 0.f;
    auto prefetch = [&](int unit) {
        const int c = unit & 15, jb = (unit >> 4) & 7, b = unit >> 7, ch0 = 64 * jb;
#pragma unroll
        for (int k = 0; k < 4; ++k) {
            const int tabs = c * 128 + tt - 3 + k;
            xr[k][0] = (u32x4){0u, 0u, 0u, 0u}; xr[k][1] = xr[k][0];
            if (tabs >= 0) { const bf16_t* xp = proj + (size_t)(b * TSEQ + tabs) * DP + 2048 + ch0 + e0; xr[k][0] = *(const u32x4*)xp; xr[k][1] = *(const u32x4*)(xp + 8); }
        }
        if (FINAL) {
            const bf16_t* gp = proj + (size_t)(b * TSEQ + c * 128 + tt) * DP + 2560 + ch0 + e0; gr[0] = *(const u32x4*)gp; gr[1] = *(const u32x4*)(gp + 8);
            if (tid < 64) h0 = hin0g[(size_t)unit * 64 + tid];
        }
    };
    int it = BIDX();
    if (it < 1024) prefetch(it);
    for (; it < 1024; it += gridDim.x) {
        const int unit = it, c = unit & 15, jb = (unit >> 4) & 7, b = unit >> 7, row0 = b * TSEQ + c * 128, ch0 = 64 * jb;
        if ((unit & 127) != key) {
            key = unit & 127;
            { const int g = tid >> 8, e = (tid >> 2) & 63, sg = tid & 3; const bf16_t* src = WrT + (size_t)((g * 8 + jb) * 64 + e) * 64 + sg * 16;
              *(u32x4*)(wT + (g * 64 + e) * 72 + sg * 16) = *(const u32x4*)src; *(u32x4*)(wT + (g * 64 + e) * 72 + sg * 16 + 8) = *(const u32x4*)(src + 8); }
            { const int q = tid >> 6, e = tid & 63; float v;
              if (q < 4) v = p.cl_w[q * DLRU + ch0 + e]; else if (q == 4) v = p.cl_b[ch0 + e]; else if (q == 5) v = p.b_r[ch0 + e]; else if (q == 6) v = p.b_i[ch0 + e]; else v = spl[ch0 + e];
              cwL[q * 64 + e] = v; }
            LBAR();
        }
        {
            float accv[16];
#pragma unroll
            for (int i = 0; i < 4; ++i) { const f32x4 cb = *(const f32x4*)(cwL + 4 * 64 + e0 + 4 * i); accv[4 * i] = cb.x; accv[4 * i + 1] = cb.y; accv[4 * i + 2] = cb.z; accv[4 * i + 3] = cb.w; }
#pragma unroll
            for (int k = 0; k < 4; ++k) {
                float xv[16]; unpack8(xr[k][0], xv); unpack8(xr[k][1], xv + 8);
#pragma unroll
                for (int i = 0; i < 4; ++i) { const f32x4 cw = *(const f32x4*)(cwL + k * 64 + e0 + 4 * i);
                    accv[4 * i] += cw.x * xv[4 * i]; accv[4 * i + 1] += cw.y * xv[4 * i + 1]; accv[4 * i + 2] += cw.z * xv[4 * i + 2]; accv[4 * i + 3] += cw.w * xv[4 * i + 3]; }
            }
#pragma unroll
            for (int i = 0; i < 4; ++i) *(f32x4*)(xcf + tt * XP + e0 + 4 * i) = (f32x4){accv[4 * i], accv[4 * i + 1], accv[4 * i + 2], accv[4 * i + 3]};
            *(u32x4*)(xcb + tt * 72 + e0) = pack8(accv); *(u32x4*)(xcb + tt * 72 + e0 + 8) = pack8(accv + 8);
            if (FINAL) { *(u32x4*)(gbuf + tt * 64 + e0) = gr[0]; *(u32x4*)(gbuf + tt * 64 + e0 + 8) = gr[1]; }
        }
        const float h0u = h0;
        if (it + (int)gridDim.x < 1024) prefetch(it + gridDim.x);
        LBAR();
        {
            const int t = 16 * w + fr;
            bf16x8 xb[2];
#pragma unroll
            for (int kk = 0; kk < 2; ++kk) xb[kk] = *(const bf16x8*)(xcb + t * 72 + 32 * kk + 8 * fq);
            const bool first = (c == 0 && t == 0);
#pragma unroll
            for (int eb = 0; eb < 4; ++eb) {
                f32x4 ar = (f32x4){0.f, 0.f, 0.f, 0.f}, ai = (f32x4){0.f, 0.f, 0.f, 0.f};
#pragma unroll
                for (int kk = 0; kk < 2; ++kk) {
                    const bf16x8 wr_ = *(const bf16x8*)(wT + (16 * eb + fr) * 72 + 32 * kk + 8 * fq);
                    const bf16x8 wi_ = *(const bf16x8*)(wT + (64 + 16 * eb + fr) * 72 + 32 * kk + 8 * fq);
                    ar = __builtin_amdgcn_mfma_f32_16x16x32_bf16(wr_, xb[kk], ar, 0, 0, 0);
                    ai = __builtin_amdgcn_mfma_f32_16x16x32_bf16(wi_, xb[kk], ai, 0, 0, 0);
                }
                const int e = 16 * eb + 4 * fq;
                const f32x4 br = *(const f32x4*)(cwL + 5 * 64 + e), bi = *(const f32x4*)(cwL + 6 * 64 + e), sp = *(const f32x4*)(cwL + 7 * 64 + e);
                const f32x4 xc4 = *(const f32x4*)(xcf + t * XP + e);
                f32x4 av, bv;
#pragma unroll
                for (int r = 0; r < 4; ++r) {
                    const float rr = sigmoidf_(ar[r] + br[r]), ii = sigmoidf_(ai[r] + bi[r]);
                    const float la = -sp[r] * rr, a = fexp2(1.4426950408889634f * la);
                    const float em = __builtin_fmaf(-a, a, 1.f);
                    const float mult = first ? 1.f : __builtin_amdgcn_sqrtf(em);
                    av[r] = a; bv[r] = mult * ii * xc4[r];
                }
                *(f32x4*)(af + t * XP + e) = av; *(f32x4*)(xcf + t * XP + e) = bv;
            }
        }
        LBAR();
        const int e = tid & 63, seg = tid >> 6;
        {
            float A = 1.f, B = 0.f;
#pragma unroll
            for (int i = 0; i < 16; ++i) { const int t = seg * 16 + i; const float a = af[t * XP + e]; B = a * B + xcf[t * XP + e]; A *= a; }
            segA[seg * 64 + e] = A; segB[seg * 64 + e] = B;
        }
        LBAR();
        if (!FINAL) {
            if (tid < 64) {
                float A = 1.f, B = 0.f;
#pragma unroll
                for (int s = 0; s < 8; ++s) { const float a = segA[s * 64 + tid]; B = a * B + segB[s * 64 + tid]; A *= a; }
                agg[(size_t)unit * 128 + tid] = A; agg[(size_t)unit * 128 + 64 + tid] = B;
            }
        } else {
            if (tid < 64) {
                float hh = h0u;
#pragma unroll
                for (int s = 0; s < 8; ++s) { hin[s * 64 + tid] = hh; hh = segA[s * 64 + tid] * hh + segB[s * 64 + tid]; }
            }
            LBAR();
            float hh = hin[seg * 64 + e];
#pragma unroll
            for (int i = 0; i < 16; ++i) {
                const int t = seg * 16 + i;
                hh = af[t * XP + e] * hh + xcf[t * XP + e];
                gbuf[t * 64 + e] = f2bf(hh * geluf_(bf2f(gbuf[t * 64 + e])));
            }
            if (c == 15 && seg == 7) {
                p.out[O_LHP + b * 512 + ch0 + e] = hh;
#pragma unroll
                for (int k = 0; k < 3; ++k) p.out[O_LCP + (size_t)(b * 3 + k) * 512 + ch0 + e] = bf2f(proj[(size_t)(b * TSEQ + 2045 + k) * DP + 2048 + ch0 + e]);
            }
            LBAR();
            { bf16_t* op = mix + (size_t)(row0 + tt) * D + 512 + ch0 + e0; *(u32x4*)op = *(const u32x4*)(gbuf + tt * 64 + e0); *(u32x4*)(op + 8) = *(const u32x4*)(gbuf + tt * 64 + e0 + 8); }
        }
        LBAR();
    }
    __syncthreads();
}

DEV void phase_scan(const Params& p) {
    unsigned char* ws = p.ws;
    const float* KVT = (const float*)(ws + W_KVT); bf16_t* STg = (bf16_t*)(ws + W_H);
    const float* agg = (const float*)(ws + W_AGG); float* hin0g = (float*)(ws + W_HIN0);
    const int gt = BIDX() * 512 + TIDX(), GT = gridDim.x * 512;
    for (int gid = gt; gid < 32 * 4096; gid += GT) {
        const int bh = gid >> 12, idx = gid & 4095, dv = idx >> 5, dk0 = (idx & 31) * 4, h = bh & 3;
        const float cd = exp2f(gamma_log2(h) * 128.f);
        const float* src = KVT + (size_t)bh * 16 * 16384 + dv * 128 + dk0;
        f32x4 kv[16];
#pragma unroll
        for (int m = 0; m < 16; ++m) kv[m] = *(const f32x4*)(src + (size_t)m * 16384);
        f32x4 S = (f32x4){0.f, 0.f, 0.f, 0.f};
        bf16_t* dst = STg + (size_t)bh * 16 * 16384 + dv * 128 + dk0;
#pragma unroll
        for (int m = 0; m < 16; ++m) {
            u32x2 o; o.x = cvt_pk_bf16(S.x, S.y); o.y = cvt_pk_bf16(S.z, S.w);
            *(u32x2*)(dst + (size_t)m * 16384) = o;
            S = S * cd + kv[m];
        }
        float* rp = p.out + O_RETP + (size_t)bh * 16384 + dv;
        rp[(dk0 + 0) * 128] = S.x; rp[(dk0 + 1) * 128] = S.y; rp[(dk0 + 2) * 128] = S.z; rp[(dk0 + 3) * 128] = S.w;
    }
    for (int gid = gt; gid < 64 * 64; gid += GT) {
        const int bjb = gid >> 6, e = gid & 63;
        float A[16], B[16];
#pragma unroll
        for (int c = 0; c < 16; ++c) { A[c] = agg[(size_t)(bjb * 16 + c) * 128 + e]; B[c] = agg[(size_t)(bjb * 16 + c) * 128 + 64 + e]; }
        float hh = 0.f;
#pragma unroll
        for (int c = 0; c < 16; ++c) { hin0g[(size_t)(bjb * 16 + c) * 64 + e] = hh; hh = A[c] * hh + B[c]; }
    }
}

DEV void sample_ret2(const Params& p, int unit) {
    unsigned char* ws = p.ws;
    const float* projS = (const float*)(ws + W_PROJS); const float* rope = (const float*)(ws + W_ROPE) + (size_t)TSEQ * 128; bf16_t* mix = (bf16_t*)(ws + W_MIX);
    const int h = unit & 3, b = unit >> 2, tid = TIDX();
    float* qs = (float*)shm_raw; float* ks = qs + 128; float* vs = ks + 128; float* part = vs + 128;
    float* red = part + 16 * 128;
    const float* pr = projS + (size_t)b * DP;
    const float gam = 1.f - exp2f(-5.f - (float)h);
    if (tid < 64) {
        const float c = rope[tid], s = rope[64 + tid];
        const float q1 = pr[h * 128 + tid], q2 = pr[h * 128 + 64 + tid], k1 = pr[512 + h * 128 + tid], k2 = pr[512 + h * 128 + 64 + tid];
        const float qa = q1 * c - q2 * s, qb = q1 * s + q2 * c, ka = (k1 * c - k2 * s) * 0.08838834764831845f, kb = (k1 * s + k2 * c) * 0.08838834764831845f;
        qs[tid] = qa; qs[64 + tid] = qb; ks[tid] = ka; ks[64 + tid] = kb;
        const float qkp = wave_sum(qa * ka + qb * kb);
        if (tid == 0) red[4] = qkp;
    } else if (tid < 192) vs[tid - 64] = pr[1024 + h * 128 + tid - 64];
    __syncthreads();
    {
        const int dv4 = (tid & 31) * 4, dkg = tid >> 5;
        const f32x4 v4 = *(const f32x4*)(vs + dv4);
        const float* S0 = p.st_ret + (size_t)unit * 16384; float* S1 = p.out + O_RETS + (size_t)unit * 16384;
        f32x4 po = (f32x4){0.f, 0.f, 0.f, 0.f};
        f32x4 s0[8];
#pragma unroll
        for (int i = 0; i < 8; ++i) s0[i] = *(const f32x4*)(S0 + (dkg * 8 + i) * 128 + dv4);
#pragma unroll
        for (int i = 0; i < 8; ++i) {
            const int dk = dkg * 8 + i;
            *(f32x4*)(S1 + dk * 128 + dv4) = s0[i] * gam + ks[dk] * v4;
            po = po + qs[dk] * s0[i];
        }
        *(f32x4*)(part + dkg * 128 + dv4) = po;
    }
    __syncthreads();
    float o = 0.f;
    if (tid < 128) {
        const float qk = red[4];
#pragma unroll
        for (int g = 0; g < 16; ++g) o += part[g * 128 + tid];
        o = qk * vs[tid] + gam * o;
        const float s1 = wave_sum(o);
        if ((tid & 63) == 0) red[tid >> 6] = s1;
    }
    __syncthreads();
    float mu = 0.f, dlt = 0.f;
    if (tid < 128) {
        mu = (red[0] + red[1]) * (1.f / 128.f); dlt = o - mu;
        const float s2 = wave_sum(dlt * dlt);
        if ((tid & 63) == 0) red[2 + (tid >> 6)] = s2;
    }
    __syncthreads();
    if (tid < 128) {
        const float rstd = __builtin_amdgcn_rsqf((red[2] + red[3]) * (1.f / 128.f) + EPS);
        const float g = pr[1536 + h * 128 + tid];
        mix[(size_t)(NTOK + b) * D + h * 128 + tid] = f2bf(dlt * rstd * siluf_(g));
    }
    __syncthreads();
}

DEV void sample_lru(const Params& p, int b) {
    unsigned char* ws = p.ws;
    const float* projS = (const float*)(ws + W_PROJS); bf16_t* mix = (bf16_t*)(ws + W_MIX); const float* spl = (const float*)(ws + W_SPL);
    float* xcS = (float*)shm_raw;
    const int ch = TIDX();
    const float* pr = projS + (size_t)b * DP;
    const float s0 = p.st_cl[(size_t)(b * 3 + 0) * 512 + ch], s1 = p.st_cl[(size_t)(b * 3 + 1) * 512 + ch], s2 = p.st_cl[(size_t)(b * 3 + 2) * 512 + ch], x = pr[2048 + ch];
    const float xc = p.cl_b[ch] + p.cl_w[ch] * s0 + p.cl_w[512 + ch] * s1 + p.cl_w[1024 + ch] * s2 + p.cl_w[1536 + ch] * x;
    xcS[ch] = xc;
    __syncthreads();
    const int jb = ch >> 6, e = ch & 63;
    float pr_ = 0.f, pi_ = 0.f;
    const float* wr = p.w_r + (size_t)jb * 4096 + e; const float* wi = p.w_i + (size_t)jb * 4096 + e;
#pragma unroll 8
    for (int d = 0; d < 64; ++d) { const float xv = xcS[64 * jb + d]; pr_ += xv * wr[d * 64]; pi_ += xv * wi[d * 64]; }
    const float rr = sigmoidf_(pr_ + p.b_r[ch]), ii = sigmoidf_(pi_ + p.b_i[ch]);
    const float la = -spl[ch] * rr, a = __expf(la), mult = sqrtf(-expm1f(2.f * la));
    const float hh = a * p.st_h[(size_t)b * 512 + ch] + mult * ii * xc;
    p.out[O_LHS + (size_t)b * 512 + ch] = hh;
    p.out[O_LCS + (size_t)(b * 3 + 0) * 512 + ch] = s1; p.out[O_LCS + (size_t)(b * 3 + 1) * 512 + ch] = s2; p.out[O_LCS + (size_t)(b * 3 + 2) * 512 + ch] = x;
    mix[(size_t)(NTOK + b) * D + 512 + ch] = f2bf(hh * geluf_(pr[2560 + ch]));
    __syncthreads();
}

DEV void phase_mixA(const Params& p) {
    constexpr int N1 = 512, N3 = 512, N4 = 128;
    {
        const float* mod = (const float*)(p.ws + W_MOD); bf16_t* shf = (bf16_t*)(p.ws + W_SHF);
        const int gt = BIDX() * 512 + TIDX(), GT = gridDim.x * 512;
        for (int i = gt; i < NMODROWS * D; i += GT) { const int row = i >> 10, k = i & 1023; shf[i] = f2bf(row < 136 ? mod[(size_t)row * 6144 + 3 * D + k] : 0.f); }
    }
    lru_phase<false>(p);
    for (int it = BIDX(); it < N1 + N3 + N4; it += gridDim.x) {
        if (it < N1) ret_passA(p, it);
        else if (it < N1 + N3) sample_ret2(p, it - N1);
        else sample_lru(p, it - N1 - N3);
    }
}
DEV void phase_mixC(const Params& p) {
    constexpr int N1 = 512;
    lru_phase<true>(p);
    for (int it = BIDX(); it < N1; it += gridDim.x) {
        { const int u = it; const int n = u & 15; const int nn = (((u >> 4) ^ (u >> 8)) & 1) ? 15 - n : n; ret_passC(p, (u & ~15) | nn); }
    }
}

DEV void phase_outproj(const Params& p) {
    unsigned char* ws = p.ws;
    const bf16_t* mix = (const bf16_t*)(ws + W_MIX); const bf16_t* BtOut = (const bf16_t*)(ws + W_BTOUT); bf16_t* xs = (bf16_t*)(ws + W_H);
    const float* mod = (const float*)(ws + W_MOD); float* rss1 = (float*)(ws + W_RSS1);
    constexpr int NBIG = 64 * 4;
    gemm_phase<false>(mix, BtOut, D, 64, 4, NBIG, nullptr, [&](const f32x4 (&acc)[2][2][4][2], int pm, int pn, int brow, int bcol, int wr, int wc, int fr, int fq) {
                const int b = brow >> 11;
                const float* mrow = mod + (size_t)b * 6144;
                f32x4 gt[2][2], sf[2][2];
#pragma unroll
                for (int bj = 0; bj < 2; ++bj)
#pragma unroll
                    for (int n = 0; n < 2; ++n) {
                        const int col = bcol + bj * HALF + wc * 32 + 8 * fq + 4 * n;
                        gt[bj][n] = *(const f32x4*)(mrow + 2 * D + col);
                        sf[bj][n] = *(const f32x4*)(p.g_ffn + col) * (1.f + *(const f32x4*)(mrow + 4 * D + col));
                    }
#pragma unroll
                for (int ai = 0; ai < 2; ++ai)
#pragma unroll
                    for (int m = 0; m < 4; ++m) {
                        const int row = brow + ai * HALF + wr * 64 + m * 16 + fr;
                        float ss = 0.f;
#pragma unroll
                        for (int bj = 0; bj < 2; ++bj) {
                            const int col = bcol + bj * HALF + wc * 32 + 8 * fq;
                            f32x4 y[2];
#pragma unroll
                            for (int n = 0; n < 2; ++n) {
                                y[n] = *(const f32x4*)(p.x_p + (size_t)row * D + col + 4 * n) + gt[bj][n] * acc[ai][bj][m][n];
                                ss += (y[n].x * y[n].x + y[n].y * y[n].y) + (y[n].z * y[n].z + y[n].w * y[n].w);
                                y[n] = y[n] * sf[bj][n];
                            }
                            u32x4 w; w.x = cvt_pk_bf16(y[0].x, y[0].y); w.y = cvt_pk_bf16(y[0].z, y[0].w); w.z = cvt_pk_bf16(y[1].x, y[1].y); w.w = cvt_pk_bf16(y[1].z, y[1].w);
                            *(u32x4*)(xs + (size_t)row * D + col) = w;
                        }
                        ss += __shfl_xor(ss, 16); ss += __shfl_xor(ss, 32);
                        if (fq == 0) atomicAdd(rss1 + row, ss);
                    }
            });
    const bf16_t* BtUp = (const bf16_t*)(ws + W_BTUP); const bf16_t* shf = (const bf16_t*)(ws + W_SHF); float* sW = (float*)(ws + W_SW);
    SKINNY_LOOP(j, NBIG, 64 + 176) {
        if (j < 64) {
            const int g = j >> 1, n = j & 1;
            const bf16_t* B0 = BtOut + (size_t)(32 * g + 16 * n) * D;
            skinny_tile<8, 1, 4>(mix + (size_t)NTOK * D, D, B0, B0, D, [&](int row, int s, float v0, float v1) {
                const float* mrow = mod + (size_t)(8 + row) * 6144;
                const int c0 = 32 * g + slotcol(n, s);
                const float y0 = p.x_s[(size_t)row * D + c0] + mrow[2 * D + c0] * v0;
                p.out[O_YS + (size_t)row * D + c0] = y0;
                xs[(size_t)(NTOK + row) * D + c0] = f2bf(y0 * p.g_ffn[c0] * (1.f + mrow[4 * D + c0]));
                return y0 * y0;
            }, [&](int row, float ss) { atomicAdd(rss1 + NTOK + row, ss); });
        } else {
            const int t = j - 64, pn = t >> 3, bj = (t >> 2) & 1, g4 = t & 3;
            const bf16_t* B0 = BtUp + (size_t)(256 * pn + 128 * bj + 32 * g4) * D;
            skinny_tile<9, 2, 4>(shf, D, B0, B0 + 16 * D, D, [&](int row, int s, float v0, float v1) {
                const int c0 = bj * DFF + 128 * pn + 32 * g4 + slotcol(0, s); sW[(size_t)row * (2 * DFF) + c0] = v0; sW[(size_t)row * (2 * DFF) + c0 + 4] = v1; return 0.f;
            });
        }
    }
}

DEV void phase_up(const Params& p) {
    unsigned char* ws = p.ws;
    const bf16_t* xs = (const bf16_t*)(ws + W_H); const bf16_t* BtUp = (const bf16_t*)(ws + W_BTUP); bf16_t* fin = (bf16_t*)(ws + W_PROJ);
    const float* sW = (const float*)(ws + W_SW); const float* rss1 = (const float*)(ws + W_RSS1);
    float* edgeU = (float*)(ws + W_EDGEU); float* edgeG = (float*)(ws + W_EDGEG); float* tailU = (float*)(ws + W_TAILU);
    constexpr int NBIG = 64 * 22, NSK = 176;
    gemm_phase<false>(xs, BtUp, D, 64, 22, NBIG, nullptr, [&](f32x4 (&acc)[2][2][4][2], int pm, int pn, int brow, int bcol, int wr, int wc, int fr, int fq) {
        float* halo = (float*)(shm_raw + 131072);
        const int b = brow >> 11;
        const int ff0 = 128 * pn + wc * 32 + 8 * fq;
        const int cl0 = wc * 32 + 8 * fq;
        {
            f32x4 swc[2], swg[2];
#pragma unroll
            for (int n = 0; n < 2; ++n) { swc[n] = *(const f32x4*)(sW + (size_t)b * (2 * DFF) + ff0 + 4 * n); swg[n] = *(const f32x4*)(sW + (size_t)b * (2 * DFF) + DFF + ff0 + 4 * n); }
#pragma unroll
            for (int ai = 0; ai < 2; ++ai)
#pragma unroll
                for (int m = 0; m < 4; ++m) {
                    const int rl = ai * HALF + wr * 64 + m * 16 + fr;
                    const float rstd = __builtin_amdgcn_rsqf(rss1[brow + rl] * (1.f / D) + EPS);
#pragma unroll
                    for (int n = 0; n < 2; ++n) { acc[ai][0][m][n] = acc[ai][0][m][n] * rstd + swc[n]; acc[ai][1][m][n] = acc[ai][1][m][n] * rstd + swg[n]; }
                }
        }
        if (fr >= 14) {
#pragma unroll
            for (int ai = 0; ai < 2; ++ai)
#pragma unroll
                for (int n = 0; n < 2; ++n) *(f32x4*)(halo + ((ai * 2 + wr) * 2 + fr - 14) * 128 + cl0 + 4 * n) = acc[ai][0][3][n];
        }
        __syncthreads();
        {
            f32x4 cw0[2], cw1[2], cw2[2], cb[2];
#pragma unroll
            for (int n = 0; n < 2; ++n) {
                cw0[n] = *(const f32x4*)(p.cf_w + ff0 + 4 * n); cw1[n] = *(const f32x4*)(p.cf_w + DFF + ff0 + 4 * n); cw2[n] = *(const f32x4*)(p.cf_w + 2 * DFF + ff0 + 4 * n);
                cb[n] = *(const f32x4*)(p.cf_b + ff0 + 4 * n);
            }
#pragma unroll
            for (int ai = 0; ai < 2; ++ai) {
                const int st = ai * 2 + wr;
                f32x4 um1[2];
#pragma unroll
                for (int n = 0; n < 2; ++n) {
                    um1[n] = (f32x4){0.f, 0.f, 0.f, 0.f};
                    if (st > 0 && fr >= 14) um1[n] = *(const f32x4*)(halo + ((st - 1) * 2 + fr - 14) * 128 + cl0 + 4 * n);
                }
#pragma unroll
                for (int m = 0; m < 4; ++m) {
                    const int rl = ai * HALF + wr * 64 + m * 16 + fr;
                    unsigned wv[4];
#pragma unroll
                    for (int n = 0; n < 2; ++n) {
                        const f32x4 u = acc[ai][0][m][n], g = acc[ai][1][m][n];
                        f32x4 p1, p2;
#pragma unroll
                        for (int c = 0; c < 4; ++c) { p1[c] = dpp_shr1(dpp_ror1(um1[n][c]), u[c]); p2[c] = dpp_shr2(dpp_ror2(um1[n][c]), u[c]); }
                        const f32x4 uc = cb[n] + cw0[n] * p2 + cw1[n] * p1 + cw2[n] * u;
                        wv[2 * n] = cvt_pk_bf16(geluf_(uc.x) * g.x, geluf_(uc.y) * g.y); wv[2 * n + 1] = cvt_pk_bf16(geluf_(uc.z) * g.z, geluf_(uc.w) * g.w);
                        um1[n] = u;
                    }
                    if (rl >= 2) {
                        u32x4 w; w.x = wv[0]; w.y = wv[1]; w.z = wv[2]; w.w = wv[3];
                        *(u32x4*)(fin + (size_t)(brow + rl) * DFF + ff0) = w;
                    } else {
#pragma unroll
                        for (int n = 0; n < 2; ++n) {
                            *(f32x4*)(edgeU + (size_t)(pm * 2 + rl) * DFF + ff0 + 4 * n) = acc[ai][0][m][n];
                            *(f32x4*)(edgeG + (size_t)(pm * 2 + rl) * DFF + ff0 + 4 * n) = acc[ai][1][m][n];
                        }
                    }
                    if (rl >= 254) {
#pragma unroll
                        for (int n = 0; n < 2; ++n) {
                            *(f32x4*)(tailU + (size_t)(pm * 2 + rl - 254) * DFF + ff0 + 4 * n) = acc[ai][0][m][n];
                            if ((pm & 7) == 7) *(f32x4*)(p.out + O_FCP + (size_t)(b * 2 + rl - 254) * DFF + ff0 + 4 * n) = acc[ai][0][m][n];
                        }
                    }
                }
            }
        }
    });
    SKINNY_LOOP(j, NBIG, NSK) {
            const int t = j, pn = t >> 3, g4 = (t >> 1) & 3, n = t & 1;
            const bf16_t* B0 = BtUp + (size_t)(256 * pn + 32 * g4 + 16 * n) * D;
            skinny_tile<8, 2, 4>(xs + (size_t)NTOK * D, D, B0, B0 + 128 * D, D, [&](int row, int s, float v0, float v1) {
                const int ff = 128 * pn + 32 * g4 + slotcol(n, s);
                const float rstd = __builtin_amdgcn_rsqf(rss1[NTOK + row] * (1.f / D) + EPS);
                const float u = v0 * rstd + sW[(size_t)(8 + row) * (2 * DFF) + ff], g = v1 * rstd + sW[(size_t)(8 + row) * (2 * DFF) + DFF + ff];
                const float s0 = p.st_cf[(size_t)(row * 2 + 0) * DFF + ff], s1 = p.st_cf[(size_t)(row * 2 + 1) * DFF + ff];
                const float uc = p.cf_b[ff] + p.cf_w[ff] * s0 + p.cf_w[DFF + ff] * s1 + p.cf_w[2 * DFF + ff] * u;
                fin[(size_t)(NTOK + row) * DFF + ff] = f2bf(geluf_(uc) * g);
                p.out[O_FCS + (size_t)(row * 2 + 0) * DFF + ff] = s1; p.out[O_FCS + (size_t)(row * 2 + 1) * DFF + ff] = u; return 0.f;
            });
    }
}

DEV void phase_down(const Params& p) {
    unsigned char* ws = p.ws;
    const bf16_t* fin = (const bf16_t*)(ws + W_PROJ); const bf16_t* BtDown = (const bf16_t*)(ws + W_BTDOWN);
    const float* mod = (const float*)(ws + W_MOD); float* rss2 = (float*)(ws + W_RSS2);
    const float* edgeU = (const float*)(ws + W_EDGEU); const float* edgeG = (const float*)(ws + W_EDGEG); const float* tailU = (const float*)(ws + W_TAILU);
    constexpr int NBIG = 64 * 4;
    for (int it = BIDX(); it < NBIG; it += gridDim.x) {
        int pm, pn; tile_order(it, 64, 4, pm, pn);
        bf16_t* fix = (bf16_t*)(ws + W_FIX) + (size_t)it * 2 * DFF;
            {
                const bool hp = (pm & 7) != 0;
                for (int i = TIDX(); i < DFF / 4; i += 512) {
                    const int ff = 4 * i;
                    const f32x4 z = (f32x4){0.f, 0.f, 0.f, 0.f};
                    const f32x4 um1 = hp ? *(const f32x4*)(tailU + (size_t)((pm - 1) * 2 + 1) * DFF + ff) : z, um2 = hp ? *(const f32x4*)(tailU + (size_t)((pm - 1) * 2 + 0) * DFF + ff) : z;
                    const f32x4 u0 = *(const f32x4*)(edgeU + (size_t)(pm * 2) * DFF + ff), u1 = *(const f32x4*)(edgeU + (size_t)(pm * 2 + 1) * DFF + ff);
                    const f32x4 g0 = *(const f32x4*)(edgeG + (size_t)(pm * 2) * DFF + ff), g1 = *(const f32x4*)(edgeG + (size_t)(pm * 2 + 1) * DFF + ff);
                    const f32x4 cb = *(const f32x4*)(p.cf_b + ff), w0 = *(const f32x4*)(p.cf_w + ff), w1 = *(const f32x4*)(p.cf_w + DFF + ff), w2 = *(const f32x4*)(p.cf_w + 2 * DFF + ff);
                    const f32x4 c0 = cb + w0 * um2 + w1 * um1 + w2 * u0, c1 = cb + w0 * um1 + w1 * u0 + w2 * u1;
                    u32x2 o0, o1;
                    o0.x = cvt_pk_bf16(geluf_(c0.x) * g0.x, geluf_(c0.y) * g0.y); o0.y = cvt_pk_bf16(geluf_(c0.z) * g0.z, geluf_(c0.w) * g0.w);
                    o1.x = cvt_pk_bf16(geluf_(c1.x) * g1.x, geluf_(c1.y) * g1.y); o1.y = cvt_pk_bf16(geluf_(c1.z) * g1.z, geluf_(c1.w) * g1.w);
                    *(u32x2*)(fix + ff) = o0; *(u32x2*)(fix + DFF + ff) = o1;
                }
            }
    }
    asm volatile("s_waitcnt vmcnt(0)" ::: "memory");
    __syncthreads();
    gemm_phase<true>(fin, BtDown, DFF, 64, 4, NBIG, (const bf16_t*)(ws + W_FIX), [&](f32x4 (&acc)[2][2][4][2], int pm, int pn, int brow, int bcol, int wr, int wc, int fr, int fq) {
        const int b = brow >> 11;
        const float* mrow = mod + (size_t)b * 6144;
        const bf16_t* xs = (const bf16_t*)(ws + W_H);
        const bool fuse = (gridDim.x == 256);
        unsigned* cnt = (unsigned*)(ws + W_BAR) + 3456 + 64 * pm;
        {
            f32x4 gt[2][2], isf[2][2];
#pragma unroll
            for (int bj = 0; bj < 2; ++bj)
#pragma unroll
                for (int n = 0; n < 2; ++n) {
                    const int col = bcol + bj * HALF + wc * 32 + 8 * fq + 4 * n;
                    gt[bj][n] = *(const f32x4*)(mrow + 5 * D + col);
                    const f32x4 sf = *(const f32x4*)(p.g_ffn + col) * (1.f + *(const f32x4*)(mrow + 4 * D + col));
                    isf[bj][n] = (f32x4){__builtin_amdgcn_rcpf(sf.x), __builtin_amdgcn_rcpf(sf.y), __builtin_amdgcn_rcpf(sf.z), __builtin_amdgcn_rcpf(sf.w)};
                }
#pragma unroll
            for (int ai = 0; ai < 2; ++ai)
#pragma unroll
                for (int m = 0; m < 4; ++m) {
                    const int row = brow + ai * HALF + wr * 64 + m * 16 + fr;
                    float ss = 0.f;
#pragma unroll
                    for (int bj = 0; bj < 2; ++bj) {
                        const int col = bcol + bj * HALF + wc * 32 + 8 * fq;
                        float xv[8]; unpack8(*(const u32x4*)(xs + (size_t)row * D + col), xv);
#pragma unroll
                        for (int n = 0; n < 2; ++n) {
                            const f32x4 x1 = (f32x4){xv[4 * n], xv[4 * n + 1], xv[4 * n + 2], xv[4 * n + 3]} * isf[bj][n];
                            const f32x4 y = x1 + gt[bj][n] * acc[ai][bj][m][n];
                            acc[ai][bj][m][n] = y;
                            ss += (y.x * y.x + y.y * y.y) + (y.z * y.z + y.w * y.w);
                        }
                    }
                    ss += __shfl_xor(ss, 16); ss += __shfl_xor(ss, 32);
                    if (fq == 0) atomicAdd(rss2 + row, ss);
                }
        }
        asm volatile("s_waitcnt vmcnt(0)" ::: "memory");
        __syncthreads();
        if (fuse && TIDX() == 0) {
            __hip_atomic_fetch_add(cnt, 1u, __ATOMIC_RELAXED, __HIP_MEMORY_SCOPE_AGENT);
            unsigned sp = 0;
            while (__hip_atomic_load(cnt, __ATOMIC_RELAXED, __HIP_MEMORY_SCOPE_AGENT) < 4u) { __builtin_amdgcn_s_sleep(2); if (++sp > (1u << 22)) break; }
        }
        __syncthreads();
        {
            f32x4 gf[2][2];
#pragma unroll
            for (int bj = 0; bj < 2; ++bj)
#pragma unroll
                for (int n = 0; n < 2; ++n) gf[bj][n] = *(const f32x4*)(p.g_final + bcol + bj * HALF + wc * 32 + 8 * fq + 4 * n);
            float tot[2][4];
#pragma unroll
            for (int ai = 0; ai < 2; ++ai)
#pragma unroll
                for (int m = 0; m < 4; ++m) tot[ai][m] = fuse ? __hip_atomic_load(rss2 + brow + ai * HALF + wr * 64 + m * 16 + fr, __ATOMIC_RELAXED, __HIP_MEMORY_SCOPE_AGENT) : 0.f;
#pragma unroll
            for (int ai = 0; ai < 2; ++ai)
#pragma unroll
                for (int m = 0; m < 4; ++m) {
                    const int row = brow + ai * HALF + wr * 64 + m * 16 + fr;
                    const float rstd = fuse ? __builtin_amdgcn_rsqf(tot[ai][m] * (1.f / D) + EPS) : 1.f;
#pragma unroll
                    for (int bj = 0; bj < 2; ++bj)
#pragma unroll
                        for (int n = 0; n < 2; ++n)
                            *(f32x4*)(p.out + O_YP + (size_t)row * D + bcol + bj * HALF + wc * 32 + 8 * fq + 4 * n) = fuse ? acc[ai][bj][m][n] * rstd * gf[bj][n] : acc[ai][bj][m][n];
                }
        }
    });
    for (int j = BIDX(); j < 32 * 11; j += gridDim.x) {
        const int g = j / 11, ksl = j - g * 11;
        const bf16_t* B0 = BtDown + (size_t)(32 * g) * DFF + ksl * 256;
        float* part = (float*)(ws + W_KVT) + (size_t)ksl * NSMP * D;
        skinny_tile<8, 2, 2>(fin + (size_t)NTOK * DFF + ksl * 256, DFF, B0, B0 + 16 * DFF, 256, [&](int row, int s, float v0, float v1) {
            const int c0 = 32 * g + slotcol(0, s);
            part[(size_t)row * D + c0] = v0; part[(size_t)row * D + c0 + 4] = v1; return 0.f;
        }, NoRowFn(), DFF);
    }
}

DEV void phase_final(const Params& p) {
    const float* rss2 = (const float*)(p.ws + W_RSS2);
    const int gt = BIDX() * 512 + TIDX(), GT = gridDim.x * 512;
    if (gridDim.x != 256)
    for (int i = gt; i < NTOK * 256; i += GT) {
        const int row = i >> 8, k = (i & 255) * 4;
        const float rstd = __builtin_amdgcn_rsqf(rss2[row] * (1.f / D) + EPS);
        f32x4* yp = (f32x4*)(p.out + (size_t)row * D + k);
        *yp = *yp * rstd * *(const f32x4*)(p.g_final + k);
    }
    const float* part = (const float*)(p.ws + W_KVT); const float* mod = (const float*)(p.ws + W_MOD);
    const int lane = TIDX() & 63, gw = BIDX() * 8 + (TIDX() >> 6), NGW = gridDim.x * 8;
    for (int row = gw; row < NSMP; row += NGW) {
        float* yp = p.out + O_YS + (size_t)row * D; const float* mrow = mod + (size_t)(8 + row) * 6144 + 5 * D;
        f32x4 y[4]; float ss = 0.f;
#pragma unroll
        for (int j = 0; j < 4; ++j) {
            const int k = 4 * lane + 256 * j;
            f32x4 a = (f32x4){0.f, 0.f, 0.f, 0.f};
#pragma unroll
            for (int sl = 0; sl < 11; ++sl) a = a + *(const f32x4*)(part + ((size_t)sl * NSMP + row) * D + k);
            y[j] = *(const f32x4*)(yp + k) + *(const f32x4*)(mrow + k) * a;
            ss += y[j].x * y[j].x + y[j].y * y[j].y + y[j].z * y[j].z + y[j].w * y[j].w;
        }
        const float rstd = __builtin_amdgcn_rsqf(wave_sum(ss) * (1.f / D) + EPS);
#pragma unroll
        for (int j = 0; j < 4; ++j) { const int k = 4 * lane + 256 * j; *(f32x4*)(yp + k) = y[j] * rstd * *(const f32x4*)(p.g_final + k); }
    }
}

#define XB_TMO      128
#define XB_XCNT(j)  (256  + 64 * (j))
#define XB_XSUB(j)  (1280 + 64 * (j))
#define XB_XGEN(j)  (2304 + 64 * (j))
#define XB_TOP      3328
#define XB_TOPGEN   3392
#define XCD_BAR_WORDS 3456
#define XB_SPIN_CAP (1u << 20)
DEV unsigned xb_ld(unsigned* p) { return __hip_atomic_load(p, __ATOMIC_RELAXED, __HIP_MEMORY_SCOPE_AGENT); }
DEV unsigned xb_add(unsigned* p, unsigned v) { return __hip_atomic_fetch_add(p, v, __ATOMIC_RELAXED, __HIP_MEMORY_SCOPE_AGENT); }
DEV unsigned xb_xcc_id() { return (unsigned)__builtin_amdgcn_s_getreg((3 << 11) | 20) & 0xFu; }
#define XB_SPIN(cond, bar) do { unsigned _sp = 0; while (cond) { __builtin_amdgcn_s_sleep(1); \
    if ((++_sp & 255u) == 0u) { if (xb_ld(&(bar)[XB_TMO])) break; if (_sp > XB_SPIN_CAP) { atomicAdd(&(bar)[XB_TMO], 1u); break; } } } } while (0)
struct XcdBarrier { unsigned* bar; unsigned x; volatile LAS unsigned* st; };
DEV XcdBarrier xcd_barrier_post(unsigned* bar, volatile LAS unsigned* st) {
    XcdBarrier b; b.bar = bar; b.x = xb_xcc_id(); b.st = st;
    if (threadIdx.x == 0) (void)xb_add(&bar[XB_XCNT(b.x)], 1u);
    return b;
}
DEV void xcd_barrier_complete(unsigned* bar, unsigned x, unsigned& nloc, unsigned& nx) {
    const unsigned G = gridDim.x * gridDim.y * gridDim.z;
    unsigned sum, cnt, mine, sp = 0u;
    for (;;) {
        sum = 0u; cnt = 0u; mine = 0u;
#pragma unroll
        for (unsigned j = 0; j < 16; ++j) { const unsigned c = xb_ld(&bar[XB_XCNT(j)]); sum += c; cnt += (c > 0u) ? 1u : 0u; mine = (j == x) ? c : mine; }
        if (sum == G) break;
        __builtin_amdgcn_s_sleep(1);
        if ((++sp & 255u) == 0u) { if (xb_ld(&bar[XB_TMO])) break; if (sp > XB_SPIN_CAP) { atomicAdd(&bar[XB_TMO], 1u); break; } }
    }
    nloc = mine > 0u ? mine : 1u; nx = cnt > 0u ? cnt : 1u;
}
DEV void xcd_barrier(const XcdBarrier& b) {
    asm volatile("s_waitcnt vmcnt(0)" ::: "memory");
    __syncthreads();
    if (threadIdx.x == 0) {
        unsigned* bar = b.bar;
        __builtin_amdgcn_s_waitcnt(0);
        unsigned nloc = b.st[0], nx = b.st[1];
        if (nloc == 0u) { xcd_barrier_complete(bar, b.x, nloc, nx); b.st[0] = nloc; b.st[1] = nx; }
        const unsigned old = xb_add(&bar[XB_XSUB(b.x)], 1u);
        const unsigned gen = old / nloc;
        if (old + 1u == (gen + 1u) * nloc) {
            __builtin_amdgcn_fence(__ATOMIC_RELEASE, "agent");
            asm volatile("s_waitcnt vmcnt(0)" ::: "memory");
            const unsigned og = xb_add(&bar[XB_TOP], 1u);
            const unsigned tg = og / nx;
            if (og + 1u == (tg + 1u) * nx) xb_add(&bar[XB_TOPGEN], 1u);
            else XB_SPIN(xb_ld(&bar[XB_TOPGEN]) == tg, bar);
            __builtin_amdgcn_fence(__ATOMIC_ACQUIRE, "agent");
            xb_add(&bar[XB_XGEN(b.x)], 1u);
            asm volatile("s_waitcnt vmcnt(0)" ::: "memory");
        } else {
            XB_SPIN(xb_ld(&bar[XB_XGEN(b.x)]) == gen, bar);
            __builtin_amdgcn_fence(__ATOMIC_ACQUIRE, "agent");
            asm volatile("s_waitcnt vmcnt(0)" ::: "memory");
        }
    }
    __syncthreads();
}

typedef const unsigned long long __attribute__((address_space(4)))* KWordPtr;
DEV Params kparams() {
    KWordPtr k = (KWordPtr)__builtin_amdgcn_kernarg_segment_ptr(); asm volatile("" : "+s"(k));
    Params q; unsigned long long* d = (unsigned long long*)&q;
#pragma unroll
    for (int i = 0; i < (int)(sizeof(Params) / 8); ++i) d[i] = k[i];
    return q;
}
__global__ void __launch_bounds__(512) fwd_kernel(Params p) {
    cg::grid_group grid = cg::this_grid();
    volatile LAS unsigned* xst = (volatile LAS unsigned*)((LAS unsigned char*)shm_raw + (LDS_BYTES - 16));
    if (threadIdx.x == 0) { xst[0] = 0u; xst[1] = 0u; }
    __syncthreads();
    const XcdBarrier xb = xcd_barrier_post((unsigned*)(p.ws + W_BAR), xst);
    const int lo = (int)p.ph_lo, hi = (int)p.ph_hi;
    if (hi < 0) grid.sync();
#ifdef ONLY_PHASE
#define RUNP(si, ph, call) if (ph == ONLY_PHASE) { const Params q = kparams(); call(q); }
#else
#define RUNP(si, ph, call) if (lo <= si && si < hi) { { const Params q = kparams(); call(q); } if (si + 1 < hi) { xcd_barrier(xb); } }
#endif
    RUNP(0, 0, phase_prep)
    RUNP(1, 1, phase_mod)
    RUNP(2, 2, phase_norm1)
    RUNP(3, 3, phase_inproj)
    RUNP(4, 4, phase_mixA)
    RUNP(5, 10, phase_scan)
    RUNP(6, 5, phase_mixC)
    RUNP(7, 6, phase_outproj)
    RUNP(8, 7, phase_up)
    RUNP(9, 8, phase_down)
    RUNP(10, 9, phase_final)
}

extern "C" void kernel_launch(void* const* d_in, const int* in_sizes, int n_in, void* d_out, int out_size, void* d_ws, size_t ws_size, hipStream_t stream) {
    static int grid_blocks = 0;
    if (grid_blocks == 0) {
        if (n_in != 27 || ws_size < W_END) { fprintf(stderr, "kernel_launch: unexpected n_in %d or ws_size %zu (< %zu)\n", n_in, ws_size, (size_t)W_END); grid_blocks = -1; return; }
        int dev = 0, cus = 0, per_cu = 0;
        hipGetDevice(&dev);
        hipDeviceGetAttribute(&cus, hipDeviceAttributeMultiprocessorCount, dev);
        if (hipFuncSetAttribute((const void*)fwd_kernel, hipFuncAttributeMaxDynamicSharedMemorySize, LDS_BYTES) != hipSuccess) { fprintf(stderr, "kernel_launch: hipFuncSetAttribute failed\n"); grid_blocks = -1; return; }
        if (hipOccupancyMaxActiveBlocksPerMultiprocessor(&per_cu, (const void*)fwd_kernel, 512, LDS_BYTES) != hipSuccess || per_cu < 1) { fprintf(stderr, "kernel_launch: occupancy query failed (%d)\n", per_cu); (void)hipGetLastError(); per_cu = 1; }
        grid_blocks = cus * 1;
    }
    if (grid_blocks < 0) return;
    Params p{};
    const float** pp = (const float**)&p;
    for (int i = 0; i < 27; ++i) pp[i] = (const float*)d_in[i];
    p.out = (float*)d_out; p.ws = (unsigned char*)d_ws;
    if (hipMemsetAsync((char*)d_ws + W_BAR, 0, (size_t)BAR_WORDS * 4, stream) != hipSuccess) { fprintf(stderr, "kernel_launch: memset failed\n"); return; }
#if MK_MULTI
    for (int ph = 0; ph < 11; ++ph) {
        p.ph_lo = ph; p.ph_hi = ph + 1;
        hipLaunchKernelGGL(fwd_kernel, dim3(grid_blocks), dim3(512), LDS_BYTES, stream, p);
    }
#else
    p.ph_lo = 0; p.ph_hi = 11;
    void* args[] = {&p};
    hipError_t e = hipLaunchCooperativeKernel((const void*)fwd_kernel, dim3(grid_blocks), dim3(512), args, LDS_BYTES, stream);
    if (e != hipSuccess) fprintf(stderr, "cooperative launch failed: %s (grid %d)\n", hipGetErrorString(e), grid_blocks);
#endif
}
```

```cpp
#include <hip/hip_runtime.h>
#include <hip/hip_cooperative_groups.h>
#include <cstdio>
#include <cstdint>
namespace cg = cooperative_groups;

#ifndef MK_MULTI
#define MK_MULTI 0
#endif

#define DEV __device__ __forceinline__
typedef unsigned short bf16_t;
typedef short bf16x8 __attribute__((ext_vector_type(8)));
typedef float f32x4 __attribute__((ext_vector_type(4)));
typedef unsigned u32x4 __attribute__((ext_vector_type(4)));
typedef unsigned u32x2 __attribute__((ext_vector_type(2)));

constexpr int D = 1024, TSEQ = 2048, NBATCH = 8, NTOK = 16384, NSMP = 128, NROWS = NTOK + NSMP;
constexpr int DP = 3072, DFF = 2816, DLRU = 512, NMODROWS = 144;
constexpr float EPS = 1e-6f;
constexpr int PAST_LEN = 16384;

constexpr size_t O_YP = 0, O_YS = O_YP + (size_t)NTOK * D, O_RETP = O_YS + (size_t)NSMP * D, O_LHP = O_RETP + 8 * 4 * 128 * 128,
                 O_LCP = O_LHP + 8 * 512, O_FCP = O_LCP + 8 * 3 * 512, O_RETS = O_FCP + 8 * 2 * DFF, O_LHS = O_RETS + (size_t)128 * 4 * 128 * 128,
                 O_LCS = O_LHS + 128 * 512, O_FCS = O_LCS + 128 * 3 * 512;

constexpr size_t al256(size_t x) { return (x + 255) & ~(size_t)255; }
constexpr size_t W_BTIN = 0;
constexpr size_t W_BTOUT = W_BTIN + (size_t)DP * D * 2;
constexpr size_t W_BTUP = W_BTOUT + (size_t)D * D * 2;
constexpr size_t W_BTDOWN = W_BTUP + (size_t)2 * DFF * D * 2;
constexpr size_t W_WRT = W_BTDOWN + (size_t)D * DFF * 2;
constexpr size_t W_H = W_WRT + 2 * 8 * 64 * 64 * 2;
constexpr size_t W_PROJ = W_H + (size_t)NROWS * D * 2;
constexpr size_t W_MIX = W_PROJ + (size_t)NTOK * DP * 2;
constexpr size_t W_KVT = W_MIX + (size_t)NROWS * D * 2;
constexpr size_t W_MOD = W_KVT + (size_t)512 * 65536;
constexpr size_t W_SW = W_MOD + (size_t)NMODROWS * 6144 * 4;
constexpr size_t W_PROJS = W_SW + (size_t)NMODROWS * 2 * DFF * 4;
constexpr size_t W_ROPE = W_PROJS + (size_t)NSMP * DP * 4;
constexpr size_t W_EDGEU = al256(W_ROPE + (size_t)(TSEQ + 1) * 128 * 4);
constexpr size_t W_EDGEG = W_EDGEU + (size_t)64 * 2 * DFF * 4;
constexpr size_t W_TAILU = W_EDGEG + (size_t)64 * 2 * DFF * 4;
constexpr size_t W_FIX = W_TAILU + (size_t)64 * 2 * DFF * 4;
constexpr size_t W_AGG = W_FIX + (size_t)256 * 2 * DFF * 2;
constexpr size_t W_RSS1 = W_AGG + (size_t)8 * 8 * 16 * 2 * 64 * 4;
constexpr size_t W_RSS2 = al256(W_RSS1 + (size_t)NROWS * 4);
constexpr size_t W_SPL = al256(W_RSS2 + (size_t)NROWS * 4);
constexpr size_t W_MODA = W_SPL + 512 * 4;
constexpr size_t W_SHF = W_MODA + (size_t)NMODROWS * D * 2;
constexpr size_t W_HIN0 = al256(W_SHF + (size_t)NMODROWS * D * 2);
constexpr size_t W_BAR = W_HIN0 + (size_t)1024 * 64 * 4;
constexpr int BAR_WORDS = 3456 + 64 * 64;
constexpr size_t W_END = W_BAR + (size_t)BAR_WORDS * 4;

constexpr int LDS_BYTES = 147456;

struct Params {
    const float *x_p, *x_s, *c_p, *c_s, *st_ret, *st_h, *st_cl, *st_cf, *w_ada, *b_ada, *g_mix, *w_in, *cl_w, *cl_b, *w_r, *b_r, *w_i, *b_i, *lam,
        *w_out, *g_ffn, *w_upc, *w_upg, *cf_w, *cf_b, *w_down, *g_final;
    float* out;
    unsigned char* ws;
    long long ph_lo, ph_hi;
};

extern __shared__ __attribute__((aligned(16))) unsigned char shm_raw[];

DEV int TIDX() { int t = threadIdx.x; asm volatile("" : "+v"(t)); return t; }
DEV int BIDX() { int b = blockIdx.x; asm volatile("" : "+s"(b)); return b; }
typedef float f32x2_ __attribute__((ext_vector_type(2)));
typedef __bf16 bf16x2_ __attribute__((ext_vector_type(2)));
DEV unsigned cvt_pk_bf16(float lo, float hi) { const f32x2_ v = {lo, hi}; const bf16x2_ r = __builtin_convertvector(v, bf16x2_); return __builtin_bit_cast(unsigned, r); }
DEV bf16_t f2bf(float x) { return (bf16_t)(cvt_pk_bf16(x, 0.f) & 0xffffu); }
DEV float bf2f(bf16_t v) { return __uint_as_float(((unsigned)v) << 16); }
DEV float bflo(unsigned w) { return __uint_as_float(w << 16); }
DEV float bfhi(unsigned w) { return __uint_as_float(w & 0xffff0000u); }
DEV float fexp2(float x) { return __builtin_amdgcn_exp2f(x); }
DEV float sigmoidf_(float x) { return __builtin_amdgcn_rcpf(1.f + fexp2(-1.4426950408889634f * x)); }
DEV float siluf_(float x) { return x * sigmoidf_(x); }
DEV float geluf_(float x) { const float y = 1.5957691216057308f * (x + 0.044715f * x * x * x); return x * sigmoidf_(y); }
DEV float wave_sum(float v) {
#pragma unroll
    for (int o = 1; o < 64; o <<= 1) v += __shfl_xor(v, o);
    return v;
}
DEV void unpack8(u32x4 w, float* f) { f[0] = bflo(w.x); f[1] = bfhi(w.x); f[2] = bflo(w.y); f[3] = bfhi(w.y); f[4] = bflo(w.z); f[5] = bfhi(w.z); f[6] = bflo(w.w); f[7] = bfhi(w.w); }
DEV u32x4 pack8(const float* f) { u32x4 w; w.x = cvt_pk_bf16(f[0], f[1]); w.y = cvt_pk_bf16(f[2], f[3]); w.z = cvt_pk_bf16(f[4], f[5]); w.w = cvt_pk_bf16(f[6], f[7]); return w; }
DEV int rhoinv(int w) { return 16 * ((w >> 2) & 1) + 4 * (w >> 3) + (w & 3); }
DEV int permpos(int c) { return (c & ~31) | rhoinv(c & 31); }
DEV int slotcol(int n, int s) { return 8 * (s >> 2) + 4 * n + (s & 3); }
DEV float gamma_log2(int h) { return __log2f(1.f - exp2f(-5.f - (float)h)); }

constexpr int BM = 256, BK = 64, HALF = 128, HT = HALF * BK;
DEV int lds_byte(int r, int c) { int st = (r >> 4) * 2 + (c >> 5), rr = r & 15, cc = c & 31, ob = rr * 64 + cc * 2; return st * 1024 + (ob ^ (((ob >> 9) & 1) << 5)); }
DEV void stage_rc(int b, int& R, int& C) { int st = b / 1024, sb = b % 1024, swz = sb ^ (((sb >> 9) & 1) << 5); R = (st >> 1) * 16 + swz / 64; C = (st & 1) * 32 + (swz % 64) / 2; }

#define LAS __attribute__((address_space(3)))
template <bool FIX, class Epi>
DEV void gemm_tile(const bf16_t* __restrict__ A, const bf16_t* __restrict__ Bt, const int K, const int brow, const int bcol, const bf16_t* fixA, Epi&& epi) {
    LAS unsigned char* lds = (LAS unsigned char*)shm_raw;
    const int tid = TIDX(), wid = __builtin_amdgcn_readfirstlane(tid >> 6), lane = tid & 63, wr = wid >> 2, wc = wid & 3, fr = lane & 15, fq = lane >> 4;
    const int nt = K / BK;
    constexpr int HTB = HALF * BK * 2;
    unsigned voff[2], voffF[2];
#pragma unroll
    for (int i = 0; i < 2; ++i) {
        int R, C; stage_rc(tid * 16 + i * 8192, R, C);
        voff[i] = (unsigned)(R * K + C) * 2u; voffF[i] = voff[i];
        if (FIX) { if (R < 2) voffF[i] = (unsigned)(((const char*)fixA - (const char*)(A + (size_t)brow * K)) + (long)(R * K + C) * 2); }
    }
    const size_t kstep = (size_t)(BK * 2), hstep = (size_t)HALF * K * 2;
    const unsigned ldsw = (unsigned)wid * 1024u;
    const int aoff = lds_byte(wr * 64 + fr, fq * 8), boff = lds_byte(wc * 32 + fr, fq * 8);
    const char* cA = (const char*)(A + (size_t)brow * K); const char* cB = (const char*)(Bt + (size_t)bcol * K);
#define SA(b, h) (((b) * 2 + (h)) * HTB)
#define SB(b, h) ((4 + (b) * 2 + (h)) * HTB)
#define STAGE(bufoff, gbase, vo) do { _Pragma("unroll") for (int _i = 0; _i < 2; ++_i) \
        __builtin_amdgcn_global_load_lds((const unsigned*)((const char*)(gbase) + (vo)[_i]), (LAS unsigned*)(lds + (bufoff) + ldsw + _i * 8192), 16, 0, 0); } while (0)
#define LDA(dst, b, h) do { _Pragma("unroll") for (int m = 0; m < 4; ++m) _Pragma("unroll") for (int k = 0; k < 2; ++k) dst[m][k] = *(const LAS bf16x8*)(lds + SA(b, h) + aoff + m * 2048 + k * 1024); } while (0)
#define LDB(dst, b, h) do { _Pragma("unroll") for (int n = 0; n < 2; ++n) _Pragma("unroll") for (int k = 0; k < 2; ++k) dst[n][k] = *(const LAS bf16x8*)(lds + SB(b, h) + boff + n * 2048 + k * 1024); } while (0)
#define MMA(ai, bj, At_, Bt_) do { __builtin_amdgcn_s_setprio(1); _Pragma("unroll") for (int m = 0; m < 4; ++m) _Pragma("unroll") for (int n = 0; n < 2; ++n) _Pragma("unroll") for (int k = 0; k < 2; ++k) \
        acc[ai][bj][m][n] = __builtin_amdgcn_mfma_f32_16x16x32_bf16(Bt_[n][k], At_[m][k], acc[ai][bj][m][n], 0, 0, 0); __builtin_amdgcn_s_setprio(0); } while (0)
#define WAIT_V(n) asm volatile("s_waitcnt vmcnt(" #n ")" ::: "memory")
#define WAIT_L(n) asm volatile("s_waitcnt lgkmcnt(" #n ")" ::: "memory")
#define BAR __builtin_amdgcn_s_barrier()
#define SCHED __builtin_amdgcn_sched_barrier(0)
    f32x4 acc[2][2][4][2];
#pragma unroll
    for (int a = 0; a < 2; ++a)
#pragma unroll
        for (int b = 0; b < 2; ++b)
#pragma unroll
            for (int m = 0; m < 4; ++m)
#pragma unroll
                for (int n = 0; n < 2; ++n) acc[a][b][m][n] = (f32x4){0.f, 0.f, 0.f, 0.f};
    bf16x8 At[4][2], B0[2][2], B1[2][2];
    STAGE(SB(0, 0), cB, voff); STAGE(SA(0, 0), cA, voffF); STAGE(SB(0, 1), cB + hstep, voff); STAGE(SA(0, 1), cA + hstep, voff);
    if (wr == 1) BAR;
    WAIT_V(4); BAR;
    STAGE(SB(1, 0), cB + kstep, voff); STAGE(SA(1, 0), cA + kstep, voffF); STAGE(SB(1, 1), cB + hstep + kstep, voff);
    WAIT_V(6); BAR;
    for (int t = 0; t < nt - 2; t += 2) {
        const char* a1 = cA + (size_t)(t + 1) * kstep; const char* a2 = a1 + kstep; const char* a3 = a2 + kstep;
        const char* b2 = cB + (size_t)(t + 2) * kstep; const char* b3 = b2 + kstep;
        LDB(B0, 0, 0); SCHED; LDA(At, 0, 0); STAGE(SA(1, 1), a1 + hstep, voff);
        WAIT_L(8); BAR; WAIT_L(0); MMA(0, 0, At, B0); BAR; SCHED;
        LDB(B1, 0, 1); STAGE(SB(0, 0), b2, voff);
        BAR; WAIT_L(0); MMA(0, 1, At, B1); BAR;
        LDA(At, 0, 1); STAGE(SA(0, 0), a2, voffF);
        BAR; WAIT_L(0); MMA(1, 0, At, B0); BAR; SCHED;
        STAGE(SB(0, 1), b2 + hstep, voff);
        WAIT_V(6); BAR; MMA(1, 1, At, B1); BAR;
        LDB(B0, 1, 0); SCHED; LDA(At, 1, 0); STAGE(SA(0, 1), a2 + hstep, voff);
        WAIT_L(8); BAR; WAIT_L(0); MMA(0, 0, At, B0); BAR; SCHED;
        LDB(B1, 1, 1); STAGE(SB(1, 0), b3, voff);
        BAR; WAIT_L(0); MMA(0, 1, At, B1); BAR;
        LDA(At, 1, 1); STAGE(SA(1, 0), a3, voffF);
        BAR; WAIT_L(0); MMA(1, 0, At, B0); BAR; SCHED;
        STAGE(SB(1, 1), b3 + hstep, voff);
        WAIT_V(6); BAR; MMA(1, 1, At, B1); BAR;
    }
    { LDB(B0, 0, 0); LDA(At, 0, 0); STAGE(SA(1, 1), cA + (size_t)(nt - 1) * kstep + hstep, voff);
      BAR; WAIT_L(0); MMA(0, 0, At, B0); BAR;
      LDB(B1, 0, 1); BAR; WAIT_L(0); MMA(0, 1, At, B1); BAR;
      LDA(At, 0, 1); WAIT_V(4); BAR; WAIT_L(0); MMA(1, 0, At, B0); MMA(1, 1, At, B1); BAR; }
    { LDB(B0, 1, 0); LDA(At, 1, 0); WAIT_V(2); BAR; WAIT_L(0); MMA(0, 0, At, B0); BAR;
      LDB(B1, 1, 1); WAIT_V(0); BAR; WAIT_L(0); MMA(0, 1, At, B1); BAR;
      LDA(At, 1, 1); BAR; WAIT_L(0); MMA(1, 0, At, B0); MMA(1, 1, At, B1); BAR; }
    if (wr == 0) BAR;
    asm volatile("" ::: "memory");
    epi(acc, brow, bcol, wr, wc, fr, fq);
#undef SA
#undef SB
#undef STAGE
#undef LDA
#undef LDB
#undef MMA
}

DEV void tile_order(int L, int nM, int nN, int& pm, int& pn) {
    const int nwg = nM * nN, NX = 8, WGM = 8;
    int wgid = L; { const int q = nwg / NX, r = nwg % NX, xcd = wgid % NX, off = wgid / NX; wgid = (xcd < r ? xcd * (q + 1) : r * (q + 1) + (xcd - r) * q) + off; }
    const int nig = WGM * nN, gid = wgid / nig, fm = gid * WGM, gsz = (nM - fm) < WGM ? (nM - fm) : WGM;
    pm = fm + ((wgid % nig) % gsz); pn = (wgid % nig) / gsz;
}

DEV float dpp_ror1(float x) { return __int_as_float(__builtin_amdgcn_update_dpp(0, __float_as_int(x), 0x121, 0xf, 0xf, false)); }
DEV float dpp_ror2(float x) { return __int_as_float(__builtin_amdgcn_update_dpp(0, __float_as_int(x), 0x122, 0xf, 0xf, false)); }
DEV float dpp_shr1(float old, float x) { return __int_as_float(__builtin_amdgcn_update_dpp(__float_as_int(old), __float_as_int(x), 0x111, 0xf, 0xf, false)); }
DEV float dpp_shr2(float old, float x) { return __int_as_float(__builtin_amdgcn_update_dpp(__float_as_int(old), __float_as_int(x), 0x112, 0xf, 0xf, false)); }
#define SKINNY_LOOP(j, NBIG_, NSK_) const int _nb = gridDim.x, _first = (NBIG_) % _nb, _bb = BIDX(); if (_bb >= _first) for (int j = _bb - _first; j < (NSK_); j += _nb - _first)
template <bool FIX, class Epi>
DEV void gemm_phase(const bf16_t* __restrict__ A, const bf16_t* __restrict__ Bt, const int K, const int nM, const int nN, const int nbig, const bf16_t* fixbase, Epi&& epi) {
    LAS unsigned char* lds = (LAS unsigned char*)shm_raw;
    const int tid = TIDX(), wid = __builtin_amdgcn_readfirstlane(tid >> 6), lane = tid & 63, wr = wid >> 2, wc = wid & 3, fr = lane & 15, fq = lane >> 4;
    const int nt = K / BK, G = gridDim.x;
    int it = BIDX();
    if (it >= nbig) return;
    constexpr int HTB = HALF * BK * 2;
    unsigned voff[2], voffF[2], voffFn[2];
    int sR[2], sC[2];
#pragma unroll
    for (int i = 0; i < 2; ++i) { stage_rc(tid * 16 + i * 8192, sR[i], sC[i]); voff[i] = (unsigned)(sR[i] * K + sC[i]) * 2u; voffF[i] = voff[i]; voffFn[i] = voff[i]; }
    const size_t kstep = (size_t)(BK * 2), hstep = (size_t)HALF * K * 2, tstep = 2 * hstep;
    const unsigned ldsw = (unsigned)wid * 1024u;
    const int aoff = lds_byte(wr * 64 + fr, fq * 8), boff = lds_byte(wc * 32 + fr, fq * 8);
    int pm, pn; tile_order(it, nM, nN, pm, pn);
    const char* cA = (const char*)A + (size_t)pm * tstep; const char* cB = (const char*)Bt + (size_t)pn * tstep;
    if (FIX) {
#pragma unroll
        for (int i = 0; i < 2; ++i) if (sR[i] < 2) voffF[i] = (unsigned)(((const char*)(fixbase + (size_t)it * 2 * K) - cA) + (long)(sR[i] * K + sC[i]) * 2);
    }
#define SA(b, h) (((b) * 2 + (h)) * HTB)
#define SB(b, h) ((4 + (b) * 2 + (h)) * HTB)
#define STAGE(bufoff, gbase, vo) do { _Pragma("unroll") for (int _i = 0; _i < 2; ++_i) \
        __builtin_amdgcn_global_load_lds((const unsigned*)((const char*)(gbase) + (vo)[_i]), (LAS unsigned*)(lds + (bufoff) + ldsw + _i * 8192), 16, 0, 0); } while (0)
#define LDA(dst, b, h) do { _Pragma("unroll") for (int m = 0; m < 4; ++m) _Pragma("unroll") for (int k = 0; k < 2; ++k) dst[m][k] = *(const LAS bf16x8*)(lds + SA(b, h) + aoff + m * 2048 + k * 1024); } while (0)
#define LDB(dst, b, h) do { _Pragma("unroll") for (int n = 0; n < 2; ++n) _Pragma("unroll") for (int k = 0; k < 2; ++k) dst[n][k] = *(const LAS bf16x8*)(lds + SB(b, h) + boff + n * 2048 + k * 1024); } while (0)
#define MMA(ai, bj, At_, Bt_) do { __builtin_amdgcn_s_setprio(1); _Pragma("unroll") for (int m = 0; m < 4; ++m) _Pragma("unroll") for (int n = 0; n < 2; ++n) _Pragma("unroll") for (int k = 0; k < 2; ++k) \
        acc[ai][bj][m][n] = __builtin_amdgcn_mfma_f32_16x16x32_bf16(Bt_[n][k], At_[m][k], acc[ai][bj][m][n], 0, 0, 0); __builtin_amdgcn_s_setprio(0); } while (0)
    f32x4 acc[2][2][4][2];
#define ZACC() do { _Pragma("unroll") for (int a_ = 0; a_ < 2; ++a_) _Pragma("unroll") for (int b_ = 0; b_ < 2; ++b_) _Pragma("unroll") for (int m_ = 0; m_ < 4; ++m_) _Pragma("unroll") for (int n_ = 0; n_ < 2; ++n_) acc[a_][b_][m_][n_] = (f32x4){0.f, 0.f, 0.f, 0.f}; } while (0)
    ZACC();
    bf16x8 At[4][2], B0[2][2], B1[2][2];
    STAGE(SB(0, 0), cB, voff); STAGE(SB(0, 1), cB + hstep, voff); STAGE(SA(0, 0), cA, voffF); STAGE(SA(0, 1), cA + hstep, voff);
    if (wr == 1) BAR;
    WAIT_V(2); BAR;
    STAGE(SB(1, 0), cB + kstep, voff); STAGE(SA(1, 0), cA + kstep, voffF); STAGE(SB(1, 1), cB + hstep + kstep, voff);
    WAIT_V(6); BAR;
    for (;;) {
        const int itn = it + G; const bool has_next = itn < nbig;
        int pmn = pm, pnn = pn; if (has_next) tile_order(itn, nM, nN, pmn, pnn);
        const char* nA = (const char*)A + (size_t)pmn * tstep; const char* nB = (const char*)Bt + (size_t)pnn * tstep;
        if (FIX) {
#pragma unroll
            for (int i = 0; i < 2; ++i) { voffFn[i] = voff[i]; if (sR[i] < 2) voffFn[i] = (unsigned)(((const char*)(fixbase + (size_t)(has_next ? itn : it) * 2 * K) - nA) + (long)(sR[i] * K + sC[i]) * 2); }
        }
        for (int t = 0; t < nt; t += 2) {
            const bool last = (t == nt - 2);
            const char* a1 = cA + (size_t)(t + 1) * kstep;
            const char* a2 = last ? nA : cA + (size_t)(t + 2) * kstep; const char* b2 = last ? nB : cB + (size_t)(t + 2) * kstep;
            const char* a3 = a2 + kstep; const char* b3 = b2 + kstep;
            unsigned vF2[2];
#pragma unroll
            for (int i = 0; i < 2; ++i) vF2[i] = FIX ? (last ? voffFn[i] : voffF[i]) : voff[i];
            LDB(B0, 0, 0); LDB(B1, 0, 1); SCHED; LDA(At, 0, 0); STAGE(SA(1, 1), a1 + hstep, voff);
            WAIT_V(8); WAIT_L(0); BAR; MMA(0, 0, At, B0); MMA(0, 1, At, B1); BAR; SCHED;
            LDA(At, 0, 1); STAGE(SB(0, 0), b2, voff); STAGE(SB(0, 1), b2 + hstep, voff); STAGE(SA(0, 0), a2, vF2);
            WAIT_V(8); WAIT_L(0); BAR; MMA(1, 0, At, B0); MMA(1, 1, At, B1); BAR; SCHED;
            LDB(B0, 1, 0); LDB(B1, 1, 1); SCHED; LDA(At, 1, 0); STAGE(SA(0, 1), a2 + hstep, voff);
            WAIT_V(8); WAIT_L(0); BAR; MMA(0, 0, At, B0); MMA(0, 1, At, B1); BAR; SCHED;
            LDA(At, 1, 1); STAGE(SB(1, 0), b3, voff); STAGE(SB(1, 1), b3 + hstep, voff); STAGE(SA(1, 0), a3, vF2);
            WAIT_V(8); WAIT_L(0); BAR; MMA(1, 0, At, B0); MMA(1, 1, At, B1); BAR; SCHED;
        }
        if (wr == 0) BAR;
        asm volatile("" ::: "memory");
        epi(acc, pm, pn, pm * BM, pn * BM, wr, wc, fr, fq);
        if (!has_next) { asm volatile("s_waitcnt vmcnt(0)" ::: "memory"); break; }
        ZACC();
        it = itn; pm = pmn; pn = pnn; cA = nA; cB = nB;
        if (FIX) { voffF[0] = voffFn[0]; voffF[1] = voffFn[1]; }
        if (wr == 1) BAR;
    }
    BAR;
#undef SA
#undef SB
#undef STAGE
#undef LDA
#undef LDB
#undef MMA
#undef ZACC
}

struct NoRowFn { DEV void operator()(int, float) const {} };
template <int RB, int NBLK, int U, class Epi, class RowFn = NoRowFn>
DEV void skinny_tile(const bf16_t* __restrict__ A, const int lda, const bf16_t* __restrict__ B0, const bf16_t* __restrict__ B1, const int K, Epi&& epi, RowFn&& rowfn = NoRowFn(), const int ldb_ = 0) {
    const int ldb = ldb_ ? ldb_ : K;
    float* red = (float*)shm_raw;
    const int tid = TIDX(), w = tid >> 6, lane = tid & 63, fr = lane & 15, fq = lane >> 4;
    constexpr int KG = (NBLK == 2) ? 4 : 8;
    const int kg = (NBLK == 2) ? (w & 3) : w, nb = (NBLK == 2) ? (w >> 2) : 0;
    const bf16_t* Bp = (nb ? B1 : B0) + (long)fr * ldb + fq * 8;
    const bf16_t* Ap = A + (long)fr * lda + fq * 8;
    const int kper = K / KG, kbeg = kg * kper, kend = kbeg + kper;
    f32x4 acc[RB];
#pragma unroll
    for (int rb = 0; rb < RB; ++rb) acc[rb] = (f32x4){0.f, 0.f, 0.f, 0.f};
    int k = kbeg;
    for (; k + 32 * U <= kend; k += 32 * U) {
        bf16x8 b[U], a[U][RB];
#pragma unroll
        for (int u = 0; u < U; ++u) {
            b[u] = *(const bf16x8*)(Bp + k + 32 * u);
#pragma unroll
            for (int rb = 0; rb < RB; ++rb) a[u][rb] = *(const bf16x8*)(Ap + (long)rb * 16 * lda + k + 32 * u);
        }
#pragma unroll
        for (int u = 0; u < U; ++u)
#pragma unroll
            for (int rb = 0; rb < RB; ++rb) acc[rb] = __builtin_amdgcn_mfma_f32_16x16x32_bf16(b[u], a[u][rb], acc[rb], 0, 0, 0);
    }
    for (; k < kend; k += 32) {
        const bf16x8 b = *(const bf16x8*)(Bp + k);
        bf16x8 a[RB];
#pragma unroll
        for (int rb = 0; rb < RB; ++rb) a[rb] = *(const bf16x8*)(Ap + (long)rb * 16 * lda + k);
#pragma unroll
        for (int rb = 0; rb < RB; ++rb) acc[rb] = __builtin_amdgcn_mfma_f32_16x16x32_bf16(b, a[rb], acc[rb], 0, 0, 0);
    }
    f32x4* r4 = (f32x4*)red;
#pragma unroll
    for (int rb = 0; rb < RB; ++rb) r4[(w * RB + rb) * 64 + lane] = acc[rb];
    __syncthreads();
    for (int e = tid; e < RB * 256; e += 512) {
        const int row = e >> 4, s = e & 15, rb = row >> 4, l2 = (row & 15) + 16 * (s >> 2), r = s & 3;
        float v0 = 0.f, v1 = 0.f;
        if (NBLK == 2) {
#pragma unroll
            for (int g = 0; g < 4; ++g) { v0 += red[((g * RB + rb) * 64 + l2) * 4 + r]; v1 += red[(((4 + g) * RB + rb) * 64 + l2) * 4 + r]; }
        } else {
#pragma unroll
            for (int g = 0; g < 8; ++g) v0 += red[((g * RB + rb) * 64 + l2) * 4 + r];
        }
        float ss = epi(row, s, v0, v1);
        ss += __shfl_xor(ss, 1); ss += __shfl_xor(ss, 2); ss += __shfl_xor(ss, 4); ss += __shfl_xor(ss, 8);
        if (s == 0) rowfn(row, ss);
    }
    __syncthreads();
}

template <class RowMap>
DEV void transpose_tile(const float* __restrict__ src, const int N, const int K, const int k0, const int c0, bf16_t* __restrict__ dst, RowMap&& rowmap) {
    float* lds = (float*)shm_raw;
    const int tid = TIDX();
#pragma unroll
    for (int i = 0; i < 2; ++i) {
        const int idx = tid * 4 + i * 2048, kk = idx >> 6, cc = idx & 63;
        const f32x4 v = *(const f32x4*)(src + (size_t)(k0 + kk) * N + c0 + cc);
        lds[kk * 65 + cc] = v.x; lds[kk * 65 + cc + 1] = v.y; lds[kk * 65 + cc + 2] = v.z; lds[kk * 65 + cc + 3] = v.w;
    }
    __syncthreads();
    {
        const int c = tid >> 3, ks = (tid & 7) * 8;
        float f[8];
#pragma unroll
        for (int e = 0; e < 8; ++e) f[e] = lds[(ks + e) * 65 + c];
        *(u32x4*)(dst + (size_t)rowmap(c0 + c) * K + k0 + ks) = pack8(f);
    }
    __syncthreads();
}

DEV void phase_prep(const Params& p) {
    unsigned char* ws = p.ws;
    bf16_t* BtIn = (bf16_t*)(ws + W_BTIN); bf16_t* BtOut = (bf16_t*)(ws + W_BTOUT); bf16_t* BtUp = (bf16_t*)(ws + W_BTUP);
    bf16_t* BtDown = (bf16_t*)(ws + W_BTDOWN); bf16_t* BtAda = (bf16_t*)(ws + W_KVT); bf16_t* WrT = (bf16_t*)(ws + W_WRT);
    constexpr int T_IN = 16 * 48, T_OUT = 16 * 16, T_UP = 16 * 44, T_DOWN = 44 * 16, T_ADA = 16 * 96, T_G = 16;
    constexpr int T_ALL = T_IN + T_OUT + 2 * T_UP + T_DOWN + T_ADA + T_G;
    for (int it = BIDX(); it < T_ALL; it += gridDim.x) {
        int r = it;
        if (r < T_ADA) { transpose_tile(p.w_ada, 6144, 1024, (r / 96) * 64, (r % 96) * 64, BtAda, [](int c) { return permpos(c); }); continue; } r -= T_ADA;
        if (r < T_IN) { transpose_tile(p.w_in, DP, 1024, (r / 48) * 64, (r % 48) * 64, BtIn, [](int c) { return permpos(c); }); continue; } r -= T_IN;
        if (r < T_OUT) { transpose_tile(p.w_out, D, 1024, (r / 16) * 64, (r % 16) * 64, BtOut, [](int c) { return permpos(c); }); continue; } r -= T_OUT;
        if (r < T_UP) { transpose_tile(p.w_upc, DFF, 1024, (r / 44) * 64, (r % 44) * 64, BtUp, [](int c) { return 256 * (c >> 7) + permpos(c & 127); }); continue; } r -= T_UP;
        if (r < T_UP) { transpose_tile(p.w_upg, DFF, 1024, (r / 44) * 64, (r % 44) * 64, BtUp, [](int c) { return 256 * (c >> 7) + 128 + permpos(c & 127); }); continue; } r -= T_UP;
        if (r < T_DOWN) { transpose_tile(p.w_down, D, DFF, (r / 16) * 64, (r % 16) * 64, BtDown, [](int c) { return permpos(c); }); continue; } r -= T_DOWN;
        { const int g = r >> 3, jb = r & 7; transpose_tile((g ? p.w_i : p.w_r) + jb * 4096, 64, 64, 0, 0, WrT + (g * 8 + jb) * 4096, [](int c) { return c; }); }
    }
    const int gt = BIDX() * 512 + TIDX(), GT = gridDim.x * 512;
    bf16_t* modA = (bf16_t*)(ws + W_MODA);
    for (int i = gt; i < NMODROWS * D; i += GT) {
        const int row = i >> 10, k = i & 1023;
        float v = 0.f;
        if (row < 8) v = siluf_(p.c_p[row * D + k]); else if (row < 136) v = siluf_(p.c_s[(row - 8) * D + k]);
        modA[i] = f2bf(v);
    }
    float* rope = (float*)(ws + W_ROPE);
    for (int i = gt; i < (TSEQ + 1) * 64; i += GT) {
        const int t = i >> 6, j = i & 63;
        const float pos = (t < TSEQ) ? (float)t : (float)PAST_LEN;
        const float invf = exp2f(-(float)(2 * j) * (13.287712379549449f / 128.f));
        const float ang = pos * invf;
        float s, c; sincosf(ang, &s, &c);
        rope[t * 128 + j] = c; rope[t * 128 + 64 + j] = s;
    }
    float* rss1 = (float*)(ws + W_RSS1); float* rss2 = (float*)(ws + W_RSS2); float* spl = (float*)(ws + W_SPL);
    for (int i = gt; i < NROWS; i += GT) { rss1[i] = 0.f; rss2[i] = 0.f; }
    for (int i = gt; i < 512; i += GT) spl[i] = 8.f * log1pf(__expf(-p.lam[i]));
}

DEV void phase_mod(const Params& p) {
    unsigned char* ws = p.ws;
    const bf16_t* modA = (const bf16_t*)(ws + W_MODA); const bf16_t* BtAda = (const bf16_t*)(ws + W_KVT); float* mod = (float*)(ws + W_MOD);
    for (int it = BIDX(); it < 256; it += gridDim.x) {
        if (it < 128) {
            const int g = it >> 1, n = it & 1;
            const bf16_t* B0 = BtAda + (size_t)(32 * g + 16 * n) * D;
            skinny_tile<9, 1, 4>(modA, D, B0, B0, D, [&](int row, int s, float v0, float v1) {
                if (row < 136) { const int c0 = 32 * g + slotcol(n, s); mod[(size_t)row * 6144 + c0] = v0 + p.b_ada[c0]; }
                return 0.f;
            });
        } else {
            const int g = 64 + (it - 128);
            const bf16_t* B0 = BtAda + (size_t)(32 * g) * D;
            skinny_tile<9, 2, 4>(modA, D, B0, B0 + 16 * D, D, [&](int row, int s, float v0, float v1) {
                if (row < 136) { const int c0 = 32 * g + slotcol(0, s), c1 = c0 + 4; mod[(size_t)row * 6144 + c0] = v0 + p.b_ada[c0]; mod[(size_t)row * 6144 + c1] = v1 + p.b_ada[c1]; }
                return 0.f;
            });
        }
    }
}

DEV void phase_norm1(const Params& p) {
    unsigned char* ws = p.ws;
    const float* mod = (const float*)(ws + W_MOD); bf16_t* H = (bf16_t*)(ws + W_H); bf16_t* shf = (bf16_t*)(ws + W_SHF);
    const int lane = TIDX() & 63, gw = BIDX() * 8 + (TIDX() >> 6), NGW = gridDim.x * 8;
    for (int row = gw; row < NROWS; row += NGW) {
        const float* xr = (row < NTOK) ? p.x_p + (size_t)row * D : p.x_s + (size_t)(row - NTOK) * D;
        const int b = (row < NTOK) ? (row >> 11) : 8 + (row - NTOK);
        const float* mrow = mod + (size_t)b * 6144;
        f32x4 v[4]; float ss = 0.f;
#pragma unroll
        for (int j = 0; j < 4; ++j) { v[j] = *(const f32x4*)(xr + 4 * lane + 256 * j); ss += v[j].x * v[j].x + v[j].y * v[j].y + v[j].z * v[j].z + v[j].w * v[j].w; }
        const float rstd = __builtin_amdgcn_rsqf(wave_sum(ss) * (1.f / D) + EPS);
#pragma unroll
        for (int j = 0; j < 4; ++j) {
            const int k = 4 * lane + 256 * j;
            const f32x4 g = *(const f32x4*)(p.g_mix + k), sh = *(const f32x4*)(mrow + k), sc = *(const f32x4*)(mrow + D + k);
            const f32x4 h = v[j] * rstd * g * (1.f + sc) + sh;
            u32x2 o; o.x = cvt_pk_bf16(h.x, h.y); o.y = cvt_pk_bf16(h.z, h.w);
            *(u32x2*)(H + (size_t)row * D + k) = o;
        }
    }
}

DEV void phase_inproj(const Params& p) {
    unsigned char* ws = p.ws;
    const bf16_t* H = (const bf16_t*)(ws + W_H); const bf16_t* BtIn = (const bf16_t*)(ws + W_BTIN); bf16_t* proj = (bf16_t*)(ws + W_PROJ);
    float* projS = (float*)(ws + W_PROJS);
    constexpr int NBIG = 64 * 12, NSK1 = 96;
    gemm_phase<false>(H, BtIn, D, 64, 12, NBIG, nullptr, [&](const f32x4 (&acc)[2][2][4][2], int pm, int pn, int brow, int bcol, int wr, int wc, int fr, int fq) {
#pragma unroll
        for (int ai = 0; ai < 2; ++ai)
#pragma unroll
            for (int m = 0; m < 4; ++m) {
                bf16_t* rp = proj + (size_t)(brow + ai * HALF + wr * 64 + m * 16 + fr) * DP + bcol + wc * 32 + 8 * fq;
#pragma unroll
                for (int bj = 0; bj < 2; ++bj) {
                    const f32x4 a = acc[ai][bj][m][0], b = acc[ai][bj][m][1];
                    u32x4 w; w.x = cvt_pk_bf16(a[0], a[1]); w.y = cvt_pk_bf16(a[2], a[3]); w.z = cvt_pk_bf16(b[0], b[1]); w.w = cvt_pk_bf16(b[2], b[3]);
                    *(u32x4*)(rp + bj * HALF) = w;
                }
            }
    });
    const bf16_t* modA = (const bf16_t*)(ws + W_MODA); const bf16_t* BtAda = (const bf16_t*)(ws + W_KVT); float* mod = (float*)(ws + W_MOD);
    SKINNY_LOOP(j, NBIG, 2 * NSK1) {
        const int g = j >> 1, n = j & 1;
        const bf16_t* B0 = BtIn + (size_t)(32 * g + 16 * n) * D;
        skinny_tile<8, 1, 4>(H + (size_t)NTOK * D, D, B0, B0, D, [&](int row, int s, float v0, float v1) {
            projS[row * DP + 32 * g + slotcol(n, s)] = v0; return 0.f;
        });
    }
}

constexpr int RP = 136;
DEV void rot8(const float* x1, const float* x2, const float* tr, int d0, float scale, float* o1, float* o2) {
    const f32x4 c0 = *(const f32x4*)(tr + d0), c1 = *(const f32x4*)(tr + d0 + 4), s0 = *(const f32x4*)(tr + 64 + d0), s1 = *(const f32x4*)(tr + 64 + d0 + 4);
    const float c[8] = {c0.x, c0.y, c0.z, c0.w, c1.x, c1.y, c1.z, c1.w}, s[8] = {s0.x, s0.y, s0.z, s0.w, s1.x, s1.y, s1.z, s1.w};
#pragma unroll
    for (int e = 0; e < 8; ++e) { o1[e] = (x1[e] * c[e] - x2[e] * s[e]) * scale; o2[e] = (x1[e] * s[e] + x2[e] * c[e]) * scale; }
}

DEV void rot8v(const u32x4 a, const u32x4 b, const f32x4 c0, const f32x4 c1, const f32x4 s0, const f32x4 s1, float scale, float* o1, float* o2) {
    float x1[8], x2[8]; unpack8(a, x1); unpack8(b, x2);
    const float c[8] = {c0.x, c0.y, c0.z, c0.w, c1.x, c1.y, c1.z, c1.w}, s[8] = {s0.x, s0.y, s0.z, s0.w, s1.x, s1.y, s1.z, s1.w};
#pragma unroll
    for (int e = 0; e < 8; ++e) { o1[e] = (x1[e] * c[e] - x2[e] * s[e]) * scale; o2[e] = (x1[e] * s[e] + x2[e] * c[e]) * scale; }
}
DEV void scatter_vT(const u32x4 w, int j, int d0, bf16_t* vT) {
    const unsigned ww[4] = {w.x, w.y, w.z, w.w};
#pragma unroll
    for (int e = 0; e < 4; ++e) { vT[(d0 + 2 * e) * RP + j] = (bf16_t)(ww[e] & 0xffffu); vT[(d0 + 2 * e + 1) * RP + j] = (bf16_t)(ww[e] >> 16); }
}
DEV void stage_vT(const bf16_t* proj, int row0, int h, bf16_t* vT) {
    for (int item = TIDX(); item < 2048; item += 512) {
        const int j = item >> 4, d0 = (item & 15) * 8;
        const u32x4 w = *(const u32x4*)(proj + (size_t)(row0 + j) * DP + 1024 + h * 128 + d0);
        const unsigned ww[4] = {w.x, w.y, w.z, w.w};
#pragma unroll
        for (int e = 0; e < 4; ++e) { vT[(d0 + 2 * e) * RP + j] = (bf16_t)(ww[e] & 0xffffu); vT[(d0 + 2 * e + 1) * RP + j] = (bf16_t)(ww[e] >> 16); }
    }
}

DEV void ret_passA(const Params& p, int unit) {
    unsigned char* ws = p.ws;
    const bf16_t* proj = (const bf16_t*)(ws + W_PROJ); const float* rope = (const float*)(ws + W_ROPE); float* KVT = (float*)(ws + W_KVT) + (size_t)unit * 16384;
    const int n = unit & 15, h = (unit >> 4) & 3, b = unit >> 6, row0 = b * TSEQ + n * 128;
    bf16_t* kT = (bf16_t*)shm_raw; bf16_t* vT = kT + 128 * RP;
    const float lg = gamma_log2(h);
    {
        const int tid = TIDX();
        u32x4 kA[2], kB[2], vv[4]; f32x4 rc[2][4];
#pragma unroll
        for (int i = 0; i < 2; ++i) {
            const int item = tid + 512 * i, j = item >> 3, d0 = (item & 7) * 8;
            const bf16_t* kr = proj + (size_t)(row0 + j) * DP + 512 + h * 128; const float* tr = rope + (size_t)(n * 128 + j) * 128;
            kA[i] = *(const u32x4*)(kr + d0); kB[i] = *(const u32x4*)(kr + 64 + d0);
            rc[i][0] = *(const f32x4*)(tr + d0); rc[i][1] = *(const f32x4*)(tr + d0 + 4); rc[i][2] = *(const f32x4*)(tr + 64 + d0); rc[i][3] = *(const f32x4*)(tr + 64 + d0 + 4);
        }
#pragma unroll
        for (int i = 0; i < 4; ++i) { const int item = tid + 512 * i, j = item >> 4, d0 = (item & 15) * 8; vv[i] = *(const u32x4*)(proj + (size_t)(row0 + j) * DP + 1024 + h * 128 + d0); }
#pragma unroll
        for (int i = 0; i < 2; ++i) {
            const int item = tid + 512 * i, j = item >> 3, d0 = (item & 7) * 8;
            float o1[8], o2[8];
            rot8v(kA[i], kB[i], rc[i][0], rc[i][1], rc[i][2], rc[i][3], 0.08838834764831845f * fexp2(lg * (float)(127 - j)), o1, o2);
#pragma unroll
            for (int e = 0; e < 8; ++e) { kT[(d0 + e) * RP + j] = f2bf(o1[e]); kT[(64 + d0 + e) * RP + j] = f2bf(o2[e]); }
        }
#pragma unroll
        for (int i = 0; i < 4; ++i) { const int item = tid + 512 * i; scatter_vT(vv[i], item >> 4, (item & 15) * 8, vT); }
    }
    __syncthreads();
    const int w = TIDX() >> 6, lane = TIDX() & 63, fr = lane & 15, fq = lane >> 4;
    f32x4 acc[8];
#pragma unroll
    for (int vb = 0; vb < 8; ++vb) acc[vb] = (f32x4){0.f, 0.f, 0.f, 0.f};
#pragma unroll
    for (int ks = 0; ks < 4; ++ks) {
        const bf16x8 a = *(const bf16x8*)(kT + (16 * w + fr) * RP + 32 * ks + 8 * fq);
#pragma unroll
        for (int vb = 0; vb < 8; ++vb) {
            const bf16x8 bb = *(const bf16x8*)(vT + (16 * vb + fr) * RP + 32 * ks + 8 * fq);
            acc[vb] = __builtin_amdgcn_mfma_f32_16x16x32_bf16(a, bb, acc[vb], 0, 0, 0);
        }
    }
#pragma unroll
    for (int vb = 0; vb < 8; ++vb) *(f32x4*)(KVT + (16 * vb + fr) * 128 + 16 * w + 4 * fq) = acc[vb];
    __syncthreads();
}

DEV void ret_passC(const Params& p, int unit) {
    unsigned char* ws = p.ws;
    const bf16_t* proj = (const bf16_t*)(ws + W_PROJ); const float* rope = (const float*)(ws + W_ROPE); bf16_t* mix = (bf16_t*)(ws + W_MIX);
    const int n = unit & 15, h = (unit >> 4) & 3, b = unit >> 6, row0 = b * TSEQ + n * 128;
    bf16_t* ks_ = (bf16_t*)shm_raw; bf16_t* vT = ks_ + 128 * RP; bf16_t* ST = vT + 128 * RP; bf16_t* P = ST + 128 * RP;
    const float lg = gamma_log2(h);
    const int tid = TIDX(), w = tid >> 6, lane = tid & 63, fr = lane & 15, fq = lane >> 4;
    const int i_loc = 16 * w + fr;
    bf16x8 qf[4];
    {
        u32x4 kA[2], kB[2], vv[4], st[4], qA[2], qB[2]; f32x4 rc[2][4], qc[2][4];
#pragma unroll
        for (int i = 0; i < 2; ++i) {
            const int item = tid + 512 * i, j = item >> 3, d0 = (item & 7) * 8;
            const bf16_t* kr = proj + (size_t)(row0 + j) * DP + 512 + h * 128; const float* tr = rope + (size_t)(n * 128 + j) * 128;
            kA[i] = *(const u32x4*)(kr + d0); kB[i] = *(const u32x4*)(kr + 64 + d0);
            rc[i][0] = *(const f32x4*)(tr + d0); rc[i][1] = *(const f32x4*)(tr + d0 + 4); rc[i][2] = *(const f32x4*)(tr + 64 + d0); rc[i][3] = *(const f32x4*)(tr + 64 + d0 + 4);
        }
#pragma unroll
        for (int i = 0; i < 4; ++i) { const int item = tid + 512 * i, j = item >> 4, d0 = (item & 15) * 8; vv[i] = *(const u32x4*)(proj + (size_t)(row0 + j) * DP + 1024 + h * 128 + d0); }
        {
            const int dv = tid >> 2, sg = tid & 3;
            const bf16_t* src = (const bf16_t*)(ws + W_H) + (size_t)unit * 16384 + dv * 128 + sg * 32;
#pragma unroll
            for (int i = 0; i < 4; ++i) st[i] = *(const u32x4*)(src + 8 * i);
        }
        {
            const bf16_t* qr = proj + (size_t)(row0 + i_loc) * DP + h * 128; const float* tr = rope + (size_t)(n * 128 + i_loc) * 128;
#pragma unroll
            for (int kk = 0; kk < 2; ++kk) {
                const int d0 = 32 * kk + 8 * fq;
                qA[kk] = *(const u32x4*)(qr + d0); qB[kk] = *(const u32x4*)(qr + 64 + d0);
                qc[kk][0] = *(const f32x4*)(tr + d0); qc[kk][1] = *(const f32x4*)(tr + d0 + 4); qc[kk][2] = *(const f32x4*)(tr + 64 + d0); qc[kk][3] = *(const f32x4*)(tr + 64 + d0 + 4);
            }
        }
#pragma unroll
        for (int i = 0; i < 2; ++i) {
            const int item = tid + 512 * i, j = item >> 3, d0 = (item & 7) * 8;
            float o1[8], o2[8];
            rot8v(kA[i], kB[i], rc[i][0], rc[i][1], rc[i][2], rc[i][3], 0.08838834764831845f, o1, o2);
            *(u32x4*)(ks_ + j * RP + d0) = pack8(o1); *(u32x4*)(ks_ + j * RP + 64 + d0) = pack8(o2);
        }
#pragma unroll
        for (int i = 0; i < 4; ++i) { const int item = tid + 512 * i; scatter_vT(vv[i], item >> 4, (item & 15) * 8, vT); }
        {
            const int dv = tid >> 2, sg = tid & 3;
#pragma unroll
            for (int i = 0; i < 4; ++i) *(u32x4*)(ST + dv * RP + sg * 32 + 8 * i) = st[i];
        }
#pragma unroll
        for (int kk = 0; kk < 2; ++kk) {
            float o1[8], o2[8];
            rot8v(qA[kk], qB[kk], qc[kk][0], qc[kk][1], qc[kk][2], qc[kk][3], 1.f, o1, o2);
            const u32x4 a = pack8(o1), c = pack8(o2);
            qf[kk] = __builtin_bit_cast(bf16x8, a); qf[kk + 2] = __builtin_bit_cast(bf16x8, c);
        }
    }
    __syncthreads();
#pragma unroll
    for (int jb = 0; jb < 8; ++jb) {
        u32x2 o; o.x = 0u; o.y = 0u;
        if (jb <= w) {
            f32x4 sc = (f32x4){0.f, 0.f, 0.f, 0.f};
#pragma unroll
            for (int kk = 0; kk < 4; ++kk) {
                const bf16x8 a = *(const bf16x8*)(ks_ + (16 * jb + fr) * RP + 32 * kk + 8 * fq);
                sc = __builtin_amdgcn_mfma_f32_16x16x32_bf16(a, qf[kk], sc, 0, 0, 0);
            }
            float pv[4];
#pragma unroll
            for (int r = 0; r < 4; ++r) { const int dj = i_loc - (16 * jb + 4 * fq + r); pv[r] = dj >= 0 ? sc[r] * fexp2(lg * (float)dj) : 0.f; }
            o.x = cvt_pk_bf16(pv[0], pv[1]); o.y = cvt_pk_bf16(pv[2], pv[3]);
        }
        *(u32x2*)(P + i_loc * RP + 16 * jb + 4 * fq) = o;
    }
    __syncthreads();
    f32x4 a1[8], a2[8];
#pragma unroll
    for (int vb = 0; vb < 8; ++vb) { a1[vb] = (f32x4){0.f, 0.f, 0.f, 0.f}; a2[vb] = (f32x4){0.f, 0.f, 0.f, 0.f}; }
    for (int kk = 0; kk <= (w >> 1); ++kk) {
        const bf16x8 pb = *(const bf16x8*)(P + i_loc * RP + 32 * kk + 8 * fq);
#pragma unroll
        for (int vb = 0; vb < 8; ++vb) {
            const bf16x8 a = *(const bf16x8*)(vT + (16 * vb + fr) * RP + 32 * kk + 8 * fq);
            a1[vb] = __builtin_amdgcn_mfma_f32_16x16x32_bf16(a, pb, a1[vb], 0, 0, 0);
        }
    }
#pragma unroll
    for (int kk = 0; kk < 4; ++kk) {
#pragma unroll
        for (int vb = 0; vb < 8; ++vb) {
            const bf16x8 a = *(const bf16x8*)(ST + (16 * vb + fr) * RP + 32 * kk + 8 * fq);
            a2[vb] = __builtin_amdgcn_mfma_f32_16x16x32_bf16(a, qf[kk], a2[vb], 0, 0, 0);
        }
    }
    const float qd = fexp2(lg * (float)(i_loc + 1));
    float sum = 0.f;
#pragma unroll
    for (int vb = 0; vb < 8; ++vb) { a1[vb] = a1[vb] + qd * a2[vb]; sum += (a1[vb].x + a1[vb].y) + (a1[vb].z + a1[vb].w); }
    sum += __shfl_xor(sum, 16); sum += __shfl_xor(sum, 32);
    const float mu = sum * (1.f / 128.f);
    float var = 0.f;
#pragma unroll
    for (int vb = 0; vb < 8; ++vb) { const f32x4 d = a1[vb] - mu; var += (d.x * d.x + d.y * d.y) + (d.z * d.z + d.w * d.w); }
    var += __shfl_xor(var, 16); var += __shfl_xor(var, 32);
    const float rstd = __builtin_amdgcn_rsqf(var * (1.f / 128.f) + EPS);
    const bf16_t* gr = proj + (size_t)(row0 + i_loc) * DP + 1536 + h * 128 + 4 * fq;
    bf16_t* orow = mix + (size_t)(row0 + i_loc) * D + h * 128 + 4 * fq;
    u32x2 gg[8];
#pragma unroll
    for (int vb = 0; vb < 8; ++vb) gg[vb] = *(const u32x2*)(gr + 16 * vb);
#pragma unroll
    for (int vb = 0; vb < 8; ++vb) {
        const u32x2 g = gg[vb];
        const f32x4 d = (a1[vb] - mu) * rstd;
        u32x2 o; o.x = cvt_pk_bf16(d.x * siluf_(bflo(g.x)), d.y * siluf_(bfhi(g.x))); o.y = cvt_pk_bf16(d.z * siluf_(bflo(g.y)), d.w * siluf_(bfhi(g.y)));
        *(u32x2*)(orow + 16 * vb) = o;
    }
    __syncthreads();
}

#define LBAR() do { asm volatile("s_waitcnt lgkmcnt(0)" ::: "memory"); __builtin_amdgcn_s_barrier(); asm volatile("" ::: "memory"); } while (0)
template <bool FINAL>
DEV void lru_phase(const Params& p) {
    unsigned char* ws = p.ws;
    const bf16_t* proj = (const bf16_t*)(ws + W_PROJ); bf16_t* mix = (bf16_t*)(ws + W_MIX); const bf16_t* WrT = (const bf16_t*)(ws + W_WRT);
    const float* spl = (const float*)(ws + W_SPL); float* agg = (float*)(ws + W_AGG); const float* hin0g = (const float*)(ws + W_HIN0);
    float* xcf = (float*)shm_raw;
    constexpr int XP = 68;
    float* af = xcf + 128 * XP;
    bf16_t* xcb = (bf16_t*)(af + 128 * XP);
    float* segA = (float*)(xcb + 128 * 72);
    float* segB = segA + 512;
    float* hin = segB + 512;
    bf16_t* wT = (bf16_t*)(hin + 512);
    float* cwL = (float*)(wT + 2 * 64 * 72);
    bf16_t* gbuf = (bf16_t*)(cwL + 8 * 64);
    const int tid = TIDX(), w = tid >> 6, lane = tid & 63, fr = lane & 15, fq = lane >> 4;
    const int tt = tid >> 2, e0 = (tid & 3) * 16;
    int key = -1;
    u32x4 xr[4][2]; u32x4 gr[2]; float h0 = 0.f;
    auto prefetch = [&](int unit) {
        const int c = unit & 15, jb = (unit >> 4) & 7, b = unit >> 7, ch0 = 64 * jb;
#pragma unroll
        for (int k = 0; k < 4; ++k) {
            const int tabs = c * 128 + tt - 3 + k;
            xr[k][0] = (u32x4){0u, 0u, 0u, 0u}; xr[k][1] = xr[k][0];
            if (tabs >= 0) { const bf16_t* xp = proj + (size_t)(b * TSEQ + tabs) * DP + 2048 + ch0 + e0; xr[k][0] = *(const u32x4*)xp; xr[k][1] = *(const u32x4*)(xp + 8); }
        }
        if (FINAL) {
            const bf16_t* gp = proj + (size_t)(b * TSEQ + c * 128 + tt) * DP + 2560 + ch0 + e0; gr[0] = *(const u32x4*)gp; gr[1] = *(const u32x4*)(gp + 8);
            if (tid < 64) h0 = hin0g[(size_t)unit * 64 + tid];
        }
    };
    int it = BIDX();
    if (it < 1024) prefetch(it);
    for (; it < 1024; it += gridDim.x) {
        const int unit = it, c = unit & 15, jb = (unit >> 4) & 7, b = unit >> 7, row0 = b * TSEQ + c * 128, ch0 = 64 * jb;
        if ((unit & 127) != key) {
            key = unit & 127;
            { const int g = tid >> 8, e = (tid >> 2) & 63, sg = tid & 3; const bf16_t* src = WrT + (size_t)((g * 8 + jb) * 64 + e) * 64 + sg * 16;
              *(u32x4*)(wT + (g * 64 + e) * 72 + sg * 16) = *(const u32x4*)src; *(u32x4*)(wT + (g * 64 + e) * 72 + sg * 16 + 8) = *(const u32x4*)(src + 8); }
            { const int q = tid >> 6, e = tid & 63; float v;
              if (q < 4) v = p.cl_w[q * DLRU + ch0 + e]; else if (q == 4) v = p.cl_b[ch0 + e]; else if (q == 5) v = p.b_r[ch0 + e]; else if (q == 6) v = p.b_i[ch0 + e]; else v = spl[ch0 + e];
              cwL[q * 64 + e] = v; }
            LBAR();
        }
        {
            float accv[16];
#pragma unroll
            for (int i = 0; i < 4; ++i) { const f32x4 cb = *(const f32x4*)(cwL + 4 * 64 + e0 + 4 * i); accv[4 * i] = cb.x; accv[4 * i + 1] = cb.y; accv[4 * i + 2] = cb.z; accv[4 * i + 3] = cb.w; }
#pragma unroll
            for (int k = 0; k < 4; ++k) {
                float xv[16]; unpack8(xr[k][0], xv); unpack8(xr[k][1], xv + 8);
#pragma unroll
                for (int i = 0; i < 4; ++i) { const f32x4 cw = *(const f32x4*)(cwL + k * 64 + e0 + 4 * i);
                    accv[4 * i] += cw.x * xv[4 * i]; accv[4 * i + 1] += cw.y * xv[4 * i + 1]; accv[4 * i + 2] += cw.z * xv[4 * i + 2]; accv[4 * i + 3] += cw.w * xv[4 * i + 3]; }
            }
#pragma unroll
            for (int i = 0; i < 4; ++i) *(f32x4*)(xcf + tt * XP + e0 + 4 * i) = (f32x4){accv[4 * i], accv[4 * i + 1], accv[4 * i + 2], accv[4 * i + 3]};
            *(u32x4*)(xcb + tt * 72 + e0) = pack8(accv); *(u32x4*)(xcb + tt * 72 + e0 + 8) = pack8(accv + 8);
            if (FINAL) { *(u32x4*)(gbuf + tt * 64 + e0) = gr[0]; *(u32x4*)(gbuf + tt * 64 + e0 + 8) = gr[1]; }
        }
        const float h0u = h0;
        if (it + (int)gridDim.x < 1024) prefetch(it + gridDim.x);
        LBAR();
        {
            const int t = 16 * w + fr;
            bf16x8 xb[2];
#pragma unroll
            for (int kk = 0; kk < 2; ++kk) xb[kk] = *(const bf16x8*)(xcb + t * 72 + 32 * kk + 8 * fq);
            const bool first = (c == 0 && t == 0);
#pragma unroll
            for (int eb = 0; eb < 4; ++eb) {
                f32x4 ar = (f32x4){0.f, 0.f, 0.f, 0.f}, ai = (f32x4){0.f, 0.f, 0.f, 0.f};
#pragma unroll
                for (int kk = 0; kk < 2; ++kk) {
                    const bf16x8 wr_ = *(const bf16x8*)(wT + (16 * eb + fr) * 72 + 32 * kk + 8 * fq);
                    const bf16x8 wi_ = *(const bf16x8*)(wT + (64 + 16 * eb + fr) * 72 + 32 * kk + 8 * fq);
                    ar = __builtin_amdgcn_mfma_f32_16x16x32_bf16(wr_, xb[kk], ar, 0, 0, 0);
                    ai = __builtin_amdgcn_mfma_f32_16x16x32_bf16(wi_, xb[kk], ai, 0, 0, 0);
                }
                const int e = 16 * eb + 4 * fq;
                const f32x4 br = *(const f32x4*)(cwL + 5 * 64 + e), bi = *(const f32x4*)(cwL + 6 * 64 + e), sp = *(const f32x4*)(cwL + 7 * 64 + e);
                const f32x4 xc4 = *(const f32x4*)(xcf + t * XP + e);
                f32x4 av, bv;
#pragma unroll
                for (int r = 0; r < 4; ++r) {
                    const float rr = sigmoidf_(ar[r] + br[r]), ii = sigmoidf_(ai[r] + bi[r]);
                    const float la = -sp[r] * rr, a = fexp2(1.4426950408889634f * la);
                    const float em = __builtin_fmaf(-a, a, 1.f);
                    const float mult = first ? 1.f : __builtin_amdgcn_sqrtf(em);
                    av[r] = a; bv[r] = mult * ii * xc4[r];
                }
                *(f32x4*)(af + t * XP + e) = av; *(f32x4*)(xcf + t * XP + e) = bv;
            }
        }
        LBAR();
        const int e = tid & 63, seg = tid >> 6;
        {
            float A = 1.f, B = 0.f;
#pragma unroll
            for (int i = 0; i < 16; ++i) { const int t = seg * 16 + i; const float a = af[t * XP + e]; B = a * B + xcf[t * XP + e]; A *= a; }
            segA[seg * 64 + e] = A; segB[seg * 64 + e] = B;
        }
        LBAR();
        if (!FINAL) {
            if (tid < 64) {
                float A = 1.f, B = 0.f;
#pragma unroll
                for (int s = 0; s < 8; ++s) { const float a = segA[s * 64 + tid]; B = a * B + segB[s * 64 + tid]; A *= a; }
                agg[(size_t)unit * 128 + tid] = A; agg[(size_t)unit * 128 + 64 + tid] = B;
            }
        } else {
            if (tid < 64) {
                float hh = h0u;
#pragma unroll
                for (int s = 0; s < 8; ++s) { hin[s * 64 + tid] = hh; hh = segA[s * 64 + tid] * hh + segB[s * 64 + tid]; }
            }
            LBAR();
            float hh = hin[seg * 64 + e];
#pragma unroll
            for (int i = 0; i < 16; ++i) {
                const int t = seg * 16 + i;
                hh = af[t * XP + e] * hh + xcf[t * XP + e];
                gbuf[t * 64 + e] = f2bf(hh * geluf_(bf2f(gbuf[t * 64 + e])));
            }
            if (c == 15 && seg == 7) {
                p.out[O_LHP + b * 512 + ch0 + e] = hh;
#pragma unroll
                for (int k = 0; k < 3; ++k) p.out[O_LCP + (size_t)(b * 3 + k) * 512 + ch0 + e] = bf2f(proj[(size_t)(b * TSEQ + 2045 + k) * DP + 2048 + ch0 + e]);
            }
            LBAR();
            { bf16_t* op = mix + (size_t)(row0 + tt) * D + 512 + ch0 + e0; *(u32x4*)op = *(const u32x4*)(gbuf + tt * 64 + e0); *(u32x4*)(op + 8) = *(const u32x4*)(gbuf + tt * 64 + e0 + 8); }
        }
        LBAR();
    }
    __syncthreads();
}

DEV void phase_scan(const Params& p) {
    unsigned char* ws = p.ws;
    const float* KVT = (const float*)(ws + W_KVT); bf16_t* STg = (bf16_t*)(ws + W_H);
    const float* agg = (const float*)(ws + W_AGG); float* hin0g = (float*)(ws + W_HIN0);
    const int gt = BIDX() * 512 + TIDX(), GT = gridDim.x * 512;
    for (int gid = gt; gid < 32 * 4096; gid += GT) {
        const int bh = gid >> 12, idx = gid & 4095, dv = idx >> 5, dk0 = (idx & 31) * 4, h = bh & 3;
        const float cd = exp2f(gamma_log2(h) * 128.f);
        const float* src = KVT + (size_t)bh * 16 * 16384 + dv * 128 + dk0;
        f32x4 kv[16];
#pragma unroll
        for (int m = 0; m < 16; ++m) kv[m] = *(const f32x4*)(src + (size_t)m * 16384);
        f32x4 S = (f32x4){0.f, 0.f, 0.f, 0.f};
        bf16_t* dst = STg + (size_t)bh * 16 * 16384 + dv * 128 + dk0;
#pragma unroll
        for (int m = 0; m < 16; ++m) {
            u32x2 o; o.x = cvt_pk_bf16(S.x, S.y); o.y = cvt_pk_bf16(S.z, S.w);
            *(u32x2*)(dst + (size_t)m * 16384) = o;
            S = S * cd + kv[m];
        }
        float* rp = p.out + O_RETP + (size_t)bh * 16384 + dv;
        rp[(dk0 + 0) * 128] = S.x; rp[(dk0 + 1) * 128] = S.y; rp[(dk0 + 2) * 128] = S.z; rp[(dk0 + 3) * 128] = S.w;
    }
    for (int gid = gt; gid < 64 * 64; gid += GT) {
        const int bjb = gid >> 6, e = gid & 63;
        float A[16], B[16];
#pragma unroll
        for (int c = 0; c < 16; ++c) { A[c] = agg[(size_t)(bjb * 16 + c) * 128 + e]; B[c] = agg[(size_t)(bjb * 16 + c) * 128 + 64 + e]; }
        float hh = 0.f;
#pragma unroll
        for (int c = 0; c < 16; ++c) { hin0g[(size_t)(bjb * 16 + c) * 64 + e] = hh; hh = A[c] * hh + B[c]; }
    }
}

DEV void sample_ret2(const Params& p, int unit) {
    unsigned char* ws = p.ws;
    const float* projS = (const float*)(ws + W_PROJS); const float* rope = (const float*)(ws + W_ROPE) + (size_t)TSEQ * 128; bf16_t* mix = (bf16_t*)(ws + W_MIX);
    const int h = unit & 3, b = unit >> 2, tid = TIDX();
    float* qs = (float*)shm_raw; float* ks = qs + 128; float* vs = ks + 128; float* part = vs + 128;
    float* red = part + 16 * 128;
    const float* pr = projS + (size_t)b * DP;
    const float gam = 1.f - exp2f(-5.f - (float)h);
    if (tid < 64) {
        const float c = rope[tid], s = rope[64 + tid];
        const float q1 = pr[h * 128 + tid], q2 = pr[h * 128 + 64 + tid], k1 = pr[512 + h * 128 + tid], k2 = pr[512 + h * 128 + 64 + tid];
        const float qa = q1 * c - q2 * s, qb = q1 * s + q2 * c, ka = (k1 * c - k2 * s) * 0.08838834764831845f, kb = (k1 * s + k2 * c) * 0.08838834764831845f;
        qs[tid] = qa; qs[64 + tid] = qb; ks[tid] = ka; ks[64 + tid] = kb;
        const float qkp = wave_sum(qa * ka + qb * kb);
        if (tid == 0) red[4] = qkp;
    } else if (tid < 192) vs[tid - 64] = pr[1024 + h * 128 + tid - 64];
    __syncthreads();
    {
        const int dv4 = (tid & 31) * 4, dkg = tid >> 5;
        const f32x4 v4 = *(const f32x4*)(vs + dv4);
        const float* S0 = p.st_ret + (size_t)unit * 16384; float* S1 = p.out + O_RETS + (size_t)unit * 16384;
        f32x4 po = (f32x4){0.f, 0.f, 0.f, 0.f};
        f32x4 s0[8];
#pragma unroll
        for (int i = 0; i < 8; ++i) s0[i] = *(const f32x4*)(S0 + (dkg * 8 + i) * 128 + dv4);
#pragma unroll
        for (int i = 0; i < 8; ++i) {
            const int dk = dkg * 8 + i;
            *(f32x4*)(S1 + dk * 128 + dv4) = s0[i] * gam + ks[dk] * v4;
            po = po + qs[dk] * s0[i];
        }
        *(f32x4*)(part + dkg * 128 + dv4) = po;
    }
    __syncthreads();
    float o = 0.f;
    if (tid < 128) {
        const float qk = red[4];
#pragma unroll
        for (int g = 0; g < 16; ++g) o += part[g * 128 + tid];
        o = qk * vs[tid] + gam * o;
        const float s1 = wave_sum(o);
        if ((tid & 63) == 0) red[tid >> 6] = s1;
    }
    __syncthreads();
    float mu = 0.f, dlt = 0.f;
    if (tid < 128) {
        mu = (red[0] + red[1]) * (1.f / 128.f); dlt = o - mu;
        const float s2 = wave_sum(dlt * dlt);
        if ((tid & 63) == 0) red[2 + (tid >> 6)] = s2;
    }
    __syncthreads();
    if (tid < 128) {
        const float rstd = __builtin_amdgcn_rsqf((red[2] + red[3]) * (1.f / 128.f) + EPS);
        const float g = pr[1536 + h * 128 + tid];
        mix[(size_t)(NTOK + b) * D + h * 128 + tid] = f2bf(dlt * rstd * siluf_(g));
    }
    __syncthreads();
}

DEV void sample_lru(const Params& p, int b) {
    unsigned char* ws = p.ws;
    const float* projS = (const float*)(ws + W_PROJS); bf16_t* mix = (bf16_t*)(ws + W_MIX); const float* spl = (const float*)(ws + W_SPL);
    float* xcS = (float*)shm_raw;
    const int ch = TIDX();
    const float* pr = projS + (size_t)b * DP;
    const float s0 = p.st_cl[(size_t)(b * 3 + 0) * 512 + ch], s1 = p.st_cl[(size_t)(b * 3 + 1) * 512 + ch], s2 = p.st_cl[(size_t)(b * 3 + 2) * 512 + ch], x = pr[2048 + ch];
    const float xc = p.cl_b[ch] + p.cl_w[ch] * s0 + p.cl_w[512 + ch] * s1 + p.cl_w[1024 + ch] * s2 + p.cl_w[1536 + ch] * x;
    xcS[ch] = xc;
    __syncthreads();
    const int jb = ch >> 6, e = ch & 63;
    float pr_ = 0.f, pi_ = 0.f;
    const float* wr = p.w_r + (size_t)jb * 4096 + e; const float* wi = p.w_i + (size_t)jb * 4096 + e;
#pragma unroll 8
    for (int d = 0; d < 64; ++d) { const float xv = xcS[64 * jb + d]; pr_ += xv * wr[d * 64]; pi_ += xv * wi[d * 64]; }
    const float rr = sigmoidf_(pr_ + p.b_r[ch]), ii = sigmoidf_(pi_ + p.b_i[ch]);
    const float la = -spl[ch] * rr, a = __expf(la), mult = sqrtf(-expm1f(2.f * la));
    const float hh = a * p.st_h[(size_t)b * 512 + ch] + mult * ii * xc;
    p.out[O_LHS + (size_t)b * 512 + ch] = hh;
    p.out[O_LCS + (size_t)(b * 3 + 0) * 512 + ch] = s1; p.out[O_LCS + (size_t)(b * 3 + 1) * 512 + ch] = s2; p.out[O_LCS + (size_t)(b * 3 + 2) * 512 + ch] = x;
    mix[(size_t)(NTOK + b) * D + 512 + ch] = f2bf(hh * geluf_(pr[2560 + ch]));
    __syncthreads();
}

DEV void phase_mixA(const Params& p) {
    constexpr int N1 = 512, N3 = 512, N4 = 128;
    {
        const float* mod = (const float*)(p.ws + W_MOD); bf16_t* shf = (bf16_t*)(p.ws + W_SHF);
        const int gt = BIDX() * 512 + TIDX(), GT = gridDim.x * 512;
        for (int i = gt; i < NMODROWS * D; i += GT) { const int row = i >> 10, k = i & 1023; shf[i] = f2bf(row < 136 ? mod[(size_t)row * 6144 + 3 * D + k] : 0.f); }
    }
    lru_phase<false>(p);
    for (int it = BIDX(); it < N1 + N3 + N4; it += gridDim.x) {
        if (it < N1) ret_passA(p, it);
        else if (it < N1 + N3) sample_ret2(p, it - N1);
        else sample_lru(p, it - N1 - N3);
    }
}
DEV void phase_mixC(const Params& p) {
    constexpr int N1 = 512;
    lru_phase<true>(p);
    for (int it = BIDX(); it < N1; it += gridDim.x) {
        { const int u = it; const int n = u & 15; const int nn = (((u >> 4) ^ (u >> 8)) & 1) ? 15 - n : n; ret_passC(p, (u & ~15) | nn); }
    }
}

DEV void phase_outproj(const Params& p) {
    unsigned char* ws = p.ws;
    const bf16_t* mix = (const bf16_t*)(ws + W_MIX); const bf16_t* BtOut = (const bf16_t*)(ws + W_BTOUT); bf16_t* xs = (bf16_t*)(ws + W_H);
    const float* mod = (const float*)(ws + W_MOD); float* rss1 = (float*)(ws + W_RSS1);
    constexpr int NBIG = 64 * 4;
    gemm_phase<false>(mix, BtOut, D, 64, 4, NBIG, nullptr, [&](const f32x4 (&acc)[2][2][4][2], int pm, int pn, int brow, int bcol, int wr, int wc, int fr, int fq) {
                const int b = brow >> 11;
                const float* mrow = mod + (size_t)b * 6144;
                f32x4 gt[2][2], sf[2][2];
#pragma unroll
                for (int bj = 0; bj < 2; ++bj)
#pragma unroll
                    for (int n = 0; n < 2; ++n) {
                        const int col = bcol + bj * HALF + wc * 32 + 8 * fq + 4 * n;
                        gt[bj][n] = *(const f32x4*)(mrow + 2 * D + col);
                        sf[bj][n] = *(const f32x4*)(p.g_ffn + col) * (1.f + *(const f32x4*)(mrow + 4 * D + col));
                    }
#pragma unroll
                for (int ai = 0; ai < 2; ++ai)
#pragma unroll
                    for (int m = 0; m < 4; ++m) {
                        const int row = brow + ai * HALF + wr * 64 + m * 16 + fr;
                        float ss = 0.f;
#pragma unroll
                        for (int bj = 0; bj < 2; ++bj) {
                            const int col = bcol + bj * HALF + wc * 32 + 8 * fq;
                            f32x4 y[2];
#pragma unroll
                            for (int n = 0; n < 2; ++n) {
                                y[n] = *(const f32x4*)(p.x_p + (size_t)row * D + col + 4 * n) + gt[bj][n] * acc[ai][bj][m][n];
                                ss += (y[n].x * y[n].x + y[n].y * y[n].y) + (y[n].z * y[n].z + y[n].w * y[n].w);
                                y[n] = y[n] * sf[bj][n];
                            }
                            u32x4 w; w.x = cvt_pk_bf16(y[0].x, y[0].y); w.y = cvt_pk_bf16(y[0].z, y[0].w); w.z = cvt_pk_bf16(y[1].x, y[1].y); w.w = cvt_pk_bf16(y[1].z, y[1].w);
                            *(u32x4*)(xs + (size_t)row * D + col) = w;
                        }
                        ss += __shfl_xor(ss, 16); ss += __shfl_xor(ss, 32);
                        if (fq == 0) atomicAdd(rss1 + row, ss);
                    }
            });
    const bf16_t* BtUp = (const bf16_t*)(ws + W_BTUP); const bf16_t* shf = (const bf16_t*)(ws + W_SHF); float* sW = (float*)(ws + W_SW);
    SKINNY_LOOP(j, NBIG, 64 + 176) {
        if (j < 64) {
            const int g = j >> 1, n = j & 1;
            const bf16_t* B0 = BtOut + (size_t)(32 * g + 16 * n) * D;
            skinny_tile<8, 1, 4>(mix + (size_t)NTOK * D, D, B0, B0, D, [&](int row, int s, float v0, float v1) {
                const float* mrow = mod + (size_t)(8 + row) * 6144;
                const int c0 = 32 * g + slotcol(n, s);
                const float y0 = p.x_s[(size_t)row * D + c0] + mrow[2 * D + c0] * v0;
                p.out[O_YS + (size_t)row * D + c0] = y0;
                xs[(size_t)(NTOK + row) * D + c0] = f2bf(y0 * p.g_ffn[c0] * (1.f + mrow[4 * D + c0]));
                return y0 * y0;
            }, [&](int row, float ss) { atomicAdd(rss1 + NTOK + row, ss); });
        } else {
            const int t = j - 64, pn = t >> 3, bj = (t >> 2) & 1, g4 = t & 3;
            const bf16_t* B0 = BtUp + (size_t)(256 * pn + 128 * bj + 32 * g4) * D;
            skinny_tile<9, 2, 4>(shf, D, B0, B0 + 16 * D, D, [&](int row, int s, float v0, float v1) {
                const int c0 = bj * DFF + 128 * pn + 32 * g4 + slotcol(0, s); sW[(size_t)row * (2 * DFF) + c0] = v0; sW[(size_t)row * (2 * DFF) + c0 + 4] = v1; return 0.f;
            });
        }
    }
}

DEV void phase_up(const Params& p) {
    unsigned char* ws = p.ws;
    const bf16_t* xs = (const bf16_t*)(ws + W_H); const bf16_t* BtUp = (const bf16_t*)(ws + W_BTUP); bf16_t* fin = (bf16_t*)(ws + W_PROJ);
    const float* sW = (const float*)(ws + W_SW); const float* rss1 = (const float*)(ws + W_RSS1);
    float* edgeU = (float*)(ws + W_EDGEU); float* edgeG = (float*)(ws + W_EDGEG); float* tailU = (float*)(ws + W_TAILU);
    constexpr int NBIG = 64 * 22, NSK = 176;
    gemm_phase<false>(xs, BtUp, D, 64, 22, NBIG, nullptr, [&](f32x4 (&acc)[2][2][4][2], int pm, int pn, int brow, int bcol, int wr, int wc, int fr, int fq) {
        float* halo = (float*)(shm_raw + 131072);
        const int b = brow >> 11;
        const int ff0 = 128 * pn + wc * 32 + 8 * fq;
        const int cl0 = wc * 32 + 8 * fq;
        {
            f32x4 swc[2], swg[2];
#pragma unroll
            for (int n = 0; n < 2; ++n) { swc[n] = *(const f32x4*)(sW + (size_t)b * (2 * DFF) + ff0 + 4 * n); swg[n] = *(const f32x4*)(sW + (size_t)b * (2 * DFF) + DFF + ff0 + 4 * n); }
#pragma unroll
            for (int ai = 0; ai < 2; ++ai)
#pragma unroll
                for (int m = 0; m < 4; ++m) {
                    const int rl = ai * HALF + wr * 64 + m * 16 + fr;
                    const float rstd = __builtin_amdgcn_rsqf(rss1[brow + rl] * (1.f / D) + EPS);
#pragma unroll
                    for (int n = 0; n < 2; ++n) { acc[ai][0][m][n] = acc[ai][0][m][n] * rstd + swc[n]; acc[ai][1][m][n] = acc[ai][1][m][n] * rstd + swg[n]; }
                }
        }
        if (fr >= 14) {
#pragma unroll
            for (int ai = 0; ai < 2; ++ai)
#pragma unroll
                for (int n = 0; n < 2; ++n) *(f32x4*)(halo + ((ai * 2 + wr) * 2 + fr - 14) * 128 + cl0 + 4 * n) = acc[ai][0][3][n];
        }
        __syncthreads();
        {
            f32x4 cw0[2], cw1[2], cw2[2], cb[2];
#pragma unroll
            for (int n = 0; n < 2; ++n) {
                cw0[n] = *(const f32x4*)(p.cf_w + ff0 + 4 * n); cw1[n] = *(const f32x4*)(p.cf_w + DFF + ff0 + 4 * n); cw2[n] = *(const f32x4*)(p.cf_w + 2 * DFF + ff0 + 4 * n);
                cb[n] = *(const f32x4*)(p.cf_b + ff0 + 4 * n);
            }
#pragma unroll
            for (int ai = 0; ai < 2; ++ai) {
                const int st = ai * 2 + wr;
                f32x4 um1[2];
#pragma unroll
                for (int n = 0; n < 2; ++n) {
                    um1[n] = (f32x4){0.f, 0.f, 0.f, 0.f};
                    if (st > 0 && fr >= 14) um1[n] = *(const f32x4*)(halo + ((st - 1) * 2 + fr - 14) * 128 + cl0 + 4 * n);
                }
#pragma unroll
                for (int m = 0; m < 4; ++m) {
                    const int rl = ai * HALF + wr * 64 + m * 16 + fr;
                    unsigned wv[4];
#pragma unroll
                    for (int n = 0; n < 2; ++n) {
                        const f32x4 u = acc[ai][0][m][n], g = acc[ai][1][m][n];
                        f32x4 p1, p2;
#pragma unroll
                        for (int c = 0; c < 4; ++c) { p1[c] = dpp_shr1(dpp_ror1(um1[n][c]), u[c]); p2[c] = dpp_shr2(dpp_ror2(um1[n][c]), u[c]); }
                        const f32x4 uc = cb[n] + cw0[n] * p2 + cw1[n] * p1 + cw2[n] * u;
                        wv[2 * n] = cvt_pk_bf16(geluf_(uc.x) * g.x, geluf_(uc.y) * g.y); wv[2 * n + 1] = cvt_pk_bf16(geluf_(uc.z) * g.z, geluf_(uc.w) * g.w);
                        um1[n] = u;
                    }
                    if (rl >= 2) {
                        u32x4 w; w.x = wv[0]; w.y = wv[1]; w.z = wv[2]; w.w = wv[3];
                        *(u32x4*)(fin + (size_t)(brow + rl) * DFF + ff0) = w;
                    } else {
#pragma unroll
                        for (int n = 0; n < 2; ++n) {
                            *(f32x4*)(edgeU + (size_t)(pm * 2 + rl) * DFF + ff0 + 4 * n) = acc[ai][0][m][n];
                            *(f32x4*)(edgeG + (size_t)(pm * 2 + rl) * DFF + ff0 + 4 * n) = acc[ai][1][m][n];
                        }
                    }
                    if (rl >= 254) {
#pragma unroll
                        for (int n = 0; n < 2; ++n) {
                            *(f32x4*)(tailU + (size_t)(pm * 2 + rl - 254) * DFF + ff0 + 4 * n) = acc[ai][0][m][n];
                            if ((pm & 7) == 7) *(f32x4*)(p.out + O_FCP + (size_t)(b * 2 + rl - 254) * DFF + ff0 + 4 * n) = acc[ai][0][m][n];
                        }
                    }
                }
            }
        }
    });
    SKINNY_LOOP(j, NBIG, NSK) {
            const int t = j, pn = t >> 3, g4 = (t >> 1) & 3, n = t & 1;
            const bf16_t* B0 = BtUp + (size_t)(256 * pn + 32 * g4 + 16 * n) * D;
            skinny_tile<8, 2, 4>(xs + (size_t)NTOK * D, D, B0, B0 + 128 * D, D, [&](int row, int s, float v0, float v1) {
                const int ff = 128 * pn + 32 * g4 + slotcol(n, s);
                const float rstd = __builtin_amdgcn_rsqf(rss1[NTOK + row] * (1.f / D) + EPS);
                const float u = v0 * rstd + sW[(size_t)(8 + row) * (2 * DFF) + ff], g = v1 * rstd + sW[(size_t)(8 + row) * (2 * DFF) + DFF + ff];
                const float s0 = p.st_cf[(size_t)(row * 2 + 0) * DFF + ff], s1 = p.st_cf[(size_t)(row * 2 + 1) * DFF + ff];
                const float uc = p.cf_b[ff] + p.cf_w[ff] * s0 + p.cf_w[DFF + ff] * s1 + p.cf_w[2 * DFF + ff] * u;
                fin[(size_t)(NTOK + row) * DFF + ff] = f2bf(geluf_(uc) * g);
                p.out[O_FCS + (size_t)(row * 2 + 0) * DFF + ff] = s1; p.out[O_FCS + (size_t)(row * 2 + 1) * DFF + ff] = u; return 0.f;
            });
    }
}

DEV void phase_down(const Params& p) {
    unsigned char* ws = p.ws;
    const bf16_t* fin = (const bf16_t*)(ws + W_PROJ); const bf16_t* BtDown = (const bf16_t*)(ws + W_BTDOWN);
    const float* mod = (const float*)(ws + W_MOD); float* rss2 = (float*)(ws + W_RSS2);
    const float* edgeU = (const float*)(ws + W_EDGEU); const float* edgeG = (const float*)(ws + W_EDGEG); const float* tailU = (const float*)(ws + W_TAILU);
    constexpr int NBIG = 64 * 4;
    for (int it = BIDX(); it < NBIG; it += gridDim.x) {
        int pm, pn; tile_order(it, 64, 4, pm, pn);
        bf16_t* fix = (bf16_t*)(ws + W_FIX) + (size_t)it * 2 * DFF;
            {
                const bool hp = (pm & 7) != 0;
                for (int i = TIDX(); i < DFF / 4; i += 512) {
                    const int ff = 4 * i;
                    const f32x4 z = (f32x4){0.f, 0.f, 0.f, 0.f};
                    const f32x4 um1 = hp ? *(const f32x4*)(tailU + (size_t)((pm - 1) * 2 + 1) * DFF + ff) : z, um2 = hp ? *(const f32x4*)(tailU + (size_t)((pm - 1) * 2 + 0) * DFF + ff) : z;
                    const f32x4 u0 = *(const f32x4*)(edgeU + (size_t)(pm * 2) * DFF + ff), u1 = *(const f32x4*)(edgeU + (size_t)(pm * 2 + 1) * DFF + ff);
                    const f32x4 g0 = *(const f32x4*)(edgeG + (size_t)(pm * 2) * DFF + ff), g1 = *(const f32x4*)(edgeG + (size_t)(pm * 2 + 1) * DFF + ff);
                    const f32x4 cb = *(const f32x4*)(p.cf_b + ff), w0 = *(const f32x4*)(p.cf_w + ff), w1 = *(const f32x4*)(p.cf_w + DFF + ff), w2 = *(const f32x4*)(p.cf_w + 2 * DFF + ff);
                    const f32x4 c0 = cb + w0 * um2 + w1 * um1 + w2 * u0, c1 = cb + w0 * um1 + w1 * u0 + w2 * u1;
                    u32x2 o0, o1;
                    o0.x = cvt_pk_bf16(geluf_(c0.x) * g0.x, geluf_(c0.y) * g0.y); o0.y = cvt_pk_bf16(geluf_(c0.z) * g0.z, geluf_(c0.w) * g0.w);
                    o1.x = cvt_pk_bf16(geluf_(c1.x) * g1.x, geluf_(c1.y) * g1.y); o1.y = cvt_pk_bf16(geluf_(c1.z) * g1.z, geluf_(c1.w) * g1.w);
                    *(u32x2*)(fix + ff) = o0; *(u32x2*)(fix + DFF + ff) = o1;
                }
            }
    }
    asm volatile("s_waitcnt vmcnt(0)" ::: "memory");
    __syncthreads();
    gemm_phase<true>(fin, BtDown, DFF, 64, 4, NBIG, (const bf16_t*)(ws + W_FIX), [&](f32x4 (&acc)[2][2][4][2], int pm, int pn, int brow, int bcol, int wr, int wc, int fr, int fq) {
        const int b = brow >> 11;
        const float* mrow = mod + (size_t)b * 6144;
        const bf16_t* xs = (const bf16_t*)(ws + W_H);
        const bool fuse = (gridDim.x == 256);
        unsigned* cnt = (unsigned*)(ws + W_BAR) + 3456 + 64 * pm;
        {
            f32x4 gt[2][2], isf[2][2];
#pragma unroll
            for (int bj = 0; bj < 2; ++bj)
#pragma unroll
                for (int n = 0; n < 2; ++n) {
                    const int col = bcol + bj * HALF + wc * 32 + 8 * fq + 4 * n;
                    gt[bj][n] = *(const f32x4*)(mrow + 5 * D + col);
                    const f32x4 sf = *(const f32x4*)(p.g_ffn + col) * (1.f + *(const f32x4*)(mrow + 4 * D + col));
                    isf[bj][n] = (f32x4){__builtin_amdgcn_rcpf(sf.x), __builtin_amdgcn_rcpf(sf.y), __builtin_amdgcn_rcpf(sf.z), __builtin_amdgcn_rcpf(sf.w)};
                }
#pragma unroll
            for (int ai = 0; ai < 2; ++ai)
#pragma unroll
                for (int m = 0; m < 4; ++m) {
                    const int row = brow + ai * HALF + wr * 64 + m * 16 + fr;
                    float ss = 0.f;
#pragma unroll
                    for (int bj = 0; bj < 2; ++bj) {
                        const int col = bcol + bj * HALF + wc * 32 + 8 * fq;
                        float xv[8]; unpack8(*(const u32x4*)(xs + (size_t)row * D + col), xv);
#pragma unroll
                        for (int n = 0; n < 2; ++n) {
                            const f32x4 x1 = (f32x4){xv[4 * n], xv[4 * n + 1], xv[4 * n + 2], xv[4 * n + 3]} * isf[bj][n];
                            const f32x4 y = x1 + gt[bj][n] * acc[ai][bj][m][n];
                            acc[ai][bj][m][n] = y;
                            ss += (y.x * y.x + y.y * y.y) + (y.z * y.z + y.w * y.w);
                        }
                    }
                    ss += __shfl_xor(ss, 16); ss += __shfl_xor(ss, 32);
                    if (fq == 0) atomicAdd(rss2 + row, ss);
                }
        }
        asm volatile("s_waitcnt vmcnt(0)" ::: "memory");
        __syncthreads();
        if (fuse && TIDX() == 0) {
            __hip_atomic_fetch_add(cnt, 1u, __ATOMIC_RELAXED, __HIP_MEMORY_SCOPE_AGENT);
            unsigned sp = 0;
            while (__hip_atomic_load(cnt, __ATOMIC_RELAXED, __HIP_MEMORY_SCOPE_AGENT) < 4u) { __builtin_amdgcn_s_sleep(2); if (++sp > (1u << 22)) break; }
        }
        __syncthreads();
        {
            f32x4 gf[2][2];
#pragma unroll
            for (int bj = 0; bj < 2; ++bj)
#pragma unroll
                for (int n = 0; n < 2; ++n) gf[bj][n] = *(const f32x4*)(p.g_final + bcol + bj * HALF + wc * 32 + 8 * fq + 4 * n);
            float tot[2][4];
#pragma unroll
            for (int ai = 0; ai < 2; ++ai)
#pragma unroll
                for (int m = 0; m < 4; ++m) tot[ai][m] = fuse ? __hip_atomic_load(rss2 + brow + ai * HALF + wr * 64 + m * 16 + fr, __ATOMIC_RELAXED, __HIP_MEMORY_SCOPE_AGENT) : 0.f;
#pragma unroll
            for (int ai = 0; ai < 2; ++ai)
#pragma unroll
                for (int m = 0; m < 4; ++m) {
                    const int row = brow + ai * HALF + wr * 64 + m * 16 + fr;
                    const float rstd = fuse ? __builtin_amdgcn_rsqf(tot[ai][m] * (1.f / D) + EPS) : 1.f;
#pragma unroll
                    for (int bj = 0; bj < 2; ++bj)
#pragma unroll
                        for (int n = 0; n < 2; ++n)
                            *(f32x4*)(p.out + O_YP + (size_t)row * D + bcol + bj * HALF + wc * 32 + 8 * fq + 4 * n) = fuse ? acc[ai][bj][m][n] * rstd * gf[bj][n] : acc[ai][bj][m][n];
                }
        }
    });
    for (int j = BIDX(); j < 32 * 11; j += gridDim.x) {
        const int g = j / 11, ksl = j - g * 11;
        const bf16_t* B0 = BtDown + (size_t)(32 * g) * DFF + ksl * 256;
        float* part = (float*)(ws + W_KVT) + (size_t)ksl * NSMP * D;
        skinny_tile<8, 2, 2>(fin + (size_t)NTOK * DFF + ksl * 256, DFF, B0, B0 + 16 * DFF, 256, [&](int row, int s, float v0, float v1) {
            const int c0 = 32 * g + slotcol(0, s);
            part[(size_t)row * D + c0] = v0; part[(size_t)row * D + c0 + 4] = v1; return 0.f;
        }, NoRowFn(), DFF);
    }
}

DEV void phase_final(const Params& p) {
    const float* rss2 = (const float*)(p.ws + W_RSS2);
    const int gt = BIDX() * 512 + TIDX(), GT = gridDim.x * 512;
    if (gridDim.x != 256)
    for (int i = gt; i < NTOK * 256; i += GT) {
        const int row = i >> 8, k = (i & 255) * 4;
        const float rstd = __builtin_amdgcn_rsqf(rss2[row] * (1.f / D) + EPS);
        f32x4* yp = (f32x4*)(p.out + (size_t)row * D + k);
        *yp = *yp * rstd * *(const f32x4*)(p.g_final + k);
    }
    const float* part = (const float*)(p.ws + W_KVT); const float* mod = (const float*)(p.ws + W_MOD);
    const int lane = TIDX() & 63, gw = BIDX() * 8 + (TIDX() >> 6), NGW = gridDim.x * 8;
    for (int row = gw; row < NSMP; row += NGW) {
        float* yp = p.out + O_YS + (size_t)row * D; const float* mrow = mod + (size_t)(8 + row) * 6144 + 5 * D;
        f32x4 y[4]; float ss = 0.f;
#pragma unroll
        for (int j = 0; j < 4; ++j) {
            const int k = 4 * lane + 256 * j;
            f32x4 a = (f32x4){0.f, 0.f, 0.f, 0.f};
#pragma unroll
            for (int sl = 0; sl < 11; ++sl) a = a + *(const f32x4*)(part + ((size_t)sl * NSMP + row) * D + k);
            y[j] = *(const f32x4*)(yp + k) + *(const f32x4*)(mrow + k) * a;
            ss += y[j].x * y[j].x + y[j].y * y[j].y + y[j].z * y[j].z + y[j].w * y[j].w;
        }
        const float rstd = __builtin_amdgcn_rsqf(wave_sum(ss) * (1.f / D) + EPS);
#pragma unroll
        for (int j = 0; j < 4; ++j) { const int k = 4 * lane + 256 * j; *(f32x4*)(yp + k) = y[j] * rstd * *(const f32x4*)(p.g_final + k); }
    }
}

#define XB_TMO      128
#define XB_XCNT(j)  (256  + 64 * (j))
#define XB_XSUB(j)  (1280 + 64 * (j))
#define XB_XGEN(j)  (2304 + 64 * (j))
#define XB_TOP      3328
#define XB_TOPGEN   3392
#define XCD_BAR_WORDS 3456
#define XB_SPIN_CAP (1u << 20)
DEV unsigned xb_ld(unsigned* p) { return __hip_atomic_load(p, __ATOMIC_RELAXED, __HIP_MEMORY_SCOPE_AGENT); }
DEV unsigned xb_add(unsigned* p, unsigned v) { return __hip_atomic_fetch_add(p, v, __ATOMIC_RELAXED, __HIP_MEMORY_SCOPE_AGENT); }
DEV unsigned xb_xcc_id() { return (unsigned)__builtin_amdgcn_s_getreg((3 << 11) | 20) & 0xFu; }
#define XB_SPIN(cond, bar) do { unsigned _sp = 0; while (cond) { __builtin_amdgcn_s_sleep(4); \
    if ((++_sp & 255u) == 0u) { if (xb_ld(&(bar)[XB_TMO])) break; if (_sp > XB_SPIN_CAP) { atomicAdd(&(bar)[XB_TMO], 1u); break; } } } } while (0)
struct XcdBarrier { unsigned* bar; unsigned x; volatile LAS unsigned* st; };
DEV XcdBarrier xcd_barrier_post(unsigned* bar, volatile LAS unsigned* st) {
    XcdBarrier b; b.bar = bar; b.x = xb_xcc_id(); b.st = st;
    if (threadIdx.x == 0) (void)xb_add(&bar[XB_XCNT(b.x)], 1u);
    return b;
}
DEV void xcd_barrier_complete(unsigned* bar, unsigned x, unsigned& nloc, unsigned& nx) {
    const unsigned G = gridDim.x * gridDim.y * gridDim.z;
    unsigned sum, cnt, mine, sp = 0u;
    for (;;) {
        sum = 0u; cnt = 0u; mine = 0u;
#pragma unroll
        for (unsigned j = 0; j < 16; ++j) { const unsigned c = xb_ld(&bar[XB_XCNT(j)]); sum += c; cnt += (c > 0u) ? 1u : 0u; mine = (j == x) ? c : mine; }
        if (sum == G) break;
        __builtin_amdgcn_s_sleep(1);
        if ((++sp & 255u) == 0u) { if (xb_ld(&bar[XB_TMO])) break; if (sp > XB_SPIN_CAP) { atomicAdd(&bar[XB_TMO], 1u); break; } }
    }
    nloc = mine > 0u ? mine : 1u; nx = cnt > 0u ? cnt : 1u;
}
DEV void xcd_barrier(const XcdBarrier& b) {
    asm volatile("s_waitcnt vmcnt(0)" ::: "memory");
    __syncthreads();
    if (threadIdx.x == 0) {
        unsigned* bar = b.bar;
        __builtin_amdgcn_s_waitcnt(0);
        unsigned nloc = b.st[0], nx = b.st[1];
        if (nloc == 0u) { xcd_barrier_complete(bar, b.x, nloc, nx); b.st[0] = nloc; b.st[1] = nx; }
        const unsigned old = xb_add(&bar[XB_XSUB(b.x)], 1u);
        const unsigned gen = old / nloc;
        if (old + 1u == (gen + 1u) * nloc) {
            __builtin_amdgcn_fence(__ATOMIC_RELEASE, "agent");
            asm volatile("s_waitcnt vmcnt(0)" ::: "memory");
            const unsigned og = xb_add(&bar[XB_TOP], 1u);
            const unsigned tg = og / nx;
            if (og + 1u == (tg + 1u) * nx) xb_add(&bar[XB_TOPGEN], 1u);
            else XB_SPIN(xb_ld(&bar[XB_TOPGEN]) == tg, bar);
            __builtin_amdgcn_fence(__ATOMIC_ACQUIRE, "agent");
            xb_add(&bar[XB_XGEN(b.x)], 1u);
            asm volatile("s_waitcnt vmcnt(0)" ::: "memory");
        } else {
            XB_SPIN(xb_ld(&bar[XB_XGEN(b.x)]) == gen, bar);
            __builtin_amdgcn_fence(__ATOMIC_ACQUIRE, "agent");
            asm volatile("s_waitcnt vmcnt(0)" ::: "memory");
        }
    }
    __syncthreads();
}

typedef const unsigned long long __attribute__((address_space(4)))* KWordPtr;
DEV Params kparams() {
    KWordPtr k = (KWordPtr)__builtin_amdgcn_kernarg_segment_ptr(); asm volatile("" : "+s"(k));
    Params q; unsigned long long* d = (unsigned long long*)&q;
#pragma unroll
    for (int i = 0; i < (int)(sizeof(Params) / 8); ++i) d[i] = k[i];
    return q;
}
__global__ void __launch_bounds__(512) fwd_kernel(Params p) {
    cg::grid_group grid = cg::this_grid();
    volatile LAS unsigned* xst = (volatile LAS unsigned*)((LAS unsigned char*)shm_raw + (LDS_BYTES - 16));
    if (threadIdx.x == 0) { xst[0] = 0u; xst[1] = 0u; }
    __syncthreads();
    const XcdBarrier xb = xcd_barrier_post((unsigned*)(p.ws + W_BAR), xst);
    const int lo = (int)p.ph_lo, hi = (int)p.ph_hi;
    if (hi < 0) grid.sync();
#ifdef ONLY_PHASE
#define RUNP(si, ph, call) if (ph == ONLY_PHASE) { const Params q = kparams(); call(q); }
#else
#define RUNP(si, ph, call) if (lo <= si && si < hi) { { const Params q = kparams(); call(q); } if (si + 1 < hi) { xcd_barrier(xb); } }
#endif
    RUNP(0, 0, phase_prep)
    RUNP(1, 1, phase_mod)
    RUNP(2, 2, phase_norm1)
    RUNP(3, 3, phase_inproj)
    RUNP(4, 4, phase_mixA)
    RUNP(5, 10, phase_scan)
    RUNP(6, 5, phase_mixC)
    RUNP(7, 6, phase_outproj)
    RUNP(8, 7, phase_up)
    RUNP(9, 8, phase_down)
    RUNP(10, 9, phase_final)
}

extern "C" void kernel_launch(void* const* d_in, const int* in_sizes, int n_in, void* d_out, int out_size, void* d_ws, size_t ws_size, hipStream_t stream) {
    static int grid_blocks = 0;
    if (grid_blocks == 0) {
        if (n_in != 27 || ws_size < W_END) { fprintf(stderr, "kernel_launch: unexpected n_in %d or ws_size %zu (< %zu)\n", n_in, ws_size, (size_t)W_END); grid_blocks = -1; return; }
        int dev = 0, cus = 0, per_cu = 0;
        hipGetDevice(&dev);
        hipDeviceGetAttribute(&cus, hipDeviceAttributeMultiprocessorCount, dev);
        if (hipFuncSetAttribute((const void*)fwd_kernel, hipFuncAttributeMaxDynamicSharedMemorySize, LDS_BYTES) != hipSuccess) { fprintf(stderr, "kernel_launch: hipFuncSetAttribute failed\n"); grid_blocks = -1; return; }
        if (hipOccupancyMaxActiveBlocksPerMultiprocessor(&per_cu, (const void*)fwd_kernel, 512, LDS_BYTES) != hipSuccess || per_cu < 1) { fprintf(stderr, "kernel_launch: occupancy query failed (%d)\n", per_cu); (void)hipGetLastError(); per_cu = 1; }
        grid_blocks = cus * 1;
    }
    if (grid_blocks < 0) return;
    Params p{};
    const float** pp = (const float**)&p;
    for (int i = 0; i < 27; ++i) pp[i] = (const float*)d_in[i];
    p.out = (float*)d_out; p.ws = (unsigned char*)d_ws;
    if (hipMemsetAsync((char*)d_ws + W_BAR, 0, (size_t)BAR_WORDS * 4, stream) != hipSuccess) { fprintf(stderr, "kernel_launch: memset failed\n"); return; }
#if MK_MULTI
    for (int ph = 0; ph < 11; ++ph) {
        p.ph_lo = ph; p.ph_hi = ph + 1;
        hipLaunchKernelGGL(fwd_kernel, dim3(grid_blocks), dim3(512), LDS_BYTES, stream, p);
    }
#else
    p.ph_lo = 0; p.ph_hi = 11;
    void* args[] = {&p};
    hipError_t e = hipLaunchCooperativeKernel((const void*)fwd_kernel, dim3(grid_blocks), dim3(512), args, LDS_BYTES, stream);
    if (e != hipSuccess) fprintf(stderr, "cooperative launch failed: %s (grid %d)\n", hipGetErrorString(e), grid_blocks);
#endif
}
```
